# Optimizing an MI355X kernel written in HIP

```python
import jax, jax.numpy as jnp
from jax import lax
import numpy as np

D_MODEL = 1024
BATCH = 8
SEQ = 2048
DEPTH = 2
DEC_BATCH = 128
DEC_SEQ = 1
PAST_LEN = 16384
PAGE_SIZE = 128

D_MIX = 2 * D_MODEL
D_CONV_A = D_MIX // 4
CONV_A_W = 3
D_HG = D_MIX // 4
HG_HEADS = 4
HG_DK = D_HG // HG_HEADS
HG_DV = D_HG // HG_HEADS
HG_CHUNK = 16
D_SSD = D_MIX // 2
SSD_HEADDIM = 64
SSD_HEADS = D_SSD // SSD_HEADDIM
SSD_GROUPS = 2
SSD_STATE = 128
SSD_CONV_W = 4
SSD_CHUNK = 64
SSD_CONV_DIM = D_SSD + 2 * SSD_GROUPS * SSD_STATE
N_MEM = 256
XA_HEADS = 4
XA_HEADDIM = D_MODEL // XA_HEADS
EPS = 1e-6
IN_SIZES = (D_CONV_A,) * 4 + (D_HG,) * 4 + (D_SSD, SSD_CONV_DIM, SSD_HEADS)
D_IN_PROJ = sum(IN_SIZES)

kernel_name = 'hybrid_conv_hgrn2_ssd_memxattn_step'


def rmsnorm(x, g):
    xf = x.astype(jnp.float32)
    y = xf * lax.rsqrt(jnp.mean(xf * xf, axis=-1, keepdims=True) + EPS)
    return (y * g.astype(jnp.float32)).astype(x.dtype)


def split_cols(u, sizes):
    offs = np.cumsum(np.array(sizes))[:-1].tolist()
    return jnp.split(u, offs, axis=-1)


def causal_dwconv(x, w, prev):
    W = w.shape[0]
    L = x.shape[1]
    xp = jnp.concatenate([prev.astype(x.dtype), x], axis=1)
    y = xp[:, 0:L] * w[0]
    for k in range(1, W):
        y = y + xp[:, k:k + L] * w[k]
    return y, xp[:, -(W - 1):]


def pad_time(a, Lp):
    L = a.shape[1]
    cfg = [(0, 0)] * a.ndim
    cfg[1] = (0, Lp - L)
    return jnp.pad(a, cfg)


def hgrn2_chunked(q, k, v, logf, S0):
    b, L, h, dk = q.shape
    C = min(HG_CHUNK, L)
    nc = -(-L // C)
    Lp = nc * C
    q, k, v, logf = [pad_time(a.astype(jnp.float32), Lp) for a in (q, k, v, logf)]
    chunks = lambda a: jnp.moveaxis(a.reshape(b, nc, C, h, a.shape[-1]), 1, 0)
    mask = jnp.tril(jnp.ones((C, C), bool))[None, :, :, None, None]

    def step(S, inp):
        qc, kc, vc, gc = inp
        G = jnp.cumsum(gc, axis=1)
        diff = G[:, :, None] - G[:, None, :]
        decay = jnp.exp(jnp.where(mask, diff, -jnp.inf))
        A = jnp.einsum('bihk,bjhk,bijhk->bhij', qc, kc, decay)
        o = (jnp.einsum('bhij,bjhv->bihv', A, vc)
             + jnp.einsum('bihk,bhkv->bihv', qc * jnp.exp(G), S))
        Glast = G[:, -1]
        kd = kc * jnp.exp(Glast[:, None] - G)
        S = jnp.exp(Glast)[..., None] * S + jnp.einsum('bjhk,bjhv->bhkv', kd, vc)
        return S, o

    S, o = lax.scan(step, S0.astype(jnp.float32), (chunks(q), chunks(k), chunks(v), chunks(logf)))
    o = jnp.moveaxis(o, 0, 1).reshape(b, Lp, h, v.shape[-1])[:, :L]
    return o, S


def segsum(a):
    cs = jnp.cumsum(a, axis=-1)
    T = a.shape[-1]
    mask = jnp.tril(jnp.ones((T, T), bool))
    return jnp.where(mask, cs[..., :, None] - cs[..., None, :], -jnp.inf)


def ssd_chunked(x, dt, A, Bm, Cm, S0):
    b, L, H, P = x.shape
    G, N = Bm.shape[2], Bm.shape[3]
    R = H // G
    Cs = min(SSD_CHUNK, L)
    nc = -(-L // Cs)
    Lp = nc * Cs
    x, dt, Bm, Cm = [pad_time(a.astype(jnp.float32), Lp) for a in (x, dt, Bm, Cm)]
    X = (x * dt[..., None]).reshape(b, nc, Cs, G, R, P)
    dA = (dt * A.astype(jnp.float32)).reshape(b, nc, Cs, G, R).transpose(0, 3, 4, 1, 2)
    Bc = Bm.reshape(b, nc, Cs, G, N)
    Cc = Cm.reshape(b, nc, Cs, G, N)
    Acs = jnp.cumsum(dA, axis=-1)
    Lmat = jnp.exp(segsum(dA))
    y_diag = jnp.einsum('bclgn,bcsgn,bgrcls,bcsgrp->bclgrp', Cc, Bc, Lmat, X)
    decay_states = jnp.exp(Acs[..., -1:] - Acs)
    states = jnp.einsum('bcsgn,bgrcs,bcsgrp->bcgrpn', Bc, decay_states, X)
    chunk_decay = jnp.exp(Acs[..., -1])

    def step(S, inp):
        st, dec = inp
        return dec[..., None, None] * S + st, S

    S_fin, S_prev = lax.scan(step, S0.astype(jnp.float32).reshape(b, G, R, P, N),
                             (jnp.moveaxis(states, 1, 0), jnp.moveaxis(chunk_decay, -1, 0)))
    S_prev = jnp.moveaxis(S_prev, 0, 1)
    y_off = jnp.einsum('bclgn,bcgrpn,bgrcl->bclgrp', Cc, S_prev, jnp.exp(Acs))
    y = (y_diag + y_off).reshape(b, Lp, H, P)[:, :L]
    return y, S_fin.reshape(b, H, P, N)


def memory_kv(mem, g_mem, w_k, w_v):
    b = mem.shape[0]
    m = rmsnorm(mem, g_mem)
    k = (m @ w_k).reshape(b, N_MEM, XA_HEADS, XA_HEADDIM)
    v = (m @ w_v).reshape(b, N_MEM, XA_HEADS, XA_HEADDIM)
    return k, v


def cross_attn(h, mk, mv, w_q, w_o):
    b, L, _ = h.shape
    q = (h @ w_q).reshape(b, L, XA_HEADS, XA_HEADDIM)
    s = jnp.einsum('blhd,bmhd->bhlm', q.astype(jnp.float32), mk.astype(jnp.float32)) * (XA_HEADDIM ** -0.5)
    p = jax.nn.softmax(s, axis=-1)
    o = jnp.einsum('bhlm,bmhd->blhd', p, mv.astype(jnp.float32)).reshape(b, L, D_MODEL).astype(h.dtype)
    return o @ w_o


def decoder_layer(x, conv_a_prev, hg_S, ssd_conv_prev, ssd_S, mk, mv, lb, p):
    (w_in, conv_a_w, hg_gnorm, ssd_conv_w, ssd_conv_b, dt_bias, A_log, D_skip, ssd_norm,
     w_out, g_pre_mix, g_post_mix, g_pre_x, g_post_x, w_q, w_o) = p
    b, L, _ = x.shape
    h = rmsnorm(x, g_pre_mix)
    u = h @ w_in
    a_h, a_b, a_c, a_z, g_q, g_f, g_i, g_z, s_z, s_xbc, s_dt = split_cols(u, IN_SIZES)
    a_conv, conv_a_new = causal_dwconv(a_c * a_h, conv_a_w, conv_a_prev)
    y_a = a_b * a_conv * jax.nn.silu(a_z)
    f = lb + (1.0 - lb) * jax.nn.sigmoid(g_f.astype(jnp.float32))
    logf = jnp.log(f)
    kk = 1.0 - f
    hs = lambda t: t.reshape(b, L, HG_HEADS, HG_DK)
    o, hg_S_new = hgrn2_chunked(hs(g_q), hs(kk), hs(g_i), hs(logf), hg_S)
    o = rmsnorm(o, hg_gnorm.reshape(HG_HEADS, HG_DV)).reshape(b, L, D_HG).astype(x.dtype)
    y_b = o * jax.nn.silu(g_z)
    xbc, ssd_conv_new = causal_dwconv(s_xbc, ssd_conv_w, ssd_conv_prev)
    xbc = jax.nn.silu(xbc + ssd_conv_b)
    sx, sB, sC = split_cols(xbc, (D_SSD, SSD_GROUPS * SSD_STATE, SSD_GROUPS * SSD_STATE))
    dt = jax.nn.softplus(s_dt.astype(jnp.float32) + dt_bias.astype(jnp.float32))
    A = -jnp.exp(A_log.astype(jnp.float32))
    sxh = sx.reshape(b, L, SSD_HEADS, SSD_HEADDIM)
    y, ssd_S_new = ssd_chunked(sxh, dt, A, sB.reshape(b, L, SSD_GROUPS, SSD_STATE),
                               sC.reshape(b, L, SSD_GROUPS, SSD_STATE), ssd_S)
    y = y + D_skip.astype(jnp.float32)[:, None] * sxh.astype(jnp.float32)
    y_c = rmsnorm(y.reshape(b, L, D_SSD).astype(x.dtype) * jax.nn.silu(s_z), ssd_norm)
    mix = jnp.concatenate([y_a, y_b, y_c], axis=-1) @ w_out
    x = x + rmsnorm(mix, g_post_mix)
    x = x + rmsnorm(cross_attn(rmsnorm(x, g_pre_x), mk, mv, w_q, w_o), g_post_x)
    return x, conv_a_new, hg_S_new, ssd_conv_new, ssd_S_new


def setup_inputs(seed: int = 0) -> dict:
    key = jax.random.key(seed)
    ks = jax.random.split(key, 32)
    nrm = lambda k, s, sc: jax.random.normal(k, s, jnp.float32) * sc
    gain = lambda k, s: 1.0 + 0.02 * jax.random.normal(k, s, jnp.float32)
    dt0 = jnp.exp(jax.random.uniform(ks[12], (DEPTH, SSD_HEADS), jnp.float32)
                  * (np.log(0.1) - np.log(0.001)) + np.log(0.001))
    return {
        'x_prompt': nrm(ks[0], (BATCH, SEQ, D_MODEL), 1.0),
        'x_sample': nrm(ks[1], (DEC_BATCH, DEC_SEQ, D_MODEL), 1.0),
        'mem_prompt': nrm(ks[2], (BATCH, N_MEM, D_MODEL), 1.0),
        'state_conv_a': nrm(ks[3], (DEPTH, DEC_BATCH, CONV_A_W - 1, D_CONV_A), 1.0),
        'state_hgrn': nrm(ks[4], (DEPTH, DEC_BATCH, HG_HEADS, HG_DK, HG_DV), 0.1),
        'state_ssd_conv': nrm(ks[5], (DEPTH, DEC_BATCH, SSD_CONV_W - 1, SSD_CONV_DIM), 1.0),
        'state_ssd': nrm(ks[6], (DEPTH, DEC_BATCH, SSD_HEADS, SSD_HEADDIM, SSD_STATE), 0.1),
        'cache_mem_k': nrm(ks[7], (DEPTH, DEC_BATCH, N_MEM, XA_HEADS, XA_HEADDIM), 1.0),
        'cache_mem_v': nrm(ks[8], (DEPTH, DEC_BATCH, N_MEM, XA_HEADS, XA_HEADDIM), 1.0),
        'w_in': nrm(ks[9], (DEPTH, D_MODEL, D_IN_PROJ), D_MODEL ** -0.5),
        'conv_a_w': nrm(ks[10], (DEPTH, CONV_A_W, D_CONV_A), CONV_A_W ** -0.5),
        'hgrn_lb': nrm(ks[11], (DEPTH, D_HG), 1.0),
        'hgrn_gnorm': gain(ks[13], (DEPTH, D_HG)),
        'ssd_conv_w': nrm(ks[14], (DEPTH, SSD_CONV_W, SSD_CONV_DIM), SSD_CONV_W ** -0.5),
        'ssd_conv_b': nrm(ks[15], (DEPTH, SSD_CONV_DIM), 0.02),
        'ssd_dt_bias': dt0 + jnp.log(-jnp.expm1(-dt0)),
        'ssd_A_log': jnp.log(jax.random.uniform(ks[16], (DEPTH, SSD_HEADS), jnp.float32, 1.0, 16.0)),
        'ssd_D': gain(ks[17], (DEPTH, SSD_HEADS)),
        'ssd_norm': gain(ks[18], (DEPTH, D_SSD)),
        'w_out': nrm(ks[19], (DEPTH, D_MIX, D_MODEL), D_MIX ** -0.5),
        'g_pre_mix': gain(ks[20], (DEPTH, D_MODEL)),
        'g_post_mix': gain(ks[21], (DEPTH, D_MODEL)),
        'g_pre_x': gain(ks[22], (DEPTH, D_MODEL)),
        'g_post_x': gain(ks[23], (DEPTH, D_MODEL)),
        'g_mem': gain(ks[24], (DEPTH, D_MODEL)),
        'w_q': nrm(ks[25], (DEPTH, D_MODEL, D_MODEL), D_MODEL ** -0.5),
        'w_k': nrm(ks[26], (DEPTH, D_MODEL, D_MODEL), D_MODEL ** -0.5),
        'w_v': nrm(ks[27], (DEPTH, D_MODEL, D_MODEL), D_MODEL ** -0.5),
        'w_o': nrm(ks[28], (DEPTH, D_MODEL, D_MODEL), D_MODEL ** -0.5),
    }


def reference(x_prompt, x_sample, mem_prompt, state_conv_a, state_hgrn, state_ssd_conv, state_ssd,
              cache_mem_k, cache_mem_v, w_in, conv_a_w, hgrn_lb, hgrn_gnorm, ssd_conv_w, ssd_conv_b,
              ssd_dt_bias, ssd_A_log, ssd_D, ssd_norm, w_out, g_pre_mix, g_post_mix, g_pre_x, g_post_x,
              g_mem, w_q, w_k, w_v, w_o):
    sm = jax.nn.softmax(hgrn_lb.astype(jnp.float32), axis=0)
    lb_all = jnp.cumsum(sm, axis=0) - sm[0:1]
    yp, ys = x_prompt, x_sample
    p_ca, p_hg, p_sc, p_ss, p_mk, p_mv = [], [], [], [], [], []
    s_ca, s_hg, s_sc, s_ss = [], [], [], []
    for l in range(DEPTH):
        p = (w_in[l], conv_a_w[l], hgrn_gnorm[l], ssd_conv_w[l], ssd_conv_b[l], ssd_dt_bias[l],
             ssd_A_log[l], ssd_D[l], ssd_norm[l], w_out[l], g_pre_mix[l], g_post_mix[l],
             g_pre_x[l], g_post_x[l], w_q[l], w_o[l])
        lb = lb_all[l]
        mk, mv = memory_kv(mem_prompt, g_mem[l], w_k[l], w_v[l])
        yp, ca, hg, sc, ss = decoder_layer(
            yp,
            jnp.zeros((BATCH, CONV_A_W - 1, D_CONV_A), x_prompt.dtype),
            jnp.zeros((BATCH, HG_HEADS, HG_DK, HG_DV), jnp.float32),
            jnp.zeros((BATCH, SSD_CONV_W - 1, SSD_CONV_DIM), x_prompt.dtype),
            jnp.zeros((BATCH, SSD_HEADS, SSD_HEADDIM, SSD_STATE), jnp.float32),
            mk, mv, lb, p)
        p_ca.append(ca); p_hg.append(hg); p_sc.append(sc); p_ss.append(ss); p_mk.append(mk); p_mv.append(mv)
        ys, ca, hg, sc, ss = decoder_layer(
            ys, state_conv_a[l], state_hgrn[l], state_ssd_conv[l], state_ssd[l],
            cache_mem_k[l], cache_mem_v[l], lb, p)
        s_ca.append(ca); s_hg.append(hg); s_sc.append(sc); s_ss.append(ss)
    return (yp, ys, jnp.stack(p_ca), jnp.stack(p_hg), jnp.stack(p_sc), jnp.stack(p_ss),
            jnp.stack(p_mk), jnp.stack(p_mv), jnp.stack(s_ca), jnp.stack(s_hg), jnp.stack(s_sc),
            jnp.stack(s_ss))
```

```cpp
#include <hip/hip_runtime.h>
#include <hip/hip_cooperative_groups.h>
#include <stdint.h>
#include <cstdio>
namespace cg = cooperative_groups;

#ifndef MULTI_LAUNCH
#define MULTI_LAUNCH 0
#endif

typedef unsigned short u16;
typedef short bf16x8 __attribute__((ext_vector_type(8)));
typedef float f32x4 __attribute__((ext_vector_type(4)));
#define DEVINL __device__ __forceinline__

constexpr int D = 1024, NP = 16384, NS = 128, NR = 16512, SEQ = 2048, DINP = 6784, DIN = 6672;
constexpr int NPHASE = 21;
constexpr float EPS = 1e-6f;

constexpr size_t SZ_WIN = (size_t)DINP * 1024 * 2, SZ_WOUT = (size_t)1024 * 2048 * 2, SZ_SQ = (size_t)1024 * 1024 * 2;
constexpr size_t OFF_WIN = 0;
constexpr size_t OFF_WOUT = OFF_WIN + 2 * SZ_WIN;
constexpr size_t OFF_WQ = OFF_WOUT + 2 * SZ_WOUT;
constexpr size_t OFF_WK = OFF_WQ + 2 * SZ_SQ;
constexpr size_t OFF_WV = OFF_WK + 2 * SZ_SQ;
constexpr size_t OFF_WO = OFF_WV + 2 * SZ_SQ;
constexpr size_t OFF_X = OFF_WO + 2 * SZ_SQ;
constexpr size_t OFF_HB = OFF_X + (size_t)NR * 1024 * 4;
constexpr size_t OFF_MB = OFF_HB + (size_t)NR * 1024 * 2;
constexpr size_t OFF_U = OFF_MB + (size_t)2048 * 1024 * 2;
constexpr size_t OFF_XBC = OFF_U + (size_t)NR * DINP * 2;
constexpr size_t OFF_DT = OFF_XBC + (size_t)NR * 1536 * 4;
constexpr size_t OFF_OB = OFF_DT + (size_t)NR * 16 * 4;
constexpr size_t OFF_YC = OFF_OB + (size_t)NR * 512 * 4;
constexpr size_t OFF_YCAT = OFF_YC + (size_t)NR * 1024 * 4;
constexpr size_t OFF_T = OFF_YCAT + (size_t)NR * 2048 * 2;
constexpr size_t OFF_Q = OFF_T + (size_t)NR * 1024 * 4;
constexpr size_t OFF_O = OFF_Q + (size_t)NR * 1024 * 2;
constexpr size_t OFF_MK = OFF_O + (size_t)NR * 1024 * 2;
constexpr size_t OFF_MVT = OFF_MK + (size_t)2048 * 1024 * 2;
constexpr size_t OFF_SCR = OFF_MVT + (size_t)2048 * 1024 * 2;
constexpr size_t SCR_PER_BLOCK = 128 * 256 * 4 + 128 * 256 * 2;
constexpr int MAX_GRID = 1024;
constexpr size_t OFF_XBCB = OFF_SCR + SCR_PER_BLOCK * MAX_GRID;
constexpr size_t OFF_HQG = OFF_XBCB + (size_t)NR * 1536 * 2;
constexpr size_t OFF_HQM = OFF_HQG + (size_t)2048 * 4096 * 2;
constexpr size_t OFF_HKM = OFF_HQM + (size_t)2048 * 4096 * 2;
constexpr size_t OFF_HKD = OFF_HKM + (size_t)2048 * 4096 * 2;
constexpr size_t OFF_HDS = OFF_HKD + (size_t)2048 * 4096 * 2;
constexpr size_t OFF_BAR = OFF_HDS + (size_t)2048 * 128 * 4;
constexpr size_t WS_END = OFF_BAR + 16384;

constexpr size_t O_YP = 0;
constexpr size_t O_YS = O_YP + (size_t)NP * 1024;
constexpr size_t O_CAP = O_YS + (size_t)NS * 1024;
constexpr size_t O_HGP = O_CAP + (size_t)2 * 8 * 2 * 512;
constexpr size_t O_SCP = O_HGP + (size_t)2 * 8 * 4 * 128 * 128;
constexpr size_t O_SSP = O_SCP + (size_t)2 * 8 * 3 * 1536;
constexpr size_t O_MKP = O_SSP + (size_t)2 * 8 * 16 * 64 * 128;
constexpr size_t O_MVP = O_MKP + (size_t)2 * 8 * 256 * 1024;
constexpr size_t O_CAS = O_MVP + (size_t)2 * 8 * 256 * 1024;
constexpr size_t O_HGS = O_CAS + (size_t)2 * 128 * 2 * 512;
constexpr size_t O_SCS = O_HGS + (size_t)2 * 128 * 4 * 128 * 128;
constexpr size_t O_SSS = O_SCS + (size_t)2 * 128 * 3 * 1536;

enum { I_XP = 0, I_XS, I_MEM, I_SCA, I_SHG, I_SSC, I_SSS, I_CK, I_CV, I_WIN, I_CAW, I_HLB, I_HGN, I_SCW, I_SCB, I_DTB, I_ALOG, I_DSK,
       I_SNORM, I_WOUT, I_GPM, I_GQM, I_GPX, I_GQX, I_GMEM, I_WQ, I_WK, I_WV, I_WO };

struct Params {
    const float* in[29];
    float* out;
    char* ws;
    int ph_lo, ph_hi, coop, pad;
};

DEVINL float bf2f(uint32_t h) { return __uint_as_float(h << 16); }
DEVINL uint32_t f2bf(float f) { uint32_t u = __float_as_uint(f); return (u + 0x7fffu + ((u >> 16) & 1u)) >> 16; }
DEVINL uint32_t pack2(float a, float b) { return f2bf(a) | (f2bf(b) << 16); }
DEVINL float lo16(uint32_t v) { return __uint_as_float(v << 16); }
DEVINL float hi16(uint32_t v) { return __uint_as_float(v & 0xffff0000u); }
DEVINL float sigmoidf_(float x) { return __builtin_amdgcn_rcpf(1.0f + __expf(-x)); }
DEVINL float siluf_(float x) { return x * __builtin_amdgcn_rcpf(1.0f + __expf(-x)); }
DEVINL float wave_sum(float v) {
#pragma unroll
    for (int o = 32; o; o >>= 1) v += __shfl_xor(v, o);
    return v;
}
DEVINL float wave_max(float v) {
#pragma unroll
    for (int o = 32; o; o >>= 1) v = fmaxf(v, __shfl_xor(v, o));
    return v;
}
DEVINL void lds_barrier() { asm volatile("s_waitcnt lgkmcnt(0)\n\ts_barrier" ::: "memory"); }
#define UNPACK8(v, f) do { f[0] = lo16(v.x); f[1] = hi16(v.x); f[2] = lo16(v.y); f[3] = hi16(v.y); f[4] = lo16(v.z); f[5] = hi16(v.z); f[6] = lo16(v.w); f[7] = hi16(v.w); } while (0)

template <class Epi>
DEVINL void gemm_tile(const u16* __restrict__ A, int lda, const u16* __restrict__ Bt, int ldb, int K, char* lds, Epi epi) {
    const int tid = threadIdx.x, lane = tid & 63, wave = tid >> 6, wr = wave >> 1, wc = wave & 1, fr = lane & 15, fq = lane >> 4;
    f32x4 acc[4][4];
#pragma unroll
    for (int m = 0; m < 4; ++m)
#pragma unroll
        for (int n = 0; n < 4; ++n) acc[m][n] = (f32x4){0.f, 0.f, 0.f, 0.f};
    const int srow = tid >> 2, sch = tid & 3;
    const u16* Ag = A + (size_t)srow * lda + sch * 8;
    const u16* Bg = Bt + (size_t)srow * ldb + sch * 8;
    const int soff = srow * 64 + ((sch ^ (((srow >> 3) & 1) << 1)) << 4);
    const int swz = ((fq ^ (((fr >> 3) & 1) << 1)) << 4);
    const int fa = (wr * 64 + fr) * 64 + swz;
    const int fb = 16384 + (wc * 64 + fr) * 64 + swz;
    uint4 pa0, pa1, pa2, pa3, pb0, pb1, pb2, pb3, qa0, qa1, qa2, qa3, qb0, qb1, qb2, qb3;
    const int nt = K >> 6;
    const size_t sA1 = (size_t)64 * lda, sB1 = (size_t)64 * ldb;
#define G_LOAD(P, T) do { const int k0_ = (T) << 6; \
        P##a0 = *(const uint4*)(Ag + k0_); P##a1 = *(const uint4*)(Ag + k0_ + 32); P##a2 = *(const uint4*)(Ag + sA1 + k0_); P##a3 = *(const uint4*)(Ag + sA1 + k0_ + 32); \
        P##b0 = *(const uint4*)(Bg + k0_); P##b1 = *(const uint4*)(Bg + k0_ + 32); P##b2 = *(const uint4*)(Bg + sB1 + k0_); P##b3 = *(const uint4*)(Bg + sB1 + k0_ + 32); } while (0)
#define G_STORE(P, ST) do { char* nb_ = lds + (ST) * 32768 + soff; \
        *(uint4*)(nb_) = P##a0; *(uint4*)(nb_ + 8192) = P##a1; *(uint4*)(nb_ + 4096) = P##a2; *(uint4*)(nb_ + 4096 + 8192) = P##a3; \
        *(uint4*)(nb_ + 16384) = P##b0; *(uint4*)(nb_ + 16384 + 8192) = P##b1; *(uint4*)(nb_ + 16384 + 4096) = P##b2; *(uint4*)(nb_ + 16384 + 4096 + 8192) = P##b3; } while (0)
    auto g_compute = [&](int ST) __attribute__((always_inline)) {
        const char* base = lds + ST * 32768;
#pragma unroll
        for (int s = 0; s < 2; ++s) {
            bf16x8 a[4], b[4];
#pragma unroll
            for (int m = 0; m < 4; ++m) a[m] = *(const bf16x8*)(base + fa + m * 1024 + s * 8192);
#pragma unroll
            for (int n = 0; n < 4; ++n) b[n] = *(const bf16x8*)(base + fb + n * 1024 + s * 8192);
            __builtin_amdgcn_s_setprio(1);
#pragma unroll
            for (int m = 0; m < 4; ++m)
#pragma unroll
                for (int n = 0; n < 4; ++n) acc[m][n] = __builtin_amdgcn_mfma_f32_16x16x32_bf16(b[n], a[m], acc[m][n], 0, 0, 0);
            __builtin_amdgcn_s_setprio(0);
        }
    };
#define G_COMPUTE(ST) g_compute(ST)
    G_LOAD(p, 0);
    if (nt > 1) G_LOAD(q, 1);
    G_STORE(p, 0);
    if (nt > 2) G_LOAD(p, 2);
    lds_barrier();
#pragma unroll 1
    for (int t = 0; t < nt; t += 2) {
        if (t + 1 < nt) G_STORE(q, 1);
        if (t + 3 < nt) G_LOAD(q, t + 3);
        G_COMPUTE(0);
        lds_barrier();
        if (t + 1 < nt) {
            if (t + 2 < nt) G_STORE(p, 0);
            if (t + 4 < nt) G_LOAD(p, t + 4);
            G_COMPUTE(1);
            lds_barrier();
        }
    }
#undef G_LOAD
#undef G_STORE
#undef G_COMPUTE
#pragma unroll
    for (int m = 0; m < 4; ++m)
#pragma unroll
        for (int n = 0; n < 4; ++n) epi(wr * 64 + m * 16 + fr, wc * 64 + n * 16 + fq * 4, acc[m][n]);
}

DEVINL void gemm_tile_b(const u16* __restrict__ A, int lda, const u16* __restrict__ Bt, int ldb, int K, char* lds, u16* __restrict__ dst, int ldd) {
    const int tid = threadIdx.x, lane = tid & 63, wave = tid >> 6, wr = wave >> 1, wc = wave & 1, fr = lane & 15, fq = lane >> 4;
    f32x4 acc[4][4];
#pragma unroll
    for (int m = 0; m < 4; ++m)
#pragma unroll
        for (int n = 0; n < 4; ++n) acc[m][n] = (f32x4){0.f, 0.f, 0.f, 0.f};
    const int srow = tid >> 2, sch = tid & 3;
    const u16* Ag = A + (size_t)srow * lda + sch * 8;
    const u16* Bg = Bt + (size_t)srow * ldb + sch * 8;
    const int soff = srow * 64 + ((sch ^ (((srow >> 3) & 1) << 1)) << 4);
    const int swz = ((fq ^ (((fr >> 3) & 1) << 1)) << 4);
    const int fa = (wr * 64 + fr) * 64 + swz;
    const int fb = 16384 + (wc * 64 + fr) * 64 + swz;
    uint4 pa0, pa1, pa2, pa3, pb0, pb1, pb2, pb3, qa0, qa1, qa2, qa3, qb0, qb1, qb2, qb3;
    const int nt = K >> 6;
    const size_t sA1 = (size_t)64 * lda, sB1 = (size_t)64 * ldb;
#define G_LOAD(P, T) do { const int k0_ = (T) << 6; \
        P##a0 = *(const uint4*)(Ag + k0_); P##a1 = *(const uint4*)(Ag + k0_ + 32); P##a2 = *(const uint4*)(Ag + sA1 + k0_); P##a3 = *(const uint4*)(Ag + sA1 + k0_ + 32); \
        P##b0 = *(const uint4*)(Bg + k0_); P##b1 = *(const uint4*)(Bg + k0_ + 32); P##b2 = *(const uint4*)(Bg + sB1 + k0_); P##b3 = *(const uint4*)(Bg + sB1 + k0_ + 32); } while (0)
#define G_STORE(P, ST) do { char* nb_ = lds + (ST) * 32768 + soff; \
        *(uint4*)(nb_) = P##a0; *(uint4*)(nb_ + 8192) = P##a1; *(uint4*)(nb_ + 4096) = P##a2; *(uint4*)(nb_ + 4096 + 8192) = P##a3; \
        *(uint4*)(nb_ + 16384) = P##b0; *(uint4*)(nb_ + 16384 + 8192) = P##b1; *(uint4*)(nb_ + 16384 + 4096) = P##b2; *(uint4*)(nb_ + 16384 + 4096 + 8192) = P##b3; } while (0)
    auto g_compute = [&](int ST) __attribute__((always_inline)) {
        const char* base = lds + ST * 32768;
#pragma unroll
        for (int s = 0; s < 2; ++s) {
            bf16x8 a[4], b[4];
#pragma unroll
            for (int m = 0; m < 4; ++m) a[m] = *(const bf16x8*)(base + fa + m * 1024 + s * 8192);
#pragma unroll
            for (int n = 0; n < 4; ++n) b[n] = *(const bf16x8*)(base + fb + n * 1024 + s * 8192);
            __builtin_amdgcn_s_setprio(1);
#pragma unroll
            for (int m = 0; m < 4; ++m)
#pragma unroll
                for (int n = 0; n < 4; ++n) acc[m][n] = __builtin_amdgcn_mfma_f32_16x16x32_bf16(b[n], a[m], acc[m][n], 0, 0, 0);
            __builtin_amdgcn_s_setprio(0);
        }
    };
#define G_COMPUTE(ST) g_compute(ST)
    G_LOAD(p, 0);
    if (nt > 1) G_LOAD(q, 1);
    G_STORE(p, 0);
    if (nt > 2) G_LOAD(p, 2);
    lds_barrier();
#pragma unroll 1
    for (int t = 0; t < nt; t += 2) {
        if (t + 1 < nt) G_STORE(q, 1);
        if (t + 3 < nt) G_LOAD(q, t + 3);
        G_COMPUTE(0);
        lds_barrier();
        if (t + 1 < nt) {
            if (t + 2 < nt) G_STORE(p, 0);
            if (t + 4 < nt) G_LOAD(p, t + 4);
            G_COMPUTE(1);
            lds_barrier();
        }
    }
#undef G_LOAD
#undef G_STORE
#undef G_COMPUTE
    {
        char* img = lds + wave * 9216;
#pragma unroll
        for (int m = 0; m < 4; ++m)
#pragma unroll
            for (int n = 0; n < 4; ++n)
                *(uint2*)(img + (m * 16 + fr) * 144 + (n * 16 + fq * 4) * 2) = make_uint2(pack2(acc[m][n][0], acc[m][n][1]), pack2(acc[m][n][2], acc[m][n][3]));
        u16* d0 = dst + (size_t)(wr * 64) * ldd + wc * 64 + (lane & 7) * 8;
#pragma unroll
        for (int it = 0; it < 8; ++it) {
            const int row = it * 8 + (lane >> 3);
            const uint4 v = *(const uint4*)(img + row * 144 + (lane & 7) * 16);
            *(uint4*)(d0 + (size_t)row * ldd) = v;
        }
    }
    lds_barrier();
}

template <class Epi>
DEVINL void gemm_tile1(const u16* __restrict__ A, int lda, const u16* __restrict__ Bt, int ldb, int K, char* lds, Epi epi) {
    const int tid = threadIdx.x, lane = tid & 63, wave = tid >> 6, wr = wave >> 1, wc = wave & 1, fr = lane & 15, fq = lane >> 4;
    f32x4 acc[4][4];
#pragma unroll
    for (int m = 0; m < 4; ++m)
#pragma unroll
        for (int n = 0; n < 4; ++n) acc[m][n] = (f32x4){0.f, 0.f, 0.f, 0.f};
    const int srow = tid >> 3, sch = tid & 7;
    const u16* Ag = A + (size_t)srow * lda + sch * 8;
    const u16* Bg = Bt + (size_t)srow * ldb + sch * 8;
    const int soff = (sch >> 2) * 8192 + srow * 64 + ((((sch & 3) ^ (((srow >> 3) & 1) << 1))) << 4);
    const int swz = ((fq ^ (((fr >> 3) & 1) << 1)) << 4);
    const int fa = (wr * 64 + fr) * 64 + swz;
    const int fb = 16384 + (wc * 64 + fr) * 64 + swz;
    uint4 ra[4], rb[4];
    const int nt = K >> 6;
#pragma unroll
    for (int i = 0; i < 4; ++i) {
        ra[i] = *(const uint4*)(Ag + (size_t)i * 32 * lda);
        rb[i] = *(const uint4*)(Bg + (size_t)i * 32 * ldb);
    }
#pragma unroll
    for (int i = 0; i < 4; ++i) {
        *(uint4*)(lds + soff + i * 2048) = ra[i];
        *(uint4*)(lds + 16384 + soff + i * 2048) = rb[i];
    }
    __syncthreads();
    for (int t = 0; t < nt; ++t) {
        const bool more = (t + 1 < nt);
        if (more) {
            const int k0 = (t + 1) << 6;
#pragma unroll
            for (int i = 0; i < 4; ++i) {
                ra[i] = *(const uint4*)(Ag + (size_t)i * 32 * lda + k0);
                rb[i] = *(const uint4*)(Bg + (size_t)i * 32 * ldb + k0);
            }
        }
        const char* base = lds + (t & 1) * 32768;
#pragma unroll
        for (int s = 0; s < 2; ++s) {
            bf16x8 a[4], b[4];
#pragma unroll
            for (int m = 0; m < 4; ++m) a[m] = *(const bf16x8*)(base + fa + m * 1024 + s * 8192);
#pragma unroll
            for (int n = 0; n < 4; ++n) b[n] = *(const bf16x8*)(base + fb + n * 1024 + s * 8192);
#pragma unroll
            for (int m = 0; m < 4; ++m)
#pragma unroll
                for (int n = 0; n < 4; ++n) acc[m][n] = __builtin_amdgcn_mfma_f32_16x16x32_bf16(b[n], a[m], acc[m][n], 0, 0, 0);
        }
        if (more) {
            char* nb = lds + ((t + 1) & 1) * 32768;
#pragma unroll
            for (int i = 0; i < 4; ++i) {
                *(uint4*)(nb + soff + i * 2048) = ra[i];
                *(uint4*)(nb + 16384 + soff + i * 2048) = rb[i];
            }
        }
        __syncthreads();
    }
#pragma unroll
    for (int m = 0; m < 4; ++m)
#pragma unroll
        for (int n = 0; n < 4; ++n) epi(wr * 64 + m * 16 + fr, wc * 64 + n * 16 + fq * 4, acc[m][n]);
}

DEVINL void tile_mn(int id, int nM, int nN, int& m, int& n) {
    const int grp = id / (8 * nN), fm = grp * 8;
    const int gsz = (nM - fm) < 8 ? (nM - fm) : 8;
    const int rem = id - grp * 8 * nN;
    m = fm + rem % gsz; n = rem / gsz;
}

template <class F>
DEVINL void for_tiles_xcd(int T, F f) {
    const int G = gridDim.x;
    if ((G & 7) == 0) {
        const int x = blockIdx.x & 7, s = blockIdx.x >> 3, GS = G >> 3, per = ((((T + 7) >> 3) + 63) >> 6) << 6;
        for (int i = s; i < per; i += GS) { const int id = x * per + i; if (id < T) f(id); }
    } else {
        for (int id = blockIdx.x; id < T; id += G) f(id);
    }
}

DEVINL void transpose_tile(const float* __restrict__ W, int K, int N, u16* __restrict__ Wt, int k0, int n0, float* tile) {
    const int tid = threadIdx.x, tx = tid & 15, ty = tid >> 4;
#pragma unroll
    for (int i = 0; i < 4; ++i) {
        const int k = ty + 16 * i, n = n0 + tx * 4;
        float4 v = make_float4(0.f, 0.f, 0.f, 0.f);
        if (n < N) v = *(const float4*)(W + (size_t)(k0 + k) * N + n);
        float* t = tile + k * 65 + tx * 4;
        t[0] = v.x; t[1] = v.y; t[2] = v.z; t[3] = v.w;
    }
    __syncthreads();
    const int n = tid >> 2, kc = (tid & 3) * 16;
    uint32_t w[8];
#pragma unroll
    for (int j = 0; j < 8; ++j) w[j] = pack2(tile[(kc + 2 * j) * 65 + n], tile[(kc + 2 * j + 1) * 65 + n]);
    uint4* dst = (uint4*)(Wt + (size_t)(n0 + n) * K + k0 + kc);
    dst[0] = make_uint4(w[0], w[1], w[2], w[3]);
    dst[1] = make_uint4(w[4], w[5], w[6], w[7]);
    __syncthreads();
}

DEVINL void rowpass_row(const float* __restrict__ base, const u16* __restrict__ trow, const float* __restrict__ gpost,
                        float* __restrict__ xdst, const float* __restrict__ gnext, u16* __restrict__ hb, int lane) {
    float x[16];
    {
        const float4 a = *(const float4*)(base + lane * 8), b = *(const float4*)(base + lane * 8 + 4);
        const float4 c = *(const float4*)(base + 512 + lane * 8), d = *(const float4*)(base + 512 + lane * 8 + 4);
        x[0] = a.x; x[1] = a.y; x[2] = a.z; x[3] = a.w; x[4] = b.x; x[5] = b.y; x[6] = b.z; x[7] = b.w;
        x[8] = c.x; x[9] = c.y; x[10] = c.z; x[11] = c.w; x[12] = d.x; x[13] = d.y; x[14] = d.z; x[15] = d.w;
    }
    if (trow) {
        float t[16], g[16];
        {
            const uint4 t0 = *(const uint4*)(trow + lane * 8), t1 = *(const uint4*)(trow + 512 + lane * 8);
            t[0] = lo16(t0.x); t[1] = hi16(t0.x); t[2] = lo16(t0.y); t[3] = hi16(t0.y); t[4] = lo16(t0.z); t[5] = hi16(t0.z); t[6] = lo16(t0.w); t[7] = hi16(t0.w);
            t[8] = lo16(t1.x); t[9] = hi16(t1.x); t[10] = lo16(t1.y); t[11] = hi16(t1.y); t[12] = lo16(t1.z); t[13] = hi16(t1.z); t[14] = lo16(t1.w); t[15] = hi16(t1.w);
        }
#pragma unroll
        for (int h = 0; h < 2; ++h)
#pragma unroll
            for (int q = 0; q < 2; ++q) {
                const float4 gg = *(const float4*)(gpost + h * 512 + lane * 8 + q * 4);
                g[h * 8 + q * 4 + 0] = gg.x; g[h * 8 + q * 4 + 1] = gg.y; g[h * 8 + q * 4 + 2] = gg.z; g[h * 8 + q * 4 + 3] = gg.w;
            }
        float ss = 0.f;
#pragma unroll
        for (int i = 0; i < 16; ++i) ss += t[i] * t[i];
        ss = wave_sum(ss);
        const float rstd = rsqrtf(ss * (1.0f / 1024.0f) + EPS);
#pragma unroll
        for (int i = 0; i < 16; ++i) x[i] += t[i] * rstd * g[i];
    }
    if (xdst) {
#pragma unroll
        for (int h = 0; h < 2; ++h)
#pragma unroll
            for (int q = 0; q < 2; ++q)
                *(float4*)(xdst + h * 512 + lane * 8 + q * 4) = make_float4(x[h * 8 + q * 4], x[h * 8 + q * 4 + 1], x[h * 8 + q * 4 + 2], x[h * 8 + q * 4 + 3]);
    }
    if (gnext) {
        float ss = 0.f;
#pragma unroll
        for (int i = 0; i < 16; ++i) ss += x[i] * x[i];
        ss = wave_sum(ss);
        const float rstd = rsqrtf(ss * (1.0f / 1024.0f) + EPS);
#pragma unroll
        for (int h = 0; h < 2; ++h) {
            const float4 g0 = *(const float4*)(gnext + h * 512 + lane * 8), g1 = *(const float4*)(gnext + h * 512 + lane * 8 + 4);
            uint4 o;
            o.x = pack2(x[h * 8 + 0] * rstd * g0.x, x[h * 8 + 1] * rstd * g0.y);
            o.y = pack2(x[h * 8 + 2] * rstd * g0.z, x[h * 8 + 3] * rstd * g0.w);
            o.z = pack2(x[h * 8 + 4] * rstd * g1.x, x[h * 8 + 5] * rstd * g1.y);
            o.w = pack2(x[h * 8 + 6] * rstd * g1.z, x[h * 8 + 7] * rstd * g1.w);
            *(uint4*)(hb + h * 512 + lane * 8) = o;
        }
    }
}

DEVINL void phase_prologue(const Params& p, char* lds) {
    const int G = gridDim.x;
    u16* WinT = (u16*)(p.ws + OFF_WIN);
    u16* WoutT = (u16*)(p.ws + OFF_WOUT);
    for (int it = blockIdx.x; it < 6464; it += G) {
        const int l = it / 3232; int r = it % 3232;
        const float* W; u16* Wt; int K, N, kt, nt;
        if (r < 1696) { W = p.in[I_WIN] + (size_t)l * 1024 * DIN; K = 1024; N = DIN; Wt = WinT + (size_t)l * DINP * 1024; kt = r & 15; nt = r >> 4; }
        else if (r < 2208) { r -= 1696; W = p.in[I_WOUT] + (size_t)l * 2048 * 1024; K = 2048; N = 1024; Wt = WoutT + (size_t)l * 1024 * 2048; kt = r & 31; nt = r >> 5; }
        else {
            r -= 2208; const int j = r >> 8; r &= 255;
            W = p.in[j == 0 ? I_WQ : j == 1 ? I_WK : j == 2 ? I_WV : I_WO] + (size_t)l * 1024 * 1024;
            Wt = (u16*)(p.ws + (j == 0 ? OFF_WQ : j == 1 ? OFF_WK : j == 2 ? OFF_WV : OFF_WO)) + (size_t)l * 1024 * 1024;
            K = 1024; N = 1024; kt = r & 15; nt = r >> 4;
        }
        transpose_tile(W, K, N, Wt, kt * 64, nt * 64, (float*)lds);
    }
    const int wave = threadIdx.x >> 6, lane = threadIdx.x & 63;
    float* X = (float*)(p.ws + OFF_X);
    u16* Hb = (u16*)(p.ws + OFF_HB);
    u16* Mb = (u16*)(p.ws + OFF_MB);
    for (int it = blockIdx.x; it < (NR + 2048) / 4; it += G) {
        const int r = it * 4 + wave;
        if (r < NR) {
            const float* src = r < NP ? p.in[I_XP] + (size_t)r * 1024 : p.in[I_XS] + (size_t)(r - NP) * 1024;
            rowpass_row(src, nullptr, nullptr, nullptr, p.in[I_GPM], Hb + (size_t)r * 1024, lane);
        } else {
            const int m = r - NR;
            rowpass_row(p.in[I_MEM] + (size_t)m * 1024, nullptr, nullptr, nullptr, p.in[I_GMEM], Mb + (size_t)m * 1024, lane);
        }
    }
}

DEVINL void phase_gemm_in(const Params& p, int l, char* lds) {
    const u16* Hb = (const u16*)(p.ws + OFF_HB);
    const u16* Mb = (const u16*)(p.ws + OFF_MB);
    const u16* WinT = (const u16*)(p.ws + OFF_WIN) + (size_t)l * DINP * 1024;
    const u16* WkT = (const u16*)(p.ws + OFF_WK) + (size_t)l * 1024 * 1024;
    const u16* WvT = (const u16*)(p.ws + OFF_WV) + (size_t)l * 1024 * 1024;
    u16* U = (u16*)(p.ws + OFF_U);
    u16* MKb = (u16*)(p.ws + OFF_MK);
    u16* MVT = (u16*)(p.ws + OFF_MVT);
    float* omk = p.out + O_MKP + (size_t)l * 2048 * 1024;
    float* omv = p.out + O_MVP + (size_t)l * 2048 * 1024;
    constexpr int TU = 129 * 53;
    for_tiles_xcd(TU + 256, [&](int id) {
        if (id < TU) {
            int m, n; tile_mn(id, 129, 53, m, n);
            u16* dst = U + (size_t)m * 128 * DINP + n * 128;
            gemm_tile_b(Hb + (size_t)m * 128 * 1024, 1024, WinT + (size_t)n * 128 * 1024, 1024, 1024, lds, dst, DINP);
        } else {
            int id2 = id - TU; const int isv = id2 >> 7; id2 &= 127;
            const int m = id2 & 15, n = id2 >> 4;
            if (!isv) {
                float* df = omk + (size_t)m * 128 * 1024 + n * 128;
                u16* db = MKb + (size_t)m * 128 * 1024 + n * 128;
                gemm_tile(Mb + (size_t)m * 128 * 1024, 1024, WkT + (size_t)n * 128 * 1024, 1024, 1024, lds,
                          [&](int r, int c, f32x4 v) {
                              *(float4*)(df + (size_t)r * 1024 + c) = make_float4(v[0], v[1], v[2], v[3]);
                              *(uint2*)(db + (size_t)r * 1024 + c) = make_uint2(pack2(v[0], v[1]), pack2(v[2], v[3]));
                          });
            } else {
                float* df = omv + (size_t)m * 128 * 1024 + n * 128;
                gemm_tile(Mb + (size_t)m * 128 * 1024, 1024, WvT + (size_t)n * 128 * 1024, 1024, 1024, lds,
                          [&](int r, int c, f32x4 v) {
                              *(float4*)(df + (size_t)r * 1024 + c) = make_float4(v[0], v[1], v[2], v[3]);
                              const int row = m * 128 + r, col = n * 128 + c;
                              const int b = row >> 8, mm = row & 255, h = col >> 8, d = col & 255;
                              u16* t = MVT + ((size_t)((b * 4 + h) * 256 + d)) * 256 + mm;
                              t[0] = (u16)f2bf(v[0]); t[256] = (u16)f2bf(v[1]); t[512] = (u16)f2bf(v[2]); t[768] = (u16)f2bf(v[3]);
                          });
            }
        }
    });
}

DEVINL void phase_gemm_n1024(const u16* A, int K, const u16* Wt, float* Cf, u16* Cb, char* lds) {
    for_tiles_xcd(128 * 8, [&](int id) {
        int m, n; tile_mn(id, 128, 8, m, n);
        const size_t o = (size_t)m * 128 * 1024 + n * 128;
        if (Cf) {
            float* df = Cf + o;
            gemm_tile(A + (size_t)m * 128 * K, K, Wt + (size_t)n * 128 * K, K, K, lds,
                      [&](int r, int c, f32x4 v) { *(float4*)(df + (size_t)r * 1024 + c) = make_float4(v[0], v[1], v[2], v[3]); });
        } else {
            u16* db = Cb + o;
            gemm_tile_b(A + (size_t)m * 128 * K, K, Wt + (size_t)n * 128 * K, K, K, lds, db, 1024);
        }
    });
    const int tid = threadIdx.x, lane = tid & 63, w = tid >> 6, fr = lane & 15, fq = lane >> 4;
    float* red = (float*)lds;
    for (int pc = blockIdx.x; pc < 512; pc += gridDim.x) {
        const int row0 = NP + (pc >> 6) * 16, col0 = (pc & 63) * 16;
        const int kq = K >> 2;
        const u16* pa = A + (size_t)(row0 + fr) * K + w * kq + fq * 8;
        const u16* pb = Wt + (size_t)(col0 + fr) * K + w * kq + fq * 8;
        f32x4 acc = (f32x4){0.f, 0.f, 0.f, 0.f};
#pragma unroll 4
        for (int k = 0; k < kq; k += 32)
            acc = __builtin_amdgcn_mfma_f32_16x16x32_bf16(*(const bf16x8*)(pb + k), *(const bf16x8*)(pa + k), acc, 0, 0, 0);
        *(float4*)(red + (w * 64 + lane) * 4) = make_float4(acc[0], acc[1], acc[2], acc[3]);
        __syncthreads();
        if (w == 0) {
            const float4 a0 = *(const float4*)(red + lane * 4), a1 = *(const float4*)(red + (64 + lane) * 4), a2 = *(const float4*)(red + (128 + lane) * 4), a3 = *(const float4*)(red + (192 + lane) * 4);
            const float v0 = a0.x + a1.x + a2.x + a3.x, v1 = a0.y + a1.y + a2.y + a3.y, v2 = a0.z + a1.z + a2.z + a3.z, v3 = a0.w + a1.w + a2.w + a3.w;
            const size_t o = (size_t)(row0 + fr) * 1024 + col0 + fq * 4;
            if (Cf) *(float4*)(Cf + o) = make_float4(v0, v1, v2, v3);
            else *(uint2*)(Cb + o) = make_uint2(pack2(v0, v1), pack2(v2, v3));
        }
        __syncthreads();
    }
}

DEVINL float hgrn_lb(const Params& p, int l, int c) {
    if (l == 0) return 0.f;
    const float b0 = p.in[I_HLB][c], b1 = p.in[I_HLB][512 + c];
    return 1.0f / (1.0f + __expf(b0 - b1));
}

DEVINL void hgrn_prep_unit(const Params& p, int l, int u, char* lds) {
    const int c = u & 63, h = (u >> 6) & 3, b = u >> 8;
    const int tid = threadIdx.x;
    float* tot = (float*)lds;
    const u16* U = (const u16*)(p.ws + OFF_U);
    u16* QG = (u16*)(p.ws + OFF_HQG) + (size_t)u * 4096;
    u16* QM = (u16*)(p.ws + OFF_HQM) + (size_t)u * 4096;
    u16* KM = (u16*)(p.ws + OFF_HKM) + (size_t)u * 4096;
    u16* KD = (u16*)(p.ws + OFF_HKD) + (size_t)u * 4096;
    float* DS = (float*)(p.ws + OFF_HDS) + (size_t)u * 128;
    const int kp = (tid & 63) * 2, tq = tid >> 6;
    const float lb0 = hgrn_lb(p, l, h * 128 + kp), lb1 = hgrn_lb(p, l, h * 128 + kp + 1);
    const u16* pQ = U + ((size_t)b * SEQ + c * 32 + tq * 8) * DINP + 2048 + h * 128 + kp;
    uint32_t rq[8], rf[8];
#pragma unroll
    for (int i = 0; i < 8; ++i) { rq[i] = *(const uint32_t*)(pQ + (size_t)i * DINP); rf[i] = *(const uint32_t*)(pQ + (size_t)i * DINP + 512); }
    float f0[8], f1[8], L0[8], L1[8];
    {
        float a0 = 0.f, a1 = 0.f;
#pragma unroll
        for (int i = 0; i < 8; ++i) {
            f0[i] = lb0 + (1.f - lb0) * sigmoidf_(lo16(rf[i]));
            f1[i] = lb1 + (1.f - lb1) * sigmoidf_(hi16(rf[i]));
            a0 += __logf(f0[i]); a1 += __logf(f1[i]);
            L0[i] = a0; L1[i] = a1;
        }
        *(float2*)(tot + tq * 128 + kp) = make_float2(a0, a1);
    }
    __syncthreads();
    {
        const float2 t0 = *(const float2*)(tot + kp), t1 = *(const float2*)(tot + 128 + kp), t2 = *(const float2*)(tot + 256 + kp), t3 = *(const float2*)(tot + 384 + kp);
        const float off0 = (tq > 0 ? t0.x : 0.f) + (tq > 1 ? t1.x : 0.f) + (tq > 2 ? t2.x : 0.f);
        const float off1 = (tq > 0 ? t0.y : 0.f) + (tq > 1 ? t1.y : 0.f) + (tq > 2 ? t2.y : 0.f);
        const float ref0 = t0.x + t1.x, ref1 = t0.y + t1.y;
        const float last0 = ref0 + t2.x + t3.x, last1 = ref1 + t2.y + t3.y;
        uint32_t kd[8];
#pragma unroll
        for (int i = 0; i < 8; ++i) {
            const int t = tq * 8 + i;
            const float G0 = L0[i] + off0, G1 = L1[i] + off1;
            const float q0 = lo16(rq[i]), q1 = hi16(rq[i]);
            const float k0 = 1.f - f0[i], k1 = 1.f - f1[i];
            *(uint32_t*)(QG + t * 128 + kp) = pack2(q0 * __expf(G0), q1 * __expf(G1));
            *(uint32_t*)(QM + t * 128 + kp) = pack2(q0 * __expf(fminf(G0 - ref0, 60.f)), q1 * __expf(fminf(G1 - ref1, 60.f)));
            *(uint32_t*)(KM + t * 128 + kp) = pack2(k0 * __expf(fminf(ref0 - G0, 60.f)), k1 * __expf(fminf(ref1 - G1, 60.f)));
            kd[i] = pack2(k0 * __expf(last0 - G0), k1 * __expf(last1 - G1));
        }
        *(uint4*)(KD + kp * 32 + tq * 8) = make_uint4((kd[0] & 0xffffu) | (kd[1] << 16), (kd[2] & 0xffffu) | (kd[3] << 16), (kd[4] & 0xffffu) | (kd[5] << 16), (kd[6] & 0xffffu) | (kd[7] << 16));
        *(uint4*)(KD + (kp + 1) * 32 + tq * 8) = make_uint4((kd[0] >> 16) | (kd[1] & 0xffff0000u), (kd[2] >> 16) | (kd[3] & 0xffff0000u), (kd[4] >> 16) | (kd[5] & 0xffff0000u), (kd[6] >> 16) | (kd[7] & 0xffff0000u));
        if (tq == 0) *(float2*)(DS + kp) = make_float2(__expf(last0), __expf(last1));
    }
    __syncthreads();
}

DEVINL void phase_prep(const Params& p, int l, char* lds) {
    const bool units_first = (int)blockIdx.x < (int)(gridDim.x >> 1);
    if (units_first) { for (int u = blockIdx.x; u < 2048; u += gridDim.x) hgrn_prep_unit(p, l, u, lds); }
    const u16* U = (const u16*)(p.ws + OFF_U);
    u16* Ycat = (u16*)(p.ws + OFF_YCAT);
    float* XBC = (float*)(p.ws + OFF_XBC);
    float* DT = (float*)(p.ws + OFF_DT);
    const int tid = threadIdx.x;
#pragma unroll 1
    for (int it = blockIdx.x; it < 1024; it += gridDim.x) {
        const int b = it >> 7, t0 = (it & 127) * 16;
        const size_t r0 = (size_t)b * SEQ + t0;
        if (tid < 64) {
            const int c0 = tid * 8;
            const float* cw = p.in[I_CAW] + (size_t)l * 3 * 512 + c0;
            float w0[8], w1[8], w2[8], pm2[8], pm1[8];
            {
                const float4 a0 = *(const float4*)cw, a1 = *(const float4*)(cw + 4), b0 = *(const float4*)(cw + 512), b1 = *(const float4*)(cw + 516), d0 = *(const float4*)(cw + 1024), d1 = *(const float4*)(cw + 1028);
                w0[0] = a0.x; w0[1] = a0.y; w0[2] = a0.z; w0[3] = a0.w; w0[4] = a1.x; w0[5] = a1.y; w0[6] = a1.z; w0[7] = a1.w;
                w1[0] = b0.x; w1[1] = b0.y; w1[2] = b0.z; w1[3] = b0.w; w1[4] = b1.x; w1[5] = b1.y; w1[6] = b1.z; w1[7] = b1.w;
                w2[0] = d0.x; w2[1] = d0.y; w2[2] = d0.z; w2[3] = d0.w; w2[4] = d1.x; w2[5] = d1.y; w2[6] = d1.z; w2[7] = d1.w;
            }
            if (t0 > 0) {
                const u16* Uq = U + (r0 - 2) * DINP;
                const uint4 h2 = *(const uint4*)(Uq + c0), c2 = *(const uint4*)(Uq + 1024 + c0), h1 = *(const uint4*)(Uq + DINP + c0), c1 = *(const uint4*)(Uq + DINP + 1024 + c0);
                float fh[8], fc[8];
                UNPACK8(h2, fh); UNPACK8(c2, fc);
#pragma unroll
                for (int i = 0; i < 8; ++i) pm2[i] = fc[i] * fh[i];
                UNPACK8(h1, fh); UNPACK8(c1, fc);
#pragma unroll
                for (int i = 0; i < 8; ++i) pm1[i] = fc[i] * fh[i];
            } else {
#pragma unroll
                for (int i = 0; i < 8; ++i) { pm2[i] = 0.f; pm1[i] = 0.f; }
            }
            const float dtb = (tid < 16) ? p.in[I_DTB][l * 16 + tid] : 0.f;
#pragma unroll 4
            for (int j = 0; j < 16; ++j) {
                const u16* Ur = U + (r0 + j) * DINP;
                const uint4 vh = *(const uint4*)(Ur + c0), vc = *(const uint4*)(Ur + 1024 + c0), vb = *(const uint4*)(Ur + 512 + c0), vz = *(const uint4*)(Ur + 1536 + c0);
                float fh[8], fc[8], fb[8], fz[8], pc[8], y[8];
                UNPACK8(vh, fh); UNPACK8(vc, fc); UNPACK8(vb, fb); UNPACK8(vz, fz);
#pragma unroll
                for (int i = 0; i < 8; ++i) {
                    pc[i] = fc[i] * fh[i];
                    const float cv = w0[i] * pm2[i] + w1[i] * pm1[i] + w2[i] * pc[i];
                    y[i] = fb[i] * cv * siluf_(fz[i]);
                    pm2[i] = pm1[i]; pm1[i] = pc[i];
                }
                *(uint4*)(Ycat + (r0 + j) * 2048 + c0) = make_uint4(pack2(y[0], y[1]), pack2(y[2], y[3]), pack2(y[4], y[5]), pack2(y[6], y[7]));
                if (t0 + j >= SEQ - 2) {
                    float* o = p.out + O_CAP + (((size_t)l * 8 + b) * 2 + (t0 + j - (SEQ - 2))) * 512 + c0;
                    *(float4*)o = make_float4(pc[0], pc[1], pc[2], pc[3]);
                    *(float4*)(o + 4) = make_float4(pc[4], pc[5], pc[6], pc[7]);
                }
                if (tid < 16) {
                    const float xx = bf2f(Ur[6656 + tid]) + dtb;
                    DT[(r0 + j) * 16 + tid] = xx > 20.f ? xx : log1pf(__expf(xx));
                }
            }
        } else {
            const int c0 = (tid - 64) * 8;
            const float* cw = p.in[I_SCW] + (size_t)l * 4 * 1536 + c0;
            const float* cb = p.in[I_SCB] + (size_t)l * 1536 + c0;
            float w0[8], w1[8], w2[8], w3[8], bs[8], x3[8], x2[8], x1[8];
#pragma unroll
            for (int i = 0; i < 8; ++i) { w0[i] = cw[i]; w1[i] = cw[1536 + i]; w2[i] = cw[3072 + i]; w3[i] = cw[4608 + i]; bs[i] = cb[i]; }
            if (t0 > 0) {
                const u16* Uq = U + (r0 - 3) * DINP + 5120 + c0;
                const uint4 v3 = *(const uint4*)Uq, v2 = *(const uint4*)(Uq + DINP), v1 = *(const uint4*)(Uq + 2 * (size_t)DINP);
                UNPACK8(v3, x3); UNPACK8(v2, x2); UNPACK8(v1, x1);
            } else {
#pragma unroll
                for (int i = 0; i < 8; ++i) { x3[i] = 0.f; x2[i] = 0.f; x1[i] = 0.f; }
            }
#pragma unroll 4
            for (int j = 0; j < 16; ++j) {
                const uint4 v = *(const uint4*)(U + (r0 + j) * DINP + 5120 + c0);
                float x0[8], y[8];
                UNPACK8(v, x0);
#pragma unroll
                for (int i = 0; i < 8; ++i) {
                    y[i] = siluf_(w0[i] * x3[i] + w1[i] * x2[i] + w2[i] * x1[i] + w3[i] * x0[i] + bs[i]);
                    x3[i] = x2[i]; x2[i] = x1[i]; x1[i] = x0[i];
                }
                *(uint4*)((u16*)(p.ws + OFF_XBCB) + (r0 + j) * 1536 + c0) = make_uint4(pack2(y[0], y[1]), pack2(y[2], y[3]), pack2(y[4], y[5]), pack2(y[6], y[7]));
                if (t0 + j >= SEQ - 3) {
                    float* o = p.out + O_SCP + (((size_t)l * 8 + b) * 3 + (t0 + j - (SEQ - 3))) * 1536 + c0;
                    *(float4*)o = make_float4(x0[0], x0[1], x0[2], x0[3]);
                    *(float4*)(o + 4) = make_float4(x0[4], x0[5], x0[6], x0[7]);
                }
            }
        }
    }
    if (!units_first) { for (int u = blockIdx.x; u < 2048; u += gridDim.x) hgrn_prep_unit(p, l, u, lds); }
    for (int r = NP + blockIdx.x; r < NR; r += gridDim.x) {
        const bool prompt = false;
        const int t = r & (SEQ - 1), b = r >> 11, s = r - NP;
        const u16* Ur = U + (size_t)r * DINP;
        if (tid < 64) {
            const int c0 = tid * 8;
            float pv[3][8];
#pragma unroll
            for (int j = 0; j < 3; ++j) {
                const int back = 2 - j;
                if (prompt ? (t - back >= 0) : (back == 0)) {
                    const u16* Uq = Ur - (size_t)back * DINP;
                    const uint4 vh = *(const uint4*)(Uq + c0), vc = *(const uint4*)(Uq + 1024 + c0);
                    float fh[8], fc[8]; UNPACK8(vh, fh); UNPACK8(vc, fc);
#pragma unroll
                    for (int i = 0; i < 8; ++i) pv[j][i] = fc[i] * fh[i];
                } else if (prompt) {
#pragma unroll
                    for (int i = 0; i < 8; ++i) pv[j][i] = 0.f;
                } else {
                    const float* st = p.in[I_SCA] + (((size_t)l * NS + s) * 2 + j) * 512 + c0;
                    const float4 a = *(const float4*)st, bb = *(const float4*)(st + 4);
                    pv[j][0] = a.x; pv[j][1] = a.y; pv[j][2] = a.z; pv[j][3] = a.w; pv[j][4] = bb.x; pv[j][5] = bb.y; pv[j][6] = bb.z; pv[j][7] = bb.w;
                }
            }
            const float* cw = p.in[I_CAW] + (size_t)l * 3 * 512 + c0;
            const uint4 vb = *(const uint4*)(Ur + 512 + c0), vz = *(const uint4*)(Ur + 1536 + c0);
            float fb[8], fz[8]; UNPACK8(vb, fb); UNPACK8(vz, fz);
            float y[8];
#pragma unroll
            for (int i = 0; i < 8; ++i) {
                const float cv = cw[i] * pv[0][i] + cw[512 + i] * pv[1][i] + cw[1024 + i] * pv[2][i];
                y[i] = fb[i] * cv * siluf_(fz[i]);
            }
            *(uint4*)(Ycat + (size_t)r * 2048 + c0) = make_uint4(pack2(y[0], y[1]), pack2(y[2], y[3]), pack2(y[4], y[5]), pack2(y[6], y[7]));
            if (prompt) {
                if (t >= SEQ - 2) {
                    float* o = p.out + O_CAP + (((size_t)l * 8 + b) * 2 + (t - (SEQ - 2))) * 512 + c0;
                    *(float4*)o = make_float4(pv[2][0], pv[2][1], pv[2][2], pv[2][3]);
                    *(float4*)(o + 4) = make_float4(pv[2][4], pv[2][5], pv[2][6], pv[2][7]);
                }
            } else {
                float* o = p.out + O_CAS + (((size_t)l * NS + s) * 2) * 512 + c0;
                *(float4*)o = make_float4(pv[1][0], pv[1][1], pv[1][2], pv[1][3]);
                *(float4*)(o + 4) = make_float4(pv[1][4], pv[1][5], pv[1][6], pv[1][7]);
                *(float4*)(o + 512) = make_float4(pv[2][0], pv[2][1], pv[2][2], pv[2][3]);
                *(float4*)(o + 516) = make_float4(pv[2][4], pv[2][5], pv[2][6], pv[2][7]);
            }
        } else {
            const int c0 = (tid - 64) * 8;
            float xv[4][8];
#pragma unroll
            for (int j = 0; j < 4; ++j) {
                const int back = 3 - j;
                if (prompt ? (t - back >= 0) : (back == 0)) {
                    const uint4 v = *(const uint4*)(Ur - (size_t)back * DINP + 5120 + c0);
                    UNPACK8(v, xv[j]);
                } else if (prompt) {
#pragma unroll
                    for (int i = 0; i < 8; ++i) xv[j][i] = 0.f;
                } else {
                    const float* st = p.in[I_SSC] + (((size_t)l * NS + s) * 3 + j) * 1536 + c0;
                    const float4 a = *(const float4*)st, bb = *(const float4*)(st + 4);
                    xv[j][0] = a.x; xv[j][1] = a.y; xv[j][2] = a.z; xv[j][3] = a.w; xv[j][4] = bb.x; xv[j][5] = bb.y; xv[j][6] = bb.z; xv[j][7] = bb.w;
                }
            }
            const float* cw = p.in[I_SCW] + (size_t)l * 4 * 1536 + c0;
            const float* cb = p.in[I_SCB] + (size_t)l * 1536 + c0;
            float y[8];
#pragma unroll
            for (int i = 0; i < 8; ++i) {
                const float cv = cw[i] * xv[0][i] + cw[1536 + i] * xv[1][i] + cw[3072 + i] * xv[2][i] + cw[4608 + i] * xv[3][i] + cb[i];
                y[i] = siluf_(cv);
            }
            if (!prompt) {
                float* xo = XBC + (size_t)r * 1536 + c0;
                *(float4*)xo = make_float4(y[0], y[1], y[2], y[3]);
                *(float4*)(xo + 4) = make_float4(y[4], y[5], y[6], y[7]);
            }
            *(uint4*)((u16*)(p.ws + OFF_XBCB) + (size_t)r * 1536 + c0) = make_uint4(pack2(y[0], y[1]), pack2(y[2], y[3]), pack2(y[4], y[5]), pack2(y[6], y[7]));
            if (prompt) {
                if (t >= SEQ - 3) {
                    float* o = p.out + O_SCP + (((size_t)l * 8 + b) * 3 + (t - (SEQ - 3))) * 1536 + c0;
                    *(float4*)o = make_float4(xv[3][0], xv[3][1], xv[3][2], xv[3][3]);
                    *(float4*)(o + 4) = make_float4(xv[3][4], xv[3][5], xv[3][6], xv[3][7]);
                }
            } else {
                float* o = p.out + O_SCS + (((size_t)l * NS + s) * 3) * 1536 + c0;
#pragma unroll
                for (int j = 0; j < 3; ++j) {
                    *(float4*)(o + j * 1536) = make_float4(xv[j + 1][0], xv[j + 1][1], xv[j + 1][2], xv[j + 1][3]);
                    *(float4*)(o + j * 1536 + 4) = make_float4(xv[j + 1][4], xv[j + 1][5], xv[j + 1][6], xv[j + 1][7]);
                }
            }
        }
        if (tid < 16) {
            const float xx = bf2f(Ur[6656 + tid]) + p.in[I_DTB][l * 16 + tid];
            DT[(size_t)r * 16 + tid] = xx > 20.f ? xx : log1pf(__expf(xx));
        }
    }
}


DEVINL void hgrn_prompt_item(const Params& p, int l, int item, char* lds) {
    const int b = item >> 5, h = (item >> 3) & 3, vs = item & 7;
    const int tid = threadIdx.x, lane = tid & 63, wave = tid >> 6;
    const int vl = wave * 4 + (lane >> 4), kg = lane & 15;
    float* fS = (float*)lds;
    float* qS = fS + 2048;
    float* vS = qS + 2048;
    float* part = vS + 256;
    const u16* U = (const u16*)(p.ws + OFF_U);
    float* OB = (float*)(p.ws + OFF_OB);
    const int tl = tid >> 4, kc = (tid & 15) * 8, vi = tid & 15;
    float lbv[8];
#pragma unroll
    for (int j = 0; j < 8; ++j) lbv[j] = hgrn_lb(p, l, h * 128 + kc + j);
    const size_t rowb = (size_t)b * SEQ;
    const u16* Uq = U + (rowb + tl) * DINP + 2048 + h * 128 + kc;
    const u16* Uv = U + (rowb + tl) * DINP + 3072 + h * 128 + vs * 16 + vi;
    float S[8];
#pragma unroll
    for (int i = 0; i < 8; ++i) S[i] = 0.f;
    uint4 rq = *(const uint4*)Uq, rf = *(const uint4*)(Uq + 512);
    u16 rv = *Uv;
    for (int c = 0; c < SEQ / 16; ++c) {
        {
            float q[8], g[8]; UNPACK8(rq, q); UNPACK8(rf, g);
#pragma unroll
            for (int j = 0; j < 8; ++j) g[j] = lbv[j] + (1.0f - lbv[j]) * sigmoidf_(g[j]);
            *(float4*)(qS + tl * 128 + kc) = make_float4(q[0], q[1], q[2], q[3]);
            *(float4*)(qS + tl * 128 + kc + 4) = make_float4(q[4], q[5], q[6], q[7]);
            *(float4*)(fS + tl * 128 + kc) = make_float4(g[0], g[1], g[2], g[3]);
            *(float4*)(fS + tl * 128 + kc + 4) = make_float4(g[4], g[5], g[6], g[7]);
            vS[tl * 16 + vi] = bf2f(rv);
        }
        if (c + 1 < SEQ / 16) {
            const size_t adv = (size_t)(c + 1) * 16 * DINP;
            rq = *(const uint4*)(Uq + adv); rf = *(const uint4*)(Uq + adv + 512); rv = *(Uv + adv);
        }
        __syncthreads();
#pragma unroll 1
        for (int tg = 0; tg < 16; tg += 4) {
        float pa[4];
#pragma unroll
        for (int tt = 0; tt < 4; ++tt) {
            const int t = tg + tt;
            const float4 f0 = *(const float4*)(fS + t * 128 + kg * 4), f1 = *(const float4*)(fS + t * 128 + 64 + kg * 4);
            const float4 q0 = *(const float4*)(qS + t * 128 + kg * 4), q1 = *(const float4*)(qS + t * 128 + 64 + kg * 4);
            const float vv = vS[t * 16 + vl];
            S[0] = f0.x * S[0] + (1.f - f0.x) * vv; S[1] = f0.y * S[1] + (1.f - f0.y) * vv;
            S[2] = f0.z * S[2] + (1.f - f0.z) * vv; S[3] = f0.w * S[3] + (1.f - f0.w) * vv;
            S[4] = f1.x * S[4] + (1.f - f1.x) * vv; S[5] = f1.y * S[5] + (1.f - f1.y) * vv;
            S[6] = f1.z * S[6] + (1.f - f1.z) * vv; S[7] = f1.w * S[7] + (1.f - f1.w) * vv;
            float a = q0.x * S[0] + q0.y * S[1] + q0.z * S[2] + q0.w * S[3];
            a += q1.x * S[4] + q1.y * S[5] + q1.z * S[6] + q1.w * S[7];
            pa[tt] = a;
        }
#pragma unroll
        for (int tt = 0; tt < 4; ++tt) part[(tg + tt) * 256 + vl * 16 + kg] = pa[tt];
        }
        __syncthreads();
        {
            const float* pp = part + tl * 256 + vi * 16;
            const float4 a = *(const float4*)pp, bq = *(const float4*)(pp + 4), cq = *(const float4*)(pp + 8), dq = *(const float4*)(pp + 12);
            const float o = (a.x + a.y + a.z + a.w) + (bq.x + bq.y + bq.z + bq.w) + (cq.x + cq.y + cq.z + cq.w) + (dq.x + dq.y + dq.z + dq.w);
            OB[(rowb + c * 16 + tl) * 512 + h * 128 + vs * 16 + vi] = o;
        }
    }
    float* so = p.out + O_HGP + (((size_t)l * 8 + b) * 4 + h) * 128 * 128;
#pragma unroll
    for (int i = 0; i < 4; ++i) {
        so[(size_t)(kg * 4 + i) * 128 + vs * 16 + vl] = S[i];
        so[(size_t)(64 + kg * 4 + i) * 128 + vs * 16 + vl] = S[4 + i];
    }
    __syncthreads();
}

DEVINL void ssd_prompt_item(const Params& p, int l, int item, char* lds) {
    const int b = item >> 5, head = (item >> 1) & 15, ph = item & 1, g = head >> 3;
    const int tid = threadIdx.x;
    const int pl = tid >> 3, ng = tid & 7;
    float* Bs = (float*)lds;
    float* Cs = Bs + 2048;
    float* xs = Cs + 2048;
    float* xd = xs + 512;
    float* dcs = xd + 512;
    float* part = dcs + 64;
    const float* XBC = (const float*)(p.ws + OFF_XBC);
    const float* DT = (const float*)(p.ws + OFF_DT);
    const u16* U = (const u16*)(p.ws + OFF_U);
    float* YC = (float*)(p.ws + OFF_YC);
    const float Aneg = -__expf(p.in[I_ALOG][l * 16 + head]);
    const float Dsk = p.in[I_DSK][l * 16 + head];
    const int tl = tid >> 4, nc = (tid & 15) * 8, xc = (tid & 15) * 2;
    const size_t rowb = (size_t)b * SEQ;
    const float* pB = XBC + (rowb + tl) * 1536 + 1024 + g * 128 + nc;
    const float* pX = XBC + (rowb + tl) * 1536 + head * 64 + ph * 32 + xc;
    const float* pD = DT + (rowb + tl) * 16 + head;
    float S[16];
#pragma unroll
    for (int i = 0; i < 16; ++i) S[i] = 0.f;
    float4 rb0 = *(const float4*)pB, rb1 = *(const float4*)(pB + 4), rc0 = *(const float4*)(pB + 256), rc1 = *(const float4*)(pB + 260);
    float2 rx = *(const float2*)pX;
    float rd = *pD;
    for (int c = 0; c < SEQ / 16; ++c) {
        *(float4*)(Bs + tl * 128 + nc) = rb0; *(float4*)(Bs + tl * 128 + nc + 4) = rb1;
        *(float4*)(Cs + tl * 128 + nc) = rc0; *(float4*)(Cs + tl * 128 + nc + 4) = rc1;
        xs[tl * 32 + xc] = rx.x; xs[tl * 32 + xc + 1] = rx.y;
        xd[tl * 32 + xc] = rx.x * rd; xd[tl * 32 + xc + 1] = rx.y * rd;
        if ((tid & 15) == 0) dcs[tl] = __expf(rd * Aneg);
        if (c + 1 < SEQ / 16) {
            const size_t adv = (size_t)(c + 1) * 16;
            const float* qB = pB + adv * 1536;
            rb0 = *(const float4*)qB; rb1 = *(const float4*)(qB + 4); rc0 = *(const float4*)(qB + 256); rc1 = *(const float4*)(qB + 260);
            rx = *(const float2*)(pX + adv * 1536);
            rd = *(pD + adv * 16);
        }
        __syncthreads();
#pragma unroll 1
        for (int tg = 0; tg < 16; tg += 4) {
        float pa[4];
#pragma unroll
        for (int tt = 0; tt < 4; ++tt) {
            const int t = tg + tt;
            const float dec = dcs[t], xdt = xd[t * 32 + pl];
            float a = 0.f;
#pragma unroll
            for (int j = 0; j < 4; ++j) {
                const float4 Bv = *(const float4*)(Bs + t * 128 + j * 32 + ng * 4);
                const float4 Cv = *(const float4*)(Cs + t * 128 + j * 32 + ng * 4);
                S[j * 4 + 0] = dec * S[j * 4 + 0] + xdt * Bv.x; S[j * 4 + 1] = dec * S[j * 4 + 1] + xdt * Bv.y;
                S[j * 4 + 2] = dec * S[j * 4 + 2] + xdt * Bv.z; S[j * 4 + 3] = dec * S[j * 4 + 3] + xdt * Bv.w;
                a += Cv.x * S[j * 4 + 0] + Cv.y * S[j * 4 + 1] + Cv.z * S[j * 4 + 2] + Cv.w * S[j * 4 + 3];
            }
            pa[tt] = a;
        }
#pragma unroll
        for (int tt = 0; tt < 4; ++tt) part[(tg + tt) * 256 + tid] = pa[tt];
        }
        __syncthreads();
#pragma unroll
        for (int i = 0; i < 2; ++i) {
            const int idx = tid + 256 * i, t2 = idx >> 5, p2 = idx & 31;
            const float4 a = *(const float4*)(part + t2 * 256 + p2 * 8), bq = *(const float4*)(part + t2 * 256 + p2 * 8 + 4);
            const float y = (a.x + a.y + a.z + a.w) + (bq.x + bq.y + bq.z + bq.w) + Dsk * xs[t2 * 32 + p2];
            const size_t row = rowb + c * 16 + t2;
            const float z = bf2f(U[row * DINP + 4096 + head * 64 + ph * 32 + p2]);
            YC[row * 1024 + head * 64 + ph * 32 + p2] = y * siluf_(z);
        }
        __syncthreads();
    }
    float* so = p.out + O_SSP + ((((size_t)l * 8 + b) * 16 + head) * 64 + ph * 32 + pl) * 128;
#pragma unroll
    for (int j = 0; j < 4; ++j) *(float4*)(so + j * 32 + ng * 4) = make_float4(S[j * 4], S[j * 4 + 1], S[j * 4 + 2], S[j * 4 + 3]);
}

DEVINL void hgrn_sample_item(const Params& p, int l, int item, char* lds) {
    const int s = item >> 2, h = item & 3;
    const int tid = threadIdx.x;
    float* qs = (float*)lds; float* fs = qs + 128; float* vs = fs + 128; float* red = vs + 128;
    const u16* Ur = (const u16*)(p.ws + OFF_U) + (size_t)(NP + s) * DINP;
    if (tid < 128) {
        qs[tid] = bf2f(Ur[2048 + h * 128 + tid]);
        const float lb = hgrn_lb(p, l, h * 128 + tid);
        fs[tid] = lb + (1.f - lb) * sigmoidf_(bf2f(Ur[2560 + h * 128 + tid]));
        vs[tid] = bf2f(Ur[3072 + h * 128 + tid]);
    }
    __syncthreads();
    const int v4 = (tid & 31) * 4, kr = tid >> 5;
    const size_t sb = (((size_t)l * NS + s) * 4 + h) * 128 * 128;
    const float* Sin = p.in[I_SHG] + sb;
    float* Sout = p.out + O_HGS + sb;
    const float4 vv = *(const float4*)(vs + v4);
    float4 acc = make_float4(0.f, 0.f, 0.f, 0.f);
#pragma unroll 1
    for (int hb = 0; hb < 2; ++hb) {
        float4 so[8];
#pragma unroll
        for (int i = 0; i < 8; ++i) so[i] = *(const float4*)(Sin + (size_t)(kr + 8 * (hb * 8 + i)) * 128 + v4);
#pragma unroll
        for (int i = 0; i < 8; ++i) {
            const int k = kr + 8 * (hb * 8 + i);
            const float f = fs[k], kk = 1.f - f, q = qs[k];
            float4 sn;
            sn.x = f * so[i].x + kk * vv.x; sn.y = f * so[i].y + kk * vv.y; sn.z = f * so[i].z + kk * vv.z; sn.w = f * so[i].w + kk * vv.w;
            *(float4*)(Sout + (size_t)k * 128 + v4) = sn;
            acc.x += q * sn.x; acc.y += q * sn.y; acc.z += q * sn.z; acc.w += q * sn.w;
        }
    }
    *(float4*)(red + kr * 128 + v4) = acc;
    __syncthreads();
    if (tid < 128) {
        float o = 0.f;
#pragma unroll
        for (int i = 0; i < 8; ++i) o += red[i * 128 + tid];
        ((u16*)(p.ws + OFF_OB))[(size_t)(NP + s) * 512 + h * 128 + tid] = (u16)f2bf(o);
    }
    __syncthreads();
}

DEVINL void ssd_sample_item(const Params& p, int l, int item) {
    const int s = item >> 4, head = item & 15, g = head >> 3;
    const int tid = threadIdx.x;
    const size_t row = NP + s;
    const float* xr = (const float*)(p.ws + OFF_XBC) + row * 1536;
    const float dt = ((const float*)(p.ws + OFF_DT))[row * 16 + head];
    const float dec = __expf(-__expf(p.in[I_ALOG][l * 16 + head]) * dt);
    const float Dsk = p.in[I_DSK][l * 16 + head];
    const int n4 = (tid & 31) * 4, pr = tid >> 5;
    const float4 Bv = *(const float4*)(xr + 1024 + g * 128 + n4), Cv = *(const float4*)(xr + 1280 + g * 128 + n4);
    const size_t sb = (((size_t)l * NS + s) * 16 + head) * 64 * 128;
    const float* Sin = p.in[I_SSS] + sb;
    float* Sout = p.out + O_SSS + sb;
    const u16* Ur = (const u16*)(p.ws + OFF_U) + row * DINP;
    u16* YC = (u16*)(p.ws + OFF_YC);
    float4 so[8];
#pragma unroll
    for (int i = 0; i < 8; ++i) so[i] = *(const float4*)(Sin + (size_t)(pr + 8 * i) * 128 + n4);
#pragma unroll
    for (int i = 0; i < 8; ++i) {
        const int pp = pr + 8 * i;
        const float x = xr[head * 64 + pp], xdt = x * dt;
        float4 sn;
        sn.x = dec * so[i].x + xdt * Bv.x; sn.y = dec * so[i].y + xdt * Bv.y; sn.z = dec * so[i].z + xdt * Bv.z; sn.w = dec * so[i].w + xdt * Bv.w;
        *(float4*)(Sout + (size_t)pp * 128 + n4) = sn;
        float a = Cv.x * sn.x + Cv.y * sn.y + Cv.z * sn.z + Cv.w * sn.w;
#pragma unroll
        for (int o = 16; o; o >>= 1) a += __shfl_xor(a, o);
        if ((tid & 31) == 0) {
            const float y = a + Dsk * x;
            const float z = bf2f(Ur[4096 + head * 64 + pp]);
            YC[row * 1024 + head * 64 + pp] = (u16)f2bf(y * siluf_(z));
        }
    }
}


DEVINL bf16x8 ldfrag(const u16* base, int ld, int row, int k) { return *(const bf16x8*)(base + row * ld + k); }
DEVINL void st4bf(u16* dst, float a, float b, float c, float d) { *(uint2*)dst = make_uint2(pack2(a, b), pack2(c, d)); }

DEVINL void ssd_prompt_mfma(const Params& p, int l, int item, char* lds) {
    const int b = item >> 5, head = (item >> 1) & 15, ph = item & 1, g = head >> 3;
    const int tid = threadIdx.x, lane = tid & 63, w = tid >> 6, fr = lane & 15, fq = lane >> 4;
    u16* Cs = (u16*)lds;
    u16* Bs = Cs + 32 * 136;
    u16* Sb = Bs + 32 * 136;
    u16* BT = Sb + 32 * 136;
    u16* XT = BT + 128 * 40;
    u16* XW = XT + 32 * 40;
    u16* Ms = XW + 32 * 40;
    float* csS = (float*)(Ms + 32 * 40);
    float* dtS = csS + 32;
    const u16* XB = (const u16*)(p.ws + OFF_XBCB);
    const float* DT = (const float*)(p.ws + OFF_DT);
    const u16* U = (const u16*)(p.ws + OFF_U);
    u16* YC = (u16*)(p.ws + OFF_YC);
    const float Aneg = -__expf(p.in[I_ALOG][l * 16 + head]);
    const float Dsk = p.in[I_DSK][l * 16 + head];
    const size_t rowb = (size_t)b * SEQ;
    const int srow = tid >> 3, sc = tid & 7;
    const int ti = w >> 1, pi = w & 1;
    for (int i = tid; i < 32 * 136 / 2; i += 256) ((uint32_t*)Sb)[i] = 0u;
    f32x4 Sacc[2][2];
#pragma unroll
    for (int a = 0; a < 2; ++a)
#pragma unroll
        for (int c = 0; c < 2; ++c) Sacc[a][c] = (f32x4){0.f, 0.f, 0.f, 0.f};
    const u16* pC = XB + (rowb + srow) * 1536 + 1280 + g * 128 + sc * 16;
    const u16* pB = XB + (rowb + srow) * 1536 + 1024 + g * 128 + sc * 16;
    const u16* pX = XB + (rowb + srow) * 1536 + head * 64 + ph * 32 + sc * 4;
    const float* pD = DT + (rowb + (lane & 31)) * 16 + head;
    const u16* pZ = U + (rowb + ti * 16 + fr) * DINP + 4096 + head * 64 + ph * 32 + pi * 16 + fq * 4;
    const u16* pXs = XB + (rowb + ti * 16 + fr) * 1536 + head * 64 + ph * 32 + pi * 16 + fq * 4;
#define SSD_LD(S, CC) do { const size_t adv = (size_t)(CC) * 32; \
        S##C0 = *(const uint4*)(pC + adv * 1536); S##C1 = *(const uint4*)(pC + adv * 1536 + 8); \
        S##B0 = *(const uint4*)(pB + adv * 1536); S##B1 = *(const uint4*)(pB + adv * 1536 + 8); \
        S##x = *(const uint2*)(pX + adv * 1536); S##z = *(const uint2*)(pZ + adv * DINP); S##xs = *(const uint2*)(pXs + adv * 1536); \
        S##dt = *(pD + adv * 16); } while (0)
    uint4 aC0, aC1, aB0, aB1, bC0, bC1, bB0, bB1; uint2 ax, az, axs, bx, bz, bxs; float adt, bdt;
    SSD_LD(a, 0); SSD_LD(b, 1);
    auto stage = [&](uint4 rC0, uint4 rC1, uint4 rB0, uint4 rB1, float rdt) __attribute__((always_inline)) {
        *(uint4*)(Cs + srow * 136 + sc * 16) = rC0; *(uint4*)(Cs + srow * 136 + sc * 16 + 8) = rC1;
        *(uint4*)(Bs + srow * 136 + sc * 16) = rB0; *(uint4*)(Bs + srow * 136 + sc * 16 + 8) = rB1;
        {
            const uint32_t bw[8] = {rB0.x, rB0.y, rB0.z, rB0.w, rB1.x, rB1.y, rB1.z, rB1.w};
#pragma unroll
            for (int j = 0; j < 8; ++j) {
                BT[(sc * 16 + 2 * j) * 40 + srow] = (u16)(bw[j] & 0xffffu);
                BT[(sc * 16 + 2 * j + 1) * 40 + srow] = (u16)(bw[j] >> 16);
            }
        }
        if (w == 0) {
            float a = rdt * Aneg;
#pragma unroll
            for (int o = 1; o < 32; o <<= 1) { const float v = __shfl_up(a, o); if ((lane & 31) >= o) a += v; }
            if (lane < 32) { csS[lane] = a; dtS[lane] = rdt; }
        }
    };
    auto rest = [&](int c, uint2 cx, uint2 cz, uint2 cxs) __attribute__((always_inline)) {
        lds_barrier();
        const float cs31 = csS[31];
        {
            const float wgt = dtS[srow] * __expf(cs31 - csS[srow]);
            const float x0 = lo16(cx.x), x1 = hi16(cx.x), x2 = lo16(cx.y), x3 = hi16(cx.y);
            XT[(sc * 4 + 0) * 40 + srow] = (u16)(cx.x & 0xffffu); XT[(sc * 4 + 1) * 40 + srow] = (u16)(cx.x >> 16);
            XT[(sc * 4 + 2) * 40 + srow] = (u16)(cx.y & 0xffffu); XT[(sc * 4 + 3) * 40 + srow] = (u16)(cx.y >> 16);
            XW[(sc * 4 + 0) * 40 + srow] = (u16)f2bf(x0 * wgt); XW[(sc * 4 + 1) * 40 + srow] = (u16)f2bf(x1 * wgt);
            XW[(sc * 4 + 2) * 40 + srow] = (u16)f2bf(x2 * wgt); XW[(sc * 4 + 3) * 40 + srow] = (u16)f2bf(x3 * wgt);
        }
        {
            const int t = ti * 16 + fr, s0 = pi * 16 + fq * 4;
            if (pi <= ti) {
                f32x4 acc = (f32x4){0.f, 0.f, 0.f, 0.f};
#pragma unroll
                for (int ks = 0; ks < 4; ++ks)
                    acc = __builtin_amdgcn_mfma_f32_16x16x32_bf16(ldfrag(Bs, 136, pi * 16 + fr, ks * 32 + fq * 8), ldfrag(Cs, 136, ti * 16 + fr, ks * 32 + fq * 8), acc, 0, 0, 0);
                const float cst = csS[t];
                float m[4];
#pragma unroll
                for (int r = 0; r < 4; ++r) { const int s = s0 + r; m[r] = (s <= t) ? acc[r] * __expf(cst - csS[s]) * dtS[s] : 0.f; }
                st4bf(Ms + t * 40 + s0, m[0], m[1], m[2], m[3]);
            } else {
                *(uint2*)(Ms + t * 40 + s0) = make_uint2(0u, 0u);
            }
        }
        lds_barrier();
        {
            f32x4 ad = __builtin_amdgcn_mfma_f32_16x16x32_bf16(ldfrag(XT, 40, pi * 16 + fr, fq * 8), ldfrag(Ms, 40, ti * 16 + fr, fq * 8), (f32x4){0.f, 0.f, 0.f, 0.f}, 0, 0, 0);
            f32x4 ao = (f32x4){0.f, 0.f, 0.f, 0.f};
#pragma unroll
            for (int ks = 0; ks < 4; ++ks)
                ao = __builtin_amdgcn_mfma_f32_16x16x32_bf16(ldfrag(Sb, 136, pi * 16 + fr, ks * 32 + fq * 8), ldfrag(Cs, 136, ti * 16 + fr, ks * 32 + fq * 8), ao, 0, 0, 0);
            const int t = ti * 16 + fr;
            const float e = __expf(csS[t]);
            const float xs0 = lo16(cxs.x), xs1 = hi16(cxs.x), xs2 = lo16(cxs.y), xs3 = hi16(cxs.y);
            const float z0 = lo16(cz.x), z1 = hi16(cz.x), z2 = lo16(cz.y), z3 = hi16(cz.y);
            float4 y;
            y.x = (ad[0] + e * ao[0] + Dsk * xs0) * siluf_(z0);
            y.y = (ad[1] + e * ao[1] + Dsk * xs1) * siluf_(z1);
            y.z = (ad[2] + e * ao[2] + Dsk * xs2) * siluf_(z2);
            y.w = (ad[3] + e * ao[3] + Dsk * xs3) * siluf_(z3);
            *(uint2*)(YC + (rowb + (size_t)c * 32 + t) * 1024 + head * 64 + ph * 32 + pi * 16 + fq * 4) = make_uint2(pack2(y.x, y.y), pack2(y.z, y.w));
        }
        {
            const float e31 = __expf(cs31);
#pragma unroll
            for (int a = 0; a < 2; ++a) {
                const bf16x8 bt = ldfrag(BT, 40, (2 * w + a) * 16 + fr, fq * 8);
#pragma unroll
                for (int pt = 0; pt < 2; ++pt) {
                    f32x4 s = Sacc[a][pt];
                    s[0] *= e31; s[1] *= e31; s[2] *= e31; s[3] *= e31;
                    Sacc[a][pt] = __builtin_amdgcn_mfma_f32_16x16x32_bf16(bt, ldfrag(XW, 40, pt * 16 + fr, fq * 8), s, 0, 0, 0);
                }
            }
        }
        lds_barrier();
#pragma unroll
        for (int a = 0; a < 2; ++a)
#pragma unroll
            for (int pt = 0; pt < 2; ++pt)
                st4bf(Sb + (pt * 16 + fr) * 136 + (2 * w + a) * 16 + fq * 4, Sacc[a][pt][0], Sacc[a][pt][1], Sacc[a][pt][2], Sacc[a][pt][3]);
    };
#pragma unroll 1
    for (int c = 0; c < SEQ / 32; c += 2) {
        { stage(aC0, aC1, aB0, aB1, adt); const uint2 cx = ax, cz = az, cxs = axs; if (c + 2 < SEQ / 32) SSD_LD(a, c + 2); rest(c, cx, cz, cxs); }
        { stage(bC0, bC1, bB0, bB1, bdt); const uint2 cx = bx, cz = bz, cxs = bxs; if (c + 3 < SEQ / 32) SSD_LD(b, c + 3); rest(c + 1, cx, cz, cxs); }
    }
#undef SSD_LD
    float* so = p.out + O_SSP + ((((size_t)l * 8 + b) * 16 + head) * 64 + ph * 32) * 128;
#pragma unroll
    for (int a = 0; a < 2; ++a)
#pragma unroll
        for (int pt = 0; pt < 2; ++pt)
            *(float4*)(so + (size_t)(pt * 16 + fr) * 128 + (2 * w + a) * 16 + fq * 4) = make_float4(Sacc[a][pt][0], Sacc[a][pt][1], Sacc[a][pt][2], Sacc[a][pt][3]);
    __syncthreads();
}

DEVINL void hgrn_prompt_mfma(const Params& p, int l, int item, char* lds) {
    const int b = item >> 4, h = (item >> 2) & 3, vq = item & 3;
    const int tid = threadIdx.x, lane = tid & 63, w = tid >> 6, fr = lane & 15, fq = lane >> 4;
    u16* Qg = (u16*)lds;
    u16* Qm = Qg + 32 * 136;
    u16* Km = Qm + 32 * 136;
    u16* ST = Km + 32 * 136;
    u16* KdT = ST + 32 * 136;
    u16* VT = KdT + 128 * 40;
    u16* As = VT + 32 * 40;
    float* dS = (float*)(As + 32 * 40);
    const u16* U = (const u16*)(p.ws + OFF_U);
    u16* OB = (u16*)(p.ws + OFF_OB);
    const size_t rowb = (size_t)b * SEQ;
    const size_t u0 = (size_t)(b * 4 + h) * 64;
    const u16* gQG = (const u16*)(p.ws + OFF_HQG) + u0 * 4096;
    const u16* gQM = (const u16*)(p.ws + OFF_HQM) + u0 * 4096;
    const u16* gKM = (const u16*)(p.ws + OFF_HKM) + u0 * 4096;
    const u16* gKD = (const u16*)(p.ws + OFF_HKD) + u0 * 4096;
    const float* gDS = (const float*)(p.ws + OFF_HDS) + u0 * 128;
    const int vrow = tid >> 3, v4 = (tid & 7) * 4;
    const int ti = w >> 1, ji = w & 1;
    const int r0 = tid >> 4, c0 = (tid & 15) * 8;
    const int k0 = tid >> 2, p0 = (tid & 3) * 8;
    for (int i = tid; i < 32 * 136 / 2; i += 256) ((uint32_t*)ST)[i] = 0u;
    f32x4 Sacc[2][2];
#pragma unroll
    for (int a = 0; a < 2; ++a)
#pragma unroll
        for (int c = 0; c < 2; ++c) Sacc[a][c] = (f32x4){0.f, 0.f, 0.f, 0.f};
    const u16* pV = U + (rowb + vrow) * DINP + 3072 + h * 128 + vq * 32 + v4;
    const int gi0 = r0 * 128 + c0, gi1 = (r0 + 16) * 128 + c0, gk0 = k0 * 32 + p0, gk1 = (k0 + 64) * 32 + p0;
    const int li0 = r0 * 136 + c0, li1 = (r0 + 16) * 136 + c0, lk0 = k0 * 40 + p0, lk1 = (k0 + 64) * 40 + p0;
#define HG_LD(S, CC) do { const size_t au = (size_t)(CC) * 4096; \
        S##g0 = *(const uint4*)(gQG + au + gi0); S##g1 = *(const uint4*)(gQG + au + gi1); S##m0 = *(const uint4*)(gQM + au + gi0); S##m1 = *(const uint4*)(gQM + au + gi1); \
        S##k0 = *(const uint4*)(gKM + au + gi0); S##k1 = *(const uint4*)(gKM + au + gi1); S##d0 = *(const uint4*)(gKD + au + gk0); S##d1 = *(const uint4*)(gKD + au + gk1); \
        S##ds = *(const float4*)(gDS + (size_t)(CC) * 128 + (tid & 31) * 4); S##v = *(const uint2*)(pV + (size_t)(CC) * 32 * DINP); } while (0)
    uint4 ag0, ag1, am0, am1, ak0, ak1, ad0, ad1, bg0, bg1, bm0, bm1, bk0, bk1, bd0, bd1; float4 ads, bds; uint2 av, bv;
    HG_LD(a, 0); HG_LD(b, 1);
    auto stage = [&](uint4 g0, uint4 g1, uint4 m0, uint4 m1, uint4 kk0, uint4 kk1, uint4 d0, uint4 d1, float4 ds, uint2 rv) __attribute__((always_inline)) {
        *(uint4*)(Qg + li0) = g0; *(uint4*)(Qg + li1) = g1; *(uint4*)(Qm + li0) = m0; *(uint4*)(Qm + li1) = m1;
        *(uint4*)(Km + li0) = kk0; *(uint4*)(Km + li1) = kk1; *(uint4*)(KdT + lk0) = d0; *(uint4*)(KdT + lk1) = d1;
        if (tid < 32) *(float4*)(dS + tid * 4) = ds;
        VT[(v4 + 0) * 40 + vrow] = (u16)(rv.x & 0xffffu); VT[(v4 + 1) * 40 + vrow] = (u16)(rv.x >> 16);
        VT[(v4 + 2) * 40 + vrow] = (u16)(rv.y & 0xffffu); VT[(v4 + 3) * 40 + vrow] = (u16)(rv.y >> 16);
    };
    auto rest = [&](int c) __attribute__((always_inline)) {
        lds_barrier();
        {
            const int t = ti * 16 + fr, j0 = ji * 16 + fq * 4;
            if (ji <= ti) {
                f32x4 acc = (f32x4){0.f, 0.f, 0.f, 0.f};
#pragma unroll
                for (int ks = 0; ks < 4; ++ks)
                    acc = __builtin_amdgcn_mfma_f32_16x16x32_bf16(ldfrag(Km, 136, ji * 16 + fr, ks * 32 + fq * 8), ldfrag(Qm, 136, ti * 16 + fr, ks * 32 + fq * 8), acc, 0, 0, 0);
                st4bf(As + t * 40 + j0, (j0 + 0 <= t) ? acc[0] : 0.f, (j0 + 1 <= t) ? acc[1] : 0.f, (j0 + 2 <= t) ? acc[2] : 0.f, (j0 + 3 <= t) ? acc[3] : 0.f);
            } else {
                *(uint2*)(As + t * 40 + j0) = make_uint2(0u, 0u);
            }
        }
        lds_barrier();
        {
            const int vi = ji;
            f32x4 acc = __builtin_amdgcn_mfma_f32_16x16x32_bf16(ldfrag(VT, 40, vi * 16 + fr, fq * 8), ldfrag(As, 40, ti * 16 + fr, fq * 8), (f32x4){0.f, 0.f, 0.f, 0.f}, 0, 0, 0);
#pragma unroll
            for (int ks = 0; ks < 4; ++ks)
                acc = __builtin_amdgcn_mfma_f32_16x16x32_bf16(ldfrag(ST, 136, vi * 16 + fr, ks * 32 + fq * 8), ldfrag(Qg, 136, ti * 16 + fr, ks * 32 + fq * 8), acc, 0, 0, 0);
            *(uint2*)(OB + (rowb + (size_t)c * 32 + ti * 16 + fr) * 512 + h * 128 + vq * 32 + vi * 16 + fq * 4) = make_uint2(pack2(acc[0], acc[1]), pack2(acc[2], acc[3]));
        }
#pragma unroll
        for (int a = 0; a < 2; ++a) {
            const int kt = 2 * w + a;
            const bf16x8 kf = ldfrag(KdT, 40, kt * 16 + fr, fq * 8);
            const float4 dd = *(const float4*)(dS + kt * 16 + fq * 4);
#pragma unroll
            for (int vt = 0; vt < 2; ++vt) {
                f32x4 s = Sacc[a][vt];
                s[0] *= dd.x; s[1] *= dd.y; s[2] *= dd.z; s[3] *= dd.w;
                Sacc[a][vt] = __builtin_amdgcn_mfma_f32_16x16x32_bf16(kf, ldfrag(VT, 40, vt * 16 + fr, fq * 8), s, 0, 0, 0);
            }
        }
        lds_barrier();
#pragma unroll
        for (int a = 0; a < 2; ++a)
#pragma unroll
            for (int vt = 0; vt < 2; ++vt)
                st4bf(ST + (vt * 16 + fr) * 136 + (2 * w + a) * 16 + fq * 4, Sacc[a][vt][0], Sacc[a][vt][1], Sacc[a][vt][2], Sacc[a][vt][3]);
    };
#pragma unroll 1
    for (int c = 0; c < SEQ / 32; c += 2) {
        stage(ag0, ag1, am0, am1, ak0, ak1, ad0, ad1, ads, av); if (c + 2 < SEQ / 32) HG_LD(a, c + 2); rest(c);
        stage(bg0, bg1, bm0, bm1, bk0, bk1, bd0, bd1, bds, bv); if (c + 3 < SEQ / 32) HG_LD(b, c + 3); rest(c + 1);
    }
#undef HG_LD
    float* so = p.out + O_HGP + (((size_t)l * 8 + b) * 4 + h) * 128 * 128;
#pragma unroll
    for (int a = 0; a < 2; ++a)
#pragma unroll
        for (int vt = 0; vt < 2; ++vt)
#pragma unroll
            for (int r = 0; r < 4; ++r)
                so[(size_t)((2 * w + a) * 16 + fq * 4 + r) * 128 + vq * 32 + vt * 16 + fr] = Sacc[a][vt][r];
    __syncthreads();
}

DEVINL int scan_next_item(unsigned* ctr, int* slot) {
    __syncthreads();
    if (threadIdx.x == 0) *slot = (int)gridDim.x + (int)__hip_atomic_fetch_add(ctr, 1u, __ATOMIC_RELAXED, __HIP_MEMORY_SCOPE_AGENT);
    __syncthreads();
    return *slot;
}
DEVINL void phase_scan(const Params& p, int l, char* lds) {
    unsigned* ctr = (unsigned*)(p.ws + OFF_BAR) + 3520 + l * 64;
    __shared__ int nxt_item;
    int it = blockIdx.x;
#pragma unroll 1
    while (it < 256) { ssd_prompt_mfma(p, l, it, lds); it = scan_next_item(ctr, &nxt_item); }
#pragma unroll 1
    while (it < 384) { hgrn_prompt_mfma(p, l, it - 256, lds); it = scan_next_item(ctr, &nxt_item); }
#pragma unroll 1
    while (it < 896) { hgrn_sample_item(p, l, it - 384, lds); it = scan_next_item(ctr, &nxt_item); }
#pragma unroll 1
    while (it < 2944) { ssd_sample_item(p, l, it - 896); it = scan_next_item(ctr, &nxt_item); }
}

DEVINL void phase_mixnorm(const Params& p, int l) {
    const int wave = threadIdx.x >> 6, lane = threadIdx.x & 63;
    const u16* OB = (const u16*)(p.ws + OFF_OB);
    const u16* YC = (const u16*)(p.ws + OFF_YC);
    const u16* U = (const u16*)(p.ws + OFF_U);
    u16* Ycat = (u16*)(p.ws + OFF_YCAT);
    const float* gn = p.in[I_HGN] + (size_t)l * 512;
    const float* sn = p.in[I_SNORM] + (size_t)l * 1024;
    for (int it = blockIdx.x; it < NR / 4; it += gridDim.x) {
        const size_t r = (size_t)it * 4 + wave;
        {
            const uint4 ov = *(const uint4*)(OB + r * 512 + lane * 8);
            float x[8]; UNPACK8(ov, x);
            float ss = 0.f;
#pragma unroll
            for (int i = 0; i < 8; ++i) ss += x[i] * x[i];
            ss += __shfl_xor(ss, 1); ss += __shfl_xor(ss, 2); ss += __shfl_xor(ss, 4); ss += __shfl_xor(ss, 8);
            const float rstd = rsqrtf(ss * (1.0f / 128.0f) + EPS);
            const uint4 zz = *(const uint4*)(U + r * DINP + 3584 + lane * 8);
            float z[8]; UNPACK8(zz, z);
            const float4 g0 = *(const float4*)(gn + lane * 8), g1 = *(const float4*)(gn + lane * 8 + 4);
            const float gg[8] = {g0.x, g0.y, g0.z, g0.w, g1.x, g1.y, g1.z, g1.w};
            float y[8];
#pragma unroll
            for (int i = 0; i < 8; ++i) y[i] = x[i] * rstd * gg[i] * siluf_(z[i]);
            *(uint4*)(Ycat + r * 2048 + 512 + lane * 8) = make_uint4(pack2(y[0], y[1]), pack2(y[2], y[3]), pack2(y[4], y[5]), pack2(y[6], y[7]));
        }
        {
            float x[16];
#pragma unroll
            for (int h = 0; h < 2; ++h) {
                const uint4 yv = *(const uint4*)(YC + r * 1024 + h * 512 + lane * 8);
                x[h * 8 + 0] = lo16(yv.x); x[h * 8 + 1] = hi16(yv.x); x[h * 8 + 2] = lo16(yv.y); x[h * 8 + 3] = hi16(yv.y); x[h * 8 + 4] = lo16(yv.z); x[h * 8 + 5] = hi16(yv.z); x[h * 8 + 6] = lo16(yv.w); x[h * 8 + 7] = hi16(yv.w);
            }
            float ss = 0.f;
#pragma unroll
            for (int i = 0; i < 16; ++i) ss += x[i] * x[i];
            ss = wave_sum(ss);
            const float rstd = rsqrtf(ss * (1.0f / 1024.0f) + EPS);
#pragma unroll
            for (int h = 0; h < 2; ++h) {
                const float4 g0 = *(const float4*)(sn + h * 512 + lane * 8), g1 = *(const float4*)(sn + h * 512 + lane * 8 + 4);
                uint4 o;
                o.x = pack2(x[h * 8 + 0] * rstd * g0.x, x[h * 8 + 1] * rstd * g0.y);
                o.y = pack2(x[h * 8 + 2] * rstd * g0.z, x[h * 8 + 3] * rstd * g0.w);
                o.z = pack2(x[h * 8 + 4] * rstd * g1.x, x[h * 8 + 5] * rstd * g1.y);
                o.w = pack2(x[h * 8 + 6] * rstd * g1.z, x[h * 8 + 7] * rstd * g1.w);
                *(uint4*)(Ycat + r * 2048 + 1024 + h * 512 + lane * 8) = o;
            }
        }
    }
}

DEVINL void phase_rowpass(const Params& p, int l, int which) {
    const int wave = threadIdx.x >> 6, lane = threadIdx.x & 63;
    float* X = (float*)(p.ws + OFF_X);
    const u16* T = (const u16*)(p.ws + OFF_T);
    u16* Hb = (u16*)(p.ws + OFF_HB);
    u16* Mb = (u16*)(p.ws + OFF_MB);
    const bool last = (which == 1 && l == 1);
    const float* gpost = p.in[which == 0 ? I_GQM : I_GQX] + (size_t)l * 1024;
    const float* gnext = which == 0 ? p.in[I_GPX] + (size_t)l * 1024 : (last ? nullptr : p.in[I_GPM] + (size_t)(l + 1) * 1024);
    const int nrows = (which == 1 && !last) ? NR + 2048 : NR;
    for (int it = blockIdx.x; it < nrows / 4; it += gridDim.x) {
        const int r = it * 4 + wave;
        if (r < NR) {
            float* xd = X + (size_t)r * 1024;
            if (last) xd = r < NP ? p.out + O_YP + (size_t)r * 1024 : p.out + O_YS + (size_t)(r - NP) * 1024;
            const float* xb = X + (size_t)r * 1024;
            if (which == 0 && l == 0) xb = r < NP ? p.in[I_XP] + (size_t)r * 1024 : p.in[I_XS] + (size_t)(r - NP) * 1024;
            rowpass_row(xb, T + (size_t)r * 1024, gpost, xd, gnext, Hb + (size_t)r * 1024, lane);
        } else {
            const int m = r - NR;
            rowpass_row(p.in[I_MEM] + (size_t)m * 1024, nullptr, nullptr, nullptr, p.in[I_GMEM] + (size_t)(l + 1) * 1024, Mb + (size_t)m * 1024, lane);
        }
    }
}

DEVINL void attn_prompt_item(const Params& p, int item, char* lds) {
    const int b = item >> 6, h = (item >> 4) & 3, qt = item & 15;
    const int tid = threadIdx.x, lane = tid & 63, wave = tid >> 6;
    const u16* Qt = (const u16*)(p.ws + OFF_Q) + ((size_t)b * SEQ + qt * 128) * 1024 + h * 256;
    const u16* Kb = (const u16*)(p.ws + OFF_MK) + (size_t)b * 256 * 1024 + h * 256;
    const u16* Vt = (const u16*)(p.ws + OFF_MVT) + (size_t)(b * 4 + h) * 256 * 256;
    float* Ss = (float*)(p.ws + OFF_SCR + (size_t)blockIdx.x * SCR_PER_BLOCK);
    u16* Ps = (u16*)((char*)Ss + 128 * 256 * 4);
    u16* Ob = (u16*)(p.ws + OFF_O) + ((size_t)b * SEQ + qt * 128) * 1024 + h * 256;
#pragma unroll 1
    for (int nt = 0; nt < 2; ++nt)
        gemm_tile1(Qt, 1024, Kb + (size_t)nt * 128 * 1024, 1024, 256, lds,
                  [&](int r, int c, f32x4 v) { *(float4*)(Ss + r * 256 + nt * 128 + c) = make_float4(v[0] * 0.0625f, v[1] * 0.0625f, v[2] * 0.0625f, v[3] * 0.0625f); });
    __syncthreads();
    for (int i = 0; i < 32; ++i) {
        const int r = wave * 32 + i;
        const float4 x = *(const float4*)(Ss + r * 256 + lane * 4);
        const float m = wave_max(fmaxf(fmaxf(x.x, x.y), fmaxf(x.z, x.w)));
        const float e0 = __expf(x.x - m), e1 = __expf(x.y - m), e2 = __expf(x.z - m), e3 = __expf(x.w - m);
        const float inv = 1.0f / wave_sum(e0 + e1 + e2 + e3);
        *(uint2*)(Ps + r * 256 + lane * 4) = make_uint2(pack2(e0 * inv, e1 * inv), pack2(e2 * inv, e3 * inv));
    }
    __syncthreads();
#pragma unroll 1
    for (int nt = 0; nt < 2; ++nt)
        gemm_tile1(Ps, 256, Vt + (size_t)nt * 128 * 256, 256, 256, lds,
                  [&](int r, int c, f32x4 v) { *(uint2*)(Ob + (size_t)r * 1024 + nt * 128 + c) = make_uint2(pack2(v[0], v[1]), pack2(v[2], v[3])); });
    __syncthreads();
}


DEVINL void attn_prompt_item2(const Params& p, int item, char* lds) {
    const int b = item >> 7, h = (item >> 5) & 3, qt = item & 31;
    const int tid = threadIdx.x, lane = tid & 63, w = tid >> 6, fr = lane & 15, fq = lane >> 4;
    char* Kbuf = lds;
    char* Vbuf = lds + 33792;
    const size_t qrow = (size_t)b * SEQ + qt * 64 + w * 16 + fr;
    const u16* Qp = (const u16*)(p.ws + OFF_Q) + qrow * 1024 + h * 256 + fq * 8;
    const int krow = tid >> 5, kch = tid & 31;
    const u16* Kg = (const u16*)(p.ws + OFF_MK) + ((size_t)b * 256 + krow) * 1024 + h * 256 + kch * 8;
    const int klds = krow * 528 + kch * 16;
    const int vrow = tid >> 2, vch = tid & 3;
    const u16* Vg = (const u16*)(p.ws + OFF_MVT) + ((size_t)(b * 4 + h) * 256 + vrow) * 256 + vch * 8;
    const int vlds = vrow * 80 + vch * 16;
    bf16x8 qf[8];
#pragma unroll
    for (int ks = 0; ks < 8; ++ks) qf[ks] = *(const bf16x8*)(Qp + ks * 32);
    uint4 r0, r1, r2, r3, r4, r5, r6, r7;
#define KLOAD(KB) do { const u16* g_ = Kg + (size_t)(KB) * 64 * 1024; \
        r0 = *(const uint4*)(g_); r1 = *(const uint4*)(g_ + 8 * 1024); r2 = *(const uint4*)(g_ + 16 * 1024); r3 = *(const uint4*)(g_ + 24 * 1024); \
        r4 = *(const uint4*)(g_ + 32 * 1024); r5 = *(const uint4*)(g_ + 40 * 1024); r6 = *(const uint4*)(g_ + 48 * 1024); r7 = *(const uint4*)(g_ + 56 * 1024); } while (0)
#define KSTORE() do { char* d_ = Kbuf + klds; \
        *(uint4*)(d_) = r0; *(uint4*)(d_ + 8 * 528) = r1; *(uint4*)(d_ + 16 * 528) = r2; *(uint4*)(d_ + 24 * 528) = r3; \
        *(uint4*)(d_ + 32 * 528) = r4; *(uint4*)(d_ + 40 * 528) = r5; *(uint4*)(d_ + 48 * 528) = r6; *(uint4*)(d_ + 56 * 528) = r7; } while (0)
#define VLOAD(VB) do { const u16* g_ = Vg + (VB) * 32; \
        r0 = *(const uint4*)(g_); r1 = *(const uint4*)(g_ + 64 * 256); r2 = *(const uint4*)(g_ + 128 * 256); r3 = *(const uint4*)(g_ + 192 * 256); } while (0)
#define VSTORE() do { char* d_ = Vbuf + vlds; \
        *(uint4*)(d_) = r0; *(uint4*)(d_ + 64 * 80) = r1; *(uint4*)(d_ + 128 * 80) = r2; *(uint4*)(d_ + 192 * 80) = r3; } while (0)
    f32x4 sacc[16];
    KLOAD(0);
#pragma unroll
    for (int kb = 0; kb < 4; ++kb) {
        KSTORE();
        if (kb < 3) KLOAD(kb + 1); else VLOAD(0);
        lds_barrier();
#pragma unroll
        for (int kl = 0; kl < 4; ++kl) {
            f32x4 acc = (f32x4){0.f, 0.f, 0.f, 0.f};
#pragma unroll
            for (int ks = 0; ks < 8; ++ks)
                acc = __builtin_amdgcn_mfma_f32_16x16x32_bf16(*(const bf16x8*)(Kbuf + (kl * 16 + fr) * 528 + (ks * 32 + fq * 8) * 2), qf[ks], acc, 0, 0, 0);
            sacc[kb * 4 + kl] = acc;
        }
        lds_barrier();
    }
    float m = -3.0e38f;
#pragma unroll
    for (int kt = 0; kt < 16; ++kt) m = fmaxf(m, fmaxf(fmaxf(sacc[kt][0], sacc[kt][1]), fmaxf(sacc[kt][2], sacc[kt][3])));
    m = fmaxf(m, __shfl_xor(m, 16)); m = fmaxf(m, __shfl_xor(m, 32));
    float sum = 0.f;
#pragma unroll
    for (int kt = 0; kt < 16; ++kt)
#pragma unroll
        for (int r = 0; r < 4; ++r) { const float e = __expf((sacc[kt][r] - m) * 0.0625f); sacc[kt][r] = e; sum += e; }
    sum += __shfl_xor(sum, 16); sum += __shfl_xor(sum, 32);
    const float inv = __builtin_amdgcn_rcpf(sum);
    bf16x8 pf[8];
#pragma unroll
    for (int ks = 0; ks < 8; ++ks) {
        uint4 u;
        u.x = pack2(sacc[2 * ks][0] * inv, sacc[2 * ks][1] * inv); u.y = pack2(sacc[2 * ks][2] * inv, sacc[2 * ks][3] * inv);
        u.z = pack2(sacc[2 * ks + 1][0] * inv, sacc[2 * ks + 1][1] * inv); u.w = pack2(sacc[2 * ks + 1][2] * inv, sacc[2 * ks + 1][3] * inv);
        pf[ks] = __builtin_bit_cast(bf16x8, u);
    }
    f32x4 oacc[16];
#pragma unroll
    for (int dt = 0; dt < 16; ++dt) oacc[dt] = (f32x4){0.f, 0.f, 0.f, 0.f};
#pragma unroll
    for (int vb = 0; vb < 8; ++vb) {
        VSTORE();
        if (vb < 7) VLOAD(vb + 1);
        lds_barrier();
#pragma unroll
        for (int dt = 0; dt < 16; ++dt) {
            const uint2 lo = *(const uint2*)(Vbuf + (dt * 16 + fr) * 80 + fq * 8), hi = *(const uint2*)(Vbuf + (dt * 16 + fr) * 80 + fq * 8 + 32);
            const uint4 u = make_uint4(lo.x, lo.y, hi.x, hi.y);
            oacc[dt] = __builtin_amdgcn_mfma_f32_16x16x32_bf16(__builtin_bit_cast(bf16x8, u), pf[vb], oacc[dt], 0, 0, 0);
        }
        lds_barrier();
    }
#undef KLOAD
#undef KSTORE
#undef VLOAD
#undef VSTORE
    {
        char* img = lds + w * 8448 + fr * 528 + fq * 8;
#pragma unroll
        for (int dt = 0; dt < 16; ++dt)
            *(uint2*)(img + dt * 32) = make_uint2(pack2(oacc[dt][0], oacc[dt][1]), pack2(oacc[dt][2], oacc[dt][3]));
        const char* rd = lds + w * 8448 + (lane >> 5) * 528 + (lane & 31) * 16;
        u16* o0 = (u16*)(p.ws + OFF_O) + ((size_t)b * SEQ + qt * 64 + w * 16 + (lane >> 5)) * 1024 + h * 256 + (lane & 31) * 8;
#pragma unroll
        for (int it = 0; it < 8; ++it) *(uint4*)(o0 + (size_t)it * 2048) = *(const uint4*)(rd + it * 1056);
    }
    lds_barrier();
}

DEVINL void attn_sample_item(const Params& p, int l, int item, char* lds) {
    const int s = item >> 2, h = item & 3;
    const int tid = threadIdx.x, lane = tid & 63, wave = tid >> 6;
    float* sc = (float*)lds;
    float* red = sc + 256;
    float* wred = red + 1024;
    const int rsub = lane >> 4, part = lane & 15;
    const u16* qp = (const u16*)(p.ws + OFF_Q) + (size_t)(NP + s) * 1024 + h * 256 + part * 4;
    float qv[16];
#pragma unroll
    for (int j = 0; j < 4; ++j) {
        const uint2 qq = *(const uint2*)(qp + j * 64);
        qv[j * 4 + 0] = lo16(qq.x); qv[j * 4 + 1] = hi16(qq.x); qv[j * 4 + 2] = lo16(qq.y); qv[j * 4 + 3] = hi16(qq.y);
    }
    const size_t cb0 = (((size_t)l * NS + s) * 256) * 1024 + h * 256;
    const float* Kc = p.in[I_CK] + cb0 + part * 4;
    const float* Vc = p.in[I_CV] + cb0 + lane * 4;
#pragma unroll 1
    for (int i = 0; i < 4; ++i) {
        float4 kv[4][4];
#pragma unroll
        for (int pp = 0; pp < 4; ++pp)
#pragma unroll
            for (int j = 0; j < 4; ++j) kv[pp][j] = *(const float4*)(Kc + (size_t)(wave * 64 + (i * 4 + pp) * 4 + rsub) * 1024 + j * 64);
#pragma unroll
        for (int pp = 0; pp < 4; ++pp) {
            float d = 0.f;
#pragma unroll
            for (int j = 0; j < 4; ++j) d += kv[pp][j].x * qv[j * 4] + kv[pp][j].y * qv[j * 4 + 1] + kv[pp][j].z * qv[j * 4 + 2] + kv[pp][j].w * qv[j * 4 + 3];
            d += __shfl_xor(d, 1); d += __shfl_xor(d, 2); d += __shfl_xor(d, 4); d += __shfl_xor(d, 8);
            if (part == 0) sc[wave * 64 + (i * 4 + pp) * 4 + rsub] = d * 0.0625f;
        }
    }
    __syncthreads();
    const float x = sc[tid];
    const float wm = wave_max(x);
    if (lane == 0) wred[wave] = wm;
    __syncthreads();
    const float m = fmaxf(fmaxf(wred[0], wred[1]), fmaxf(wred[2], wred[3]));
    const float e = __expf(x - m);
    const float ws_ = wave_sum(e);
    if (lane == 0) wred[4 + wave] = ws_;
    __syncthreads();
    const float inv = 1.0f / (wred[4] + wred[5] + wred[6] + wred[7]);
    sc[tid] = e * inv;
    __syncthreads();
    float4 acc = make_float4(0.f, 0.f, 0.f, 0.f);
#pragma unroll 1
    for (int i = 0; i < 4; ++i) {
        float4 vv[16];
#pragma unroll
        for (int j = 0; j < 16; ++j) vv[j] = *(const float4*)(Vc + (size_t)(wave * 64 + i * 16 + j) * 1024);
#pragma unroll
        for (int j = 0; j < 16; ++j) {
            const float pw = sc[wave * 64 + i * 16 + j];
            acc.x += pw * vv[j].x; acc.y += pw * vv[j].y; acc.z += pw * vv[j].z; acc.w += pw * vv[j].w;
        }
    }
    *(float4*)(red + wave * 256 + lane * 4) = acc;
    __syncthreads();
    {
        const float o = red[tid] + red[256 + tid] + red[512 + tid] + red[768 + tid];
        ((u16*)(p.ws + OFF_O))[(size_t)(NP + s) * 1024 + h * 256 + tid] = (u16)f2bf(o);
    }
    __syncthreads();
}

DEVINL void phase_attn(const Params& p, int l, char* lds) {
    const int G = gridDim.x;
    const bool sample_first = (int)blockIdx.x >= (G >> 1);
#pragma unroll 1
    for (int pass = 0; pass < 2; ++pass) {
        const bool do_sample = (pass == 0) == sample_first;
        if (do_sample) {
#pragma unroll 1
            for (int it = blockIdx.x; it < 512; it += G) attn_sample_item(p, l, it, lds);
        } else {
#pragma unroll 1
            for (int it = blockIdx.x; it < 1024; it += G) attn_prompt_item2(p, it, lds);
        }
    }
}

#define XB_TMO      128
#define XB_XCNT(j)  (256  + 64 * (j))
#define XB_XSUB(j)  (1280 + 64 * (j))
#define XB_XGEN(j)  (2304 + 64 * (j))
#define XB_TOP      3328
#define XB_TOPGEN   3392
#define XCD_BAR_WORDS 3456
#define XB_SPIN_CAP (1u << 22)
#define LAS __attribute__((address_space(3)))
DEVINL unsigned xb_ld(unsigned* p) { return __hip_atomic_load(p, __ATOMIC_RELAXED, __HIP_MEMORY_SCOPE_AGENT); }
DEVINL unsigned xb_add(unsigned* p, unsigned v) { return __hip_atomic_fetch_add(p, v, __ATOMIC_RELAXED, __HIP_MEMORY_SCOPE_AGENT); }
DEVINL unsigned xb_xcc_id() { return (unsigned)__builtin_amdgcn_s_getreg((3 << 11) | 20) & 0xFu; }
#define XB_SPIN(cond, bar) do { unsigned _sp = 0; while (cond) { __builtin_amdgcn_s_sleep(1); \
    if ((++_sp & 255u) == 0u) { if (xb_ld(&(bar)[XB_TMO])) break; if (_sp > XB_SPIN_CAP) { atomicAdd(&(bar)[XB_TMO], 1u); break; } } } } while (0)
struct XcdBarrier { unsigned* bar; unsigned x; volatile LAS unsigned* st; };
DEVINL XcdBarrier xcd_barrier_post(unsigned* bar, volatile LAS unsigned* st) {
    XcdBarrier b; b.bar = bar; b.x = xb_xcc_id(); b.st = st;
    if (threadIdx.x == 0) (void)xb_add(&bar[XB_XCNT(b.x)], 1u);
    return b;
}
DEVINL void xcd_barrier_complete(unsigned* bar, unsigned x, unsigned& nloc, unsigned& nx) {
    const unsigned G = gridDim.x * gridDim.y * gridDim.z;
    unsigned sum, cnt, mine, sp = 0u;
    for (;;) {
        sum = 0u; cnt = 0u; mine = 0u;
#pragma unroll
        for (unsigned j = 0; j < 16; ++j) { const unsigned c = xb_ld(&bar[XB_XCNT(j)]); sum += c; cnt += (c > 0u) ? 1u : 0u; mine = (j == x) ? c : mine; }
        if (sum == G) break;
        __builtin_amdgcn_s_sleep(1);
        if ((++sp & 255u) == 0u) { if (xb_ld(&bar[XB_TMO])) break; if (sp > XB_SPIN_CAP) { atomicAdd(&bar[XB_TMO], 1u); break; } }
    }
    nloc = mine > 0u ? mine : 1u; nx = cnt > 0u ? cnt : 1u;
}
DEVINL void xcd_barrier(const XcdBarrier& b) {
    asm volatile("s_waitcnt vmcnt(0)" ::: "memory");
    __syncthreads();
    if (threadIdx.x == 0) {
        unsigned* bar = b.bar;
        __builtin_amdgcn_s_waitcnt(0);
        unsigned nloc = b.st[0], nx = b.st[1];
        if (nloc == 0u) { xcd_barrier_complete(bar, b.x, nloc, nx); b.st[0] = nloc; b.st[1] = nx; }
        const unsigned old = xb_add(&bar[XB_XSUB(b.x)], 1u);
        const unsigned gen = old / nloc;
        if (old + 1u == (gen + 1u) * nloc) {
            __builtin_amdgcn_fence(__ATOMIC_RELEASE, "agent");
            asm volatile("s_waitcnt vmcnt(0)" ::: "memory");
            const unsigned og = xb_add(&bar[XB_TOP], 1u);
            const unsigned tg = og / nx;
            if (og + 1u == (tg + 1u) * nx) xb_add(&bar[XB_TOPGEN], 1u);
            else XB_SPIN(xb_ld(&bar[XB_TOPGEN]) == tg, bar);
            __builtin_amdgcn_fence(__ATOMIC_ACQUIRE, "agent");
            xb_add(&bar[XB_XGEN(b.x)], 1u);
            asm volatile("s_waitcnt vmcnt(0)" ::: "memory");
        } else {
            XB_SPIN(xb_ld(&bar[XB_XGEN(b.x)]) == gen, bar);
            __builtin_amdgcn_fence(__ATOMIC_ACQUIRE, "agent");
            asm volatile("s_waitcnt vmcnt(0)" ::: "memory");
        }
    }
    __syncthreads();
}

#ifndef ONLYQ
#define ONLYQ -1
#endif
#ifndef REP_MASK
#define REP_MASK 0
#endif
__global__ void __launch_bounds__(256, 2) mega(Params p) {
    __shared__ __attribute__((aligned(16))) char lds[65536];
    __shared__ uint4 xb_words;
    XcdBarrier bar; bar.bar = (unsigned*)(p.ws + OFF_BAR); bar.x = 0; bar.st = (volatile LAS unsigned*)&xb_words;
    if (p.coop) {
        if (threadIdx.x == 0) xb_words = make_uint4(0u, 0u, 0u, 0u);
        __syncthreads();
        bar = xcd_barrier_post((unsigned*)(p.ws + OFF_BAR), (volatile LAS unsigned*)&xb_words);
    }
#define RUNPH(PH, Q, BODY) if ((ONLYQ < 0 || ONLYQ == (Q)) && p.ph_lo <= (PH) && (PH) < p.ph_hi) { BODY; if (REP_MASK & (1 << (Q))) { BODY; } \
        if (p.coop && (PH) + 1 < p.ph_hi) { if (p.pad == 0x5a5a5a5a) cg::this_grid().sync(); else xcd_barrier(bar); } }
#define LAYER(L) \
    RUNPH(1 + (L) * 10 + 0, 0, phase_gemm_in(p, L, lds)) \
    RUNPH(1 + (L) * 10 + 1, 1, phase_prep(p, L, lds)) \
    RUNPH(1 + (L) * 10 + 2, 2, phase_scan(p, L, lds)) \
    RUNPH(1 + (L) * 10 + 3, 3, phase_mixnorm(p, L)) \
    RUNPH(1 + (L) * 10 + 4, 4, phase_gemm_n1024((const u16*)(p.ws + OFF_YCAT), 2048, (const u16*)(p.ws + OFF_WOUT) + (size_t)(L) * 1024 * 2048, nullptr, (u16*)(p.ws + OFF_T), lds)) \
    RUNPH(1 + (L) * 10 + 5, 15, phase_rowpass(p, L, 0)) \
    RUNPH(1 + (L) * 10 + 6, 6, phase_gemm_n1024((const u16*)(p.ws + OFF_HB), 1024, (const u16*)(p.ws + OFF_WQ) + (size_t)(L) * 1024 * 1024, nullptr, (u16*)(p.ws + OFF_Q), lds)) \
    RUNPH(1 + (L) * 10 + 7, 7, phase_attn(p, L, lds)) \
    RUNPH(1 + (L) * 10 + 8, 8, phase_gemm_n1024((const u16*)(p.ws + OFF_O), 1024, (const u16*)(p.ws + OFF_WO) + (size_t)(L) * 1024 * 1024, nullptr, (u16*)(p.ws + OFF_T), lds)) \
    RUNPH(1 + (L) * 10 + 9, 15, phase_rowpass(p, L, 1))
    RUNPH(0, 10, phase_prologue(p, lds))
    LAYER(0)
    LAYER(1)
}

extern "C" void kernel_launch(void* const* d_in, const int* in_sizes, int n_in, void* d_out, int out_size, void* d_ws, size_t ws_size,
                              hipStream_t stream) {
    static int grid = 0;
    if (!grid) {
        int dev = 0, cus = 0, per_cu = 0;
        hipGetDevice(&dev);
        hipDeviceGetAttribute(&cus, hipDeviceAttributeMultiprocessorCount, dev);
        hipOccupancyMaxActiveBlocksPerMultiprocessor(&per_cu, mega, 256, 0);
        if (per_cu > 2) per_cu = 2;
        if (per_cu < 1) per_cu = 1;
        grid = cus * per_cu;
        if (grid > MAX_GRID) grid = MAX_GRID;
        if (n_in != 29 || ws_size < WS_END) { fprintf(stderr, "kernel_launch: unexpected n_in %d or ws_size %zu (< %zu)\n", n_in, ws_size, (size_t)WS_END); }
    }
    Params p{};
    for (int i = 0; i < 29; ++i) p.in[i] = (const float*)d_in[i];
    p.out = (float*)d_out; p.ws = (char*)d_ws;
#if MULTI_LAUNCH
    for (int ph = 0; ph < NPHASE; ++ph) {
        p.ph_lo = ph; p.ph_hi = ph + 1; p.coop = 0;
        hipLaunchKernelGGL(mega, dim3(grid), dim3(256), 0, stream, p);
    }
#else
    p.ph_lo = 0; p.ph_hi = NPHASE; p.coop = 1;
    (void)hipMemsetAsync((char*)d_ws + OFF_BAR, 0, 16384, stream);
    void* args[] = {&p};
    hipError_t e = hipLaunchCooperativeKernel((void*)mega, dim3(grid), dim3(256), args, 0, stream);
    if (e != hipSuccess) fprintf(stderr, "cooperative launch failed: %s (grid %d)\n", hipGetErrorString(e), grid);
#endif
}
```

```cpp
#include <hip/hip_runtime.h>
#include <hip/hip_cooperative_groups.h>
#include <stdint.h>
#include <cstdio>
namespace cg = cooperative_groups;

#ifndef MULTI_LAUNCH
#define MULTI_LAUNCH 0
#endif

typedef unsigned short u16;
typedef short bf16x8 __attribute__((ext_vector_type(8)));
typedef float f32x4 __attribute__((ext_vector_type(4)));
#define DEVINL __device__ __forceinline__

constexpr int D = 1024, NP = 16384, NS = 128, NR = 16512, SEQ = 2048, DINP = 6784, DIN = 6672;
constexpr int NPHASE = 21;
constexpr float EPS = 1e-6f;

constexpr size_t SZ_WIN = (size_t)DINP * 1024 * 2, SZ_WOUT = (size_t)1024 * 2048 * 2, SZ_SQ = (size_t)1024 * 1024 * 2;
constexpr size_t OFF_WIN = 0;
constexpr size_t OFF_WOUT = OFF_WIN + 2 * SZ_WIN;
constexpr size_t OFF_WQ = OFF_WOUT + 2 * SZ_WOUT;
constexpr size_t OFF_WK = OFF_WQ + 2 * SZ_SQ;
constexpr size_t OFF_WV = OFF_WK + 2 * SZ_SQ;
constexpr size_t OFF_WO = OFF_WV + 2 * SZ_SQ;
constexpr size_t OFF_X = OFF_WO + 2 * SZ_SQ;
constexpr size_t OFF_HB = OFF_X + (size_t)NR * 1024 * 4;
constexpr size_t OFF_MB = OFF_HB + (size_t)NR * 1024 * 2;
constexpr size_t OFF_U = OFF_MB + (size_t)2048 * 1024 * 2;
constexpr size_t OFF_XBC = OFF_U + (size_t)NR * DINP * 2;
constexpr size_t OFF_DT = OFF_XBC + (size_t)NR * 1536 * 4;
constexpr size_t OFF_OB = OFF_DT + (size_t)NR * 16 * 4;
constexpr size_t OFF_YC = OFF_OB + (size_t)NR * 512 * 4;
constexpr size_t OFF_YCAT = OFF_YC + (size_t)NR * 1024 * 4;
constexpr size_t OFF_T = OFF_YCAT + (size_t)NR * 2048 * 2;
constexpr size_t OFF_Q = OFF_T + (size_t)NR * 1024 * 4;
constexpr size_t OFF_O = OFF_Q + (size_t)NR * 1024 * 2;
constexpr size_t OFF_MK = OFF_O + (size_t)NR * 1024 * 2;
constexpr size_t OFF_MVT = OFF_MK + (size_t)2048 * 1024 * 2;
constexpr size_t OFF_SCR = OFF_MVT + (size_t)2048 * 1024 * 2;
constexpr size_t SCR_PER_BLOCK = 128 * 256 * 4 + 128 * 256 * 2;
constexpr int MAX_GRID = 1024;
constexpr size_t OFF_XBCB = OFF_SCR + SCR_PER_BLOCK * MAX_GRID;
constexpr size_t OFF_HQG = OFF_XBCB + (size_t)NR * 1536 * 2;
constexpr size_t OFF_HQM = OFF_HQG + (size_t)2048 * 4096 * 2;
constexpr size_t OFF_HKM = OFF_HQM + (size_t)2048 * 4096 * 2;
constexpr size_t OFF_HKD = OFF_HKM + (size_t)2048 * 4096 * 2;
constexpr size_t OFF_HDS = OFF_HKD + (size_t)2048 * 4096 * 2;
constexpr size_t OFF_BAR = OFF_HDS + (size_t)2048 * 128 * 4;
constexpr size_t WS_END = OFF_BAR + 16384;

constexpr size_t O_YP = 0;
constexpr size_t O_YS = O_YP + (size_t)NP * 1024;
constexpr size_t O_CAP = O_YS + (size_t)NS * 1024;
constexpr size_t O_HGP = O_CAP + (size_t)2 * 8 * 2 * 512;
constexpr size_t O_SCP = O_HGP + (size_t)2 * 8 * 4 * 128 * 128;
constexpr size_t O_SSP = O_SCP + (size_t)2 * 8 * 3 * 1536;
constexpr size_t O_MKP = O_SSP + (size_t)2 * 8 * 16 * 64 * 128;
constexpr size_t O_MVP = O_MKP + (size_t)2 * 8 * 256 * 1024;
constexpr size_t O_CAS = O_MVP + (size_t)2 * 8 * 256 * 1024;
constexpr size_t O_HGS = O_CAS + (size_t)2 * 128 * 2 * 512;
constexpr size_t O_SCS = O_HGS + (size_t)2 * 128 * 4 * 128 * 128;
constexpr size_t O_SSS = O_SCS + (size_t)2 * 128 * 3 * 1536;

enum { I_XP = 0, I_XS, I_MEM, I_SCA, I_SHG, I_SSC, I_SSS, I_CK, I_CV, I_WIN, I_CAW, I_HLB, I_HGN, I_SCW, I_SCB, I_DTB, I_ALOG, I_DSK,
       I_SNORM, I_WOUT, I_GPM, I_GQM, I_GPX, I_GQX, I_GMEM, I_WQ, I_WK, I_WV, I_WO };

struct Params {
    const float* in[29];
    float* out;
    char* ws;
    int ph_lo, ph_hi, coop, pad;
};

DEVINL float bf2f(uint32_t h) { return __uint_as_float(h << 16); }
DEVINL uint32_t f2bf(float f) { uint32_t u = __float_as_uint(f); return (u + 0x7fffu + ((u >> 16) & 1u)) >> 16; }
DEVINL uint32_t pack2(float a, float b) { return f2bf(a) | (f2bf(b) << 16); }
DEVINL float lo16(uint32_t v) { return __uint_as_float(v << 16); }
DEVINL float hi16(uint32_t v) { return __uint_as_float(v & 0xffff0000u); }
DEVINL float sigmoidf_(float x) { return __builtin_amdgcn_rcpf(1.0f + __expf(-x)); }
DEVINL float siluf_(float x) { return x * __builtin_amdgcn_rcpf(1.0f + __expf(-x)); }
DEVINL float wave_sum(float v) {
#pragma unroll
    for (int o = 32; o; o >>= 1) v += __shfl_xor(v, o);
    return v;
}
DEVINL float wave_max(float v) {
#pragma unroll
    for (int o = 32; o; o >>= 1) v = fmaxf(v, __shfl_xor(v, o));
    return v;
}
DEVINL void lds_barrier() { asm volatile("s_waitcnt lgkmcnt(0)\n\ts_barrier" ::: "memory"); }
DEVINL float4 ldnt4(const float* p) { const f32x4 v = __builtin_nontemporal_load((const f32x4*)p); return make_float4(v[0], v[1], v[2], v[3]); }
DEVINL void stnt4(float* p, float4 v) { const f32x4 t = (f32x4){v.x, v.y, v.z, v.w}; __builtin_nontemporal_store(t, (f32x4*)p); }
#define UNPACK8(v, f) do { f[0] = lo16(v.x); f[1] = hi16(v.x); f[2] = lo16(v.y); f[3] = hi16(v.y); f[4] = lo16(v.z); f[5] = hi16(v.z); f[6] = lo16(v.w); f[7] = hi16(v.w); } while (0)

template <class Epi>
DEVINL void gemm_tile(const u16* __restrict__ A, int lda, const u16* __restrict__ Bt, int ldb, int K, char* lds, Epi epi) {
    const int tid = threadIdx.x, lane = tid & 63, wave = tid >> 6, wr = wave >> 1, wc = wave & 1, fr = lane & 15, fq = lane >> 4;
    f32x4 acc[4][4];
#pragma unroll
    for (int m = 0; m < 4; ++m)
#pragma unroll
        for (int n = 0; n < 4; ++n) acc[m][n] = (f32x4){0.f, 0.f, 0.f, 0.f};
    const int srow = tid >> 2, sch = tid & 3;
    const u16* Ag = A + (size_t)srow * lda + sch * 8;
    const u16* Bg = Bt + (size_t)srow * ldb + sch * 8;
    const int soff = srow * 64 + ((sch ^ (((srow >> 3) & 1) << 1)) << 4);
    const int swz = ((fq ^ (((fr >> 3) & 1) << 1)) << 4);
    const int fa = (wr * 64 + fr) * 64 + swz;
    const int fb = 16384 + (wc * 64 + fr) * 64 + swz;
    uint4 pa0, pa1, pa2, pa3, pb0, pb1, pb2, pb3, qa0, qa1, qa2, qa3, qb0, qb1, qb2, qb3;
    const int nt = K >> 6;
    const size_t sA1 = (size_t)64 * lda, sB1 = (size_t)64 * ldb;
#define G_LOAD(P, T) do { const int k0_ = (T) << 6; \
        P##a0 = *(const uint4*)(Ag + k0_); P##a1 = *(const uint4*)(Ag + k0_ + 32); P##a2 = *(const uint4*)(Ag + sA1 + k0_); P##a3 = *(const uint4*)(Ag + sA1 + k0_ + 32); \
        P##b0 = *(const uint4*)(Bg + k0_); P##b1 = *(const uint4*)(Bg + k0_ + 32); P##b2 = *(const uint4*)(Bg + sB1 + k0_); P##b3 = *(const uint4*)(Bg + sB1 + k0_ + 32); } while (0)
#define G_STORE(P, ST) do { char* nb_ = lds + (ST) * 32768 + soff; \
        *(uint4*)(nb_) = P##a0; *(uint4*)(nb_ + 8192) = P##a1; *(uint4*)(nb_ + 4096) = P##a2; *(uint4*)(nb_ + 4096 + 8192) = P##a3; \
        *(uint4*)(nb_ + 16384) = P##b0; *(uint4*)(nb_ + 16384 + 8192) = P##b1; *(uint4*)(nb_ + 16384 + 4096) = P##b2; *(uint4*)(nb_ + 16384 + 4096 + 8192) = P##b3; } while (0)
    auto g_compute = [&](int ST) __attribute__((always_inline)) {
        const char* base = lds + ST * 32768;
#pragma unroll
        for (int s = 0; s < 2; ++s) {
            bf16x8 a[4], b[4];
#pragma unroll
            for (int m = 0; m < 4; ++m) a[m] = *(const bf16x8*)(base + fa + m * 1024 + s * 8192);
#pragma unroll
            for (int n = 0; n < 4; ++n) b[n] = *(const bf16x8*)(base + fb + n * 1024 + s * 8192);
            __builtin_amdgcn_s_setprio(1);
#pragma unroll
            for (int m = 0; m < 4; ++m)
#pragma unroll
                for (int n = 0; n < 4; ++n) acc[m][n] = __builtin_amdgcn_mfma_f32_16x16x32_bf16(b[n], a[m], acc[m][n], 0, 0, 0);
            __builtin_amdgcn_s_setprio(0);
        }
    };
#define G_COMPUTE(ST) g_compute(ST)
    G_LOAD(p, 0);
    if (nt > 1) G_LOAD(q, 1);
    G_STORE(p, 0);
    if (nt > 2) G_LOAD(p, 2);
    lds_barrier();
#pragma unroll 1
    for (int t = 0; t < nt; t += 2) {
        if (t + 1 < nt) G_STORE(q, 1);
        if (t + 3 < nt) G_LOAD(q, t + 3);
        G_COMPUTE(0);
        lds_barrier();
        if (t + 1 < nt) {
            if (t + 2 < nt) G_STORE(p, 0);
            if (t + 4 < nt) G_LOAD(p, t + 4);
            G_COMPUTE(1);
            lds_barrier();
        }
    }
#undef G_LOAD
#undef G_STORE
#undef G_COMPUTE
#pragma unroll
    for (int m = 0; m < 4; ++m)
#pragma unroll
        for (int n = 0; n < 4; ++n) epi(wr * 64 + m * 16 + fr, wc * 64 + n * 16 + fq * 4, acc[m][n]);
}

DEVINL void gemm_tile_b(const u16* __restrict__ A, int lda, const u16* __restrict__ Bt, int ldb, int K, char* lds, u16* __restrict__ dst, int ldd) {
    const int tid = threadIdx.x, lane = tid & 63, wave = tid >> 6, wr = wave >> 1, wc = wave & 1, fr = lane & 15, fq = lane >> 4;
    f32x4 acc[4][4];
#pragma unroll
    for (int m = 0; m < 4; ++m)
#pragma unroll
        for (int n = 0; n < 4; ++n) acc[m][n] = (f32x4){0.f, 0.f, 0.f, 0.f};
    const int srow = tid >> 2, sch = tid & 3;
    const u16* Ag = A + (size_t)srow * lda + sch * 8;
    const u16* Bg = Bt + (size_t)srow * ldb + sch * 8;
    const int soff = srow * 64 + ((sch ^ (((srow >> 3) & 1) << 1)) << 4);
    const int swz = ((fq ^ (((fr >> 3) & 1) << 1)) << 4);
    const int fa = (wr * 64 + fr) * 64 + swz;
    const int fb = 16384 + (wc * 64 + fr) * 64 + swz;
    uint4 pa0, pa1, pa2, pa3, pb0, pb1, pb2, pb3, qa0, qa1, qa2, qa3, qb0, qb1, qb2, qb3;
    const int nt = K >> 6;
    const size_t sA1 = (size_t)64 * lda, sB1 = (size_t)64 * ldb;
#define G_LOAD(P, T) do { const int k0_ = (T) << 6; \
        P##a0 = *(const uint4*)(Ag + k0_); P##a1 = *(const uint4*)(Ag + k0_ + 32); P##a2 = *(const uint4*)(Ag + sA1 + k0_); P##a3 = *(const uint4*)(Ag + sA1 + k0_ + 32); \
        P##b0 = *(const uint4*)(Bg + k0_); P##b1 = *(const uint4*)(Bg + k0_ + 32); P##b2 = *(const uint4*)(Bg + sB1 + k0_); P##b3 = *(const uint4*)(Bg + sB1 + k0_ + 32); } while (0)
#define G_STORE(P, ST) do { char* nb_ = lds + (ST) * 32768 + soff; \
        *(uint4*)(nb_) = P##a0; *(uint4*)(nb_ + 8192) = P##a1; *(uint4*)(nb_ + 4096) = P##a2; *(uint4*)(nb_ + 4096 + 8192) = P##a3; \
        *(uint4*)(nb_ + 16384) = P##b0; *(uint4*)(nb_ + 16384 + 8192) = P##b1; *(uint4*)(nb_ + 16384 + 4096) = P##b2; *(uint4*)(nb_ + 16384 + 4096 + 8192) = P##b3; } while (0)
    auto g_compute = [&](int ST) __attribute__((always_inline)) {
        const char* base = lds + ST * 32768;
#pragma unroll
        for (int s = 0; s < 2; ++s) {
            bf16x8 a[4], b[4];
#pragma unroll
            for (int m = 0; m < 4; ++m) a[m] = *(const bf16x8*)(base + fa + m * 1024 + s * 8192);
#pragma unroll
            for (int n = 0; n < 4; ++n) b[n] = *(const bf16x8*)(base + fb + n * 1024 + s * 8192);
            __builtin_amdgcn_s_setprio(1);
#pragma unroll
            for (int m = 0; m < 4; ++m)
#pragma unroll
                for (int n = 0; n < 4; ++n) acc[m][n] = __builtin_amdgcn_mfma_f32_16x16x32_bf16(b[n], a[m], acc[m][n], 0, 0, 0);
            __builtin_amdgcn_s_setprio(0);
        }
    };
#define G_COMPUTE(ST) g_compute(ST)
    G_LOAD(p, 0);
    if (nt > 1) G_LOAD(q, 1);
    G_STORE(p, 0);
    if (nt > 2) G_LOAD(p, 2);
    lds_barrier();
#pragma unroll 1
    for (int t = 0; t < nt; t += 2) {
        if (t + 1 < nt) G_STORE(q, 1);
        if (t + 3 < nt) G_LOAD(q, t + 3);
        G_COMPUTE(0);
        lds_barrier();
        if (t + 1 < nt) {
            if (t + 2 < nt) G_STORE(p, 0);
            if (t + 4 < nt) G_LOAD(p, t + 4);
            G_COMPUTE(1);
            lds_barrier();
        }
    }
#undef G_LOAD
#undef G_STORE
#undef G_COMPUTE
    {
        char* img = lds + wave * 9216;
#pragma unroll
        for (int m = 0; m < 4; ++m)
#pragma unroll
            for (int n = 0; n < 4; ++n)
                *(uint2*)(img + (m * 16 + fr) * 144 + (n * 16 + fq * 4) * 2) = make_uint2(pack2(acc[m][n][0], acc[m][n][1]), pack2(acc[m][n][2], acc[m][n][3]));
        u16* d0 = dst + (size_t)(wr * 64) * ldd + wc * 64 + (lane & 7) * 8;
#pragma unroll
        for (int it = 0; it < 8; ++it) {
            const int row = it * 8 + (lane >> 3);
            const uint4 v = *(const uint4*)(img + row * 144 + (lane & 7) * 16);
            *(uint4*)(d0 + (size_t)row * ldd) = v;
        }
    }
    lds_barrier();
}

template <class Epi>
DEVINL void gemm_tile1(const u16* __restrict__ A, int lda, const u16* __restrict__ Bt, int ldb, int K, char* lds, Epi epi) {
    const int tid = threadIdx.x, lane = tid & 63, wave = tid >> 6, wr = wave >> 1, wc = wave & 1, fr = lane & 15, fq = lane >> 4;
    f32x4 acc[4][4];
#pragma unroll
    for (int m = 0; m < 4; ++m)
#pragma unroll
        for (int n = 0; n < 4; ++n) acc[m][n] = (f32x4){0.f, 0.f, 0.f, 0.f};
    const int srow = tid >> 3, sch = tid & 7;
    const u16* Ag = A + (size_t)srow * lda + sch * 8;
    const u16* Bg = Bt + (size_t)srow * ldb + sch * 8;
    const int soff = (sch >> 2) * 8192 + srow * 64 + ((((sch & 3) ^ (((srow >> 3) & 1) << 1))) << 4);
    const int swz = ((fq ^ (((fr >> 3) & 1) << 1)) << 4);
    const int fa = (wr * 64 + fr) * 64 + swz;
    const int fb = 16384 + (wc * 64 + fr) * 64 + swz;
    uint4 ra[4], rb[4];
    const int nt = K >> 6;
#pragma unroll
    for (int i = 0; i < 4; ++i) {
        ra[i] = *(const uint4*)(Ag + (size_t)i * 32 * lda);
        rb[i] = *(const uint4*)(Bg + (size_t)i * 32 * ldb);
    }
#pragma unroll
    for (int i = 0; i < 4; ++i) {
        *(uint4*)(lds + soff + i * 2048) = ra[i];
        *(uint4*)(lds + 16384 + soff + i * 2048) = rb[i];
    }
    __syncthreads();
    for (int t = 0; t < nt; ++t) {
        const bool more = (t + 1 < nt);
        if (more) {
            const int k0 = (t + 1) << 6;
#pragma unroll
            for (int i = 0; i < 4; ++i) {
                ra[i] = *(const uint4*)(Ag + (size_t)i * 32 * lda + k0);
                rb[i] = *(const uint4*)(Bg + (size_t)i * 32 * ldb + k0);
            }
        }
        const char* base = lds + (t & 1) * 32768;
#pragma unroll
        for (int s = 0; s < 2; ++s) {
            bf16x8 a[4], b[4];
#pragma unroll
            for (int m = 0; m < 4; ++m) a[m] = *(const bf16x8*)(base + fa + m * 1024 + s * 8192);
#pragma unroll
            for (int n = 0; n < 4; ++n) b[n] = *(const bf16x8*)(base + fb + n * 1024 + s * 8192);
#pragma unroll
            for (int m = 0; m < 4; ++m)
#pragma unroll
                for (int n = 0; n < 4; ++n) acc[m][n] = __builtin_amdgcn_mfma_f32_16x16x32_bf16(b[n], a[m], acc[m][n], 0, 0, 0);
        }
        if (more) {
            char* nb = lds + ((t + 1) & 1) * 32768;
#pragma unroll
            for (int i = 0; i < 4; ++i) {
                *(uint4*)(nb + soff + i * 2048) = ra[i];
                *(uint4*)(nb + 16384 + soff + i * 2048) = rb[i];
            }
        }
        __syncthreads();
    }
#pragma unroll
    for (int m = 0; m < 4; ++m)
#pragma unroll
        for (int n = 0; n < 4; ++n) epi(wr * 64 + m * 16 + fr, wc * 64 + n * 16 + fq * 4, acc[m][n]);
}

DEVINL void tile_mn(int id, int nM, int nN, int& m, int& n) {
    const int grp = id / (8 * nN), fm = grp * 8;
    const int gsz = (nM - fm) < 8 ? (nM - fm) : 8;
    const int rem = id - grp * 8 * nN;
    m = fm + rem % gsz; n = rem / gsz;
}

template <class F>
DEVINL void for_tiles_xcd(int T, F f) {
    const int G = gridDim.x;
    if ((G & 7) == 0) {
        const int x = blockIdx.x & 7, s = blockIdx.x >> 3, GS = G >> 3, per = ((((T + 7) >> 3) + 63) >> 6) << 6;
        for (int i = s; i < per; i += GS) { const int id = x * per + i; if (id < T) f(id); }
    } else {
        for (int id = blockIdx.x; id < T; id += G) f(id);
    }
}

DEVINL void transpose_tile(const float* __restrict__ W, int K, int N, u16* __restrict__ Wt, int k0, int n0, float* tile) {
    const int tid = threadIdx.x, tx = tid & 15, ty = tid >> 4;
#pragma unroll
    for (int i = 0; i < 4; ++i) {
        const int k = ty + 16 * i, n = n0 + tx * 4;
        float4 v = make_float4(0.f, 0.f, 0.f, 0.f);
        if (n < N) v = *(const float4*)(W + (size_t)(k0 + k) * N + n);
        float* t = tile + k * 65 + tx * 4;
        t[0] = v.x; t[1] = v.y; t[2] = v.z; t[3] = v.w;
    }
    __syncthreads();
    const int n = tid >> 2, kc = (tid & 3) * 16;
    uint32_t w[8];
#pragma unroll
    for (int j = 0; j < 8; ++j) w[j] = pack2(tile[(kc + 2 * j) * 65 + n], tile[(kc + 2 * j + 1) * 65 + n]);
    uint4* dst = (uint4*)(Wt + (size_t)(n0 + n) * K + k0 + kc);
    dst[0] = make_uint4(w[0], w[1], w[2], w[3]);
    dst[1] = make_uint4(w[4], w[5], w[6], w[7]);
    __syncthreads();
}

DEVINL void rowpass_row(const float* __restrict__ base, const u16* __restrict__ trow, const float* __restrict__ gpost,
                        float* __restrict__ xdst, const float* __restrict__ gnext, u16* __restrict__ hb, int lane) {
    float x[16];
    {
        const float4 a = *(const float4*)(base + lane * 8), b = *(const float4*)(base + lane * 8 + 4);
        const float4 c = *(const float4*)(base + 512 + lane * 8), d = *(const float4*)(base + 512 + lane * 8 + 4);
        x[0] = a.x; x[1] = a.y; x[2] = a.z; x[3] = a.w; x[4] = b.x; x[5] = b.y; x[6] = b.z; x[7] = b.w;
        x[8] = c.x; x[9] = c.y; x[10] = c.z; x[11] = c.w; x[12] = d.x; x[13] = d.y; x[14] = d.z; x[15] = d.w;
    }
    if (trow) {
        float t[16], g[16];
        {
            const uint4 t0 = *(const uint4*)(trow + lane * 8), t1 = *(const uint4*)(trow + 512 + lane * 8);
            t[0] = lo16(t0.x); t[1] = hi16(t0.x); t[2] = lo16(t0.y); t[3] = hi16(t0.y); t[4] = lo16(t0.z); t[5] = hi16(t0.z); t[6] = lo16(t0.w); t[7] = hi16(t0.w);
            t[8] = lo16(t1.x); t[9] = hi16(t1.x); t[10] = lo16(t1.y); t[11] = hi16(t1.y); t[12] = lo16(t1.z); t[13] = hi16(t1.z); t[14] = lo16(t1.w); t[15] = hi16(t1.w);
        }
#pragma unroll
        for (int h = 0; h < 2; ++h)
#pragma unroll
            for (int q = 0; q < 2; ++q) {
                const float4 gg = *(const float4*)(gpost + h * 512 + lane * 8 + q * 4);
                g[h * 8 + q * 4 + 0] = gg.x; g[h * 8 + q * 4 + 1] = gg.y; g[h * 8 + q * 4 + 2] = gg.z; g[h * 8 + q * 4 + 3] = gg.w;
            }
        float ss = 0.f;
#pragma unroll
        for (int i = 0; i < 16; ++i) ss += t[i] * t[i];
        ss = wave_sum(ss);
        const float rstd = rsqrtf(ss * (1.0f / 1024.0f) + EPS);
#pragma unroll
        for (int i = 0; i < 16; ++i) x[i] += t[i] * rstd * g[i];
    }
    if (xdst) {
#pragma unroll
        for (int h = 0; h < 2; ++h)
#pragma unroll
            for (int q = 0; q < 2; ++q)
                *(float4*)(xdst + h * 512 + lane * 8 + q * 4) = make_float4(x[h * 8 + q * 4], x[h * 8 + q * 4 + 1], x[h * 8 + q * 4 + 2], x[h * 8 + q * 4 + 3]);
    }
    if (gnext) {
        float ss = 0.f;
#pragma unroll
        for (int i = 0; i < 16; ++i) ss += x[i] * x[i];
        ss = wave_sum(ss);
        const float rstd = rsqrtf(ss * (1.0f / 1024.0f) + EPS);
#pragma unroll
        for (int h = 0; h < 2; ++h) {
            const float4 g0 = *(const float4*)(gnext + h * 512 + lane * 8), g1 = *(const float4*)(gnext + h * 512 + lane * 8 + 4);
            uint4 o;
            o.x = pack2(x[h * 8 + 0] * rstd * g0.x, x[h * 8 + 1] * rstd * g0.y);
            o.y = pack2(x[h * 8 + 2] * rstd * g0.z, x[h * 8 + 3] * rstd * g0.w);
            o.z = pack2(x[h * 8 + 4] * rstd * g1.x, x[h * 8 + 5] * rstd * g1.y);
            o.w = pack2(x[h * 8 + 6] * rstd * g1.z, x[h * 8 + 7] * rstd * g1.w);
            *(uint4*)(hb + h * 512 + lane * 8) = o;
        }
    }
}

DEVINL void phase_prologue(const Params& p, char* lds) {
    const int G = gridDim.x;
    u16* WinT = (u16*)(p.ws + OFF_WIN);
    u16* WoutT = (u16*)(p.ws + OFF_WOUT);
    for (int it = blockIdx.x; it < 6464; it += G) {
        const int l = it / 3232; int r = it % 3232;
        const float* W; u16* Wt; int K, N, kt, nt;
        if (r < 1696) { W = p.in[I_WIN] + (size_t)l * 1024 * DIN; K = 1024; N = DIN; Wt = WinT + (size_t)l * DINP * 1024; kt = r & 15; nt = r >> 4; }
        else if (r < 2208) { r -= 1696; W = p.in[I_WOUT] + (size_t)l * 2048 * 1024; K = 2048; N = 1024; Wt = WoutT + (size_t)l * 1024 * 2048; kt = r & 31; nt = r >> 5; }
        else {
            r -= 2208; const int j = r >> 8; r &= 255;
            W = p.in[j == 0 ? I_WQ : j == 1 ? I_WK : j == 2 ? I_WV : I_WO] + (size_t)l * 1024 * 1024;
            Wt = (u16*)(p.ws + (j == 0 ? OFF_WQ : j == 1 ? OFF_WK : j == 2 ? OFF_WV : OFF_WO)) + (size_t)l * 1024 * 1024;
            K = 1024; N = 1024; kt = r & 15; nt = r >> 4;
        }
        transpose_tile(W, K, N, Wt, kt * 64, nt * 64, (float*)lds);
    }
    const int wave = threadIdx.x >> 6, lane = threadIdx.x & 63;
    float* X = (float*)(p.ws + OFF_X);
    u16* Hb = (u16*)(p.ws + OFF_HB);
    u16* Mb = (u16*)(p.ws + OFF_MB);
    for (int it = blockIdx.x; it < (NR + 2048) / 4; it += G) {
        const int r = it * 4 + wave;
        if (r < NR) {
            const float* src = r < NP ? p.in[I_XP] + (size_t)r * 1024 : p.in[I_XS] + (size_t)(r - NP) * 1024;
            rowpass_row(src, nullptr, nullptr, nullptr, p.in[I_GPM], Hb + (size_t)r * 1024, lane);
        } else {
            const int m = r - NR;
            rowpass_row(p.in[I_MEM] + (size_t)m * 1024, nullptr, nullptr, nullptr, p.in[I_GMEM], Mb + (size_t)m * 1024, lane);
        }
    }
}

DEVINL void phase_gemm_in(const Params& p, int l, char* lds) {
    const u16* Hb = (const u16*)(p.ws + OFF_HB);
    const u16* Mb = (const u16*)(p.ws + OFF_MB);
    const u16* WinT = (const u16*)(p.ws + OFF_WIN) + (size_t)l * DINP * 1024;
    const u16* WkT = (const u16*)(p.ws + OFF_WK) + (size_t)l * 1024 * 1024;
    const u16* WvT = (const u16*)(p.ws + OFF_WV) + (size_t)l * 1024 * 1024;
    u16* U = (u16*)(p.ws + OFF_U);
    u16* MKb = (u16*)(p.ws + OFF_MK);
    u16* MVT = (u16*)(p.ws + OFF_MVT);
    float* omk = p.out + O_MKP + (size_t)l * 2048 * 1024;
    float* omv = p.out + O_MVP + (size_t)l * 2048 * 1024;
    constexpr int TU = 129 * 53;
    for_tiles_xcd(TU + 256, [&](int id) {
        if (id < TU) {
            int m, n; tile_mn(id, 129, 53, m, n);
            u16* dst = U + (size_t)m * 128 * DINP + n * 128;
            gemm_tile_b(Hb + (size_t)m * 128 * 1024, 1024, WinT + (size_t)n * 128 * 1024, 1024, 1024, lds, dst, DINP);
        } else {
            int id2 = id - TU; const int isv = id2 >> 7; id2 &= 127;
            const int m = id2 & 15, n = id2 >> 4;
            if (!isv) {
                float* df = omk + (size_t)m * 128 * 1024 + n * 128;
                u16* db = MKb + (size_t)m * 128 * 1024 + n * 128;
                gemm_tile(Mb + (size_t)m * 128 * 1024, 1024, WkT + (size_t)n * 128 * 1024, 1024, 1024, lds,
                          [&](int r, int c, f32x4 v) {
                              *(float4*)(df + (size_t)r * 1024 + c) = make_float4(v[0], v[1], v[2], v[3]);
                              *(uint2*)(db + (size_t)r * 1024 + c) = make_uint2(pack2(v[0], v[1]), pack2(v[2], v[3]));
                          });
            } else {
                float* df = omv + (size_t)m * 128 * 1024 + n * 128;
                gemm_tile(Mb + (size_t)m * 128 * 1024, 1024, WvT + (size_t)n * 128 * 1024, 1024, 1024, lds,
                          [&](int r, int c, f32x4 v) {
                              *(float4*)(df + (size_t)r * 1024 + c) = make_float4(v[0], v[1], v[2], v[3]);
                              const int row = m * 128 + r, col = n * 128 + c;
                              const int b = row >> 8, mm = row & 255, h = col >> 8, d = col & 255;
                              u16* t = MVT + ((size_t)((b * 4 + h) * 256 + d)) * 256 + mm;
                              t[0] = (u16)f2bf(v[0]); t[256] = (u16)f2bf(v[1]); t[512] = (u16)f2bf(v[2]); t[768] = (u16)f2bf(v[3]);
                          });
            }
        }
    });
}

DEVINL void phase_gemm_n1024(const u16* A, int K, const u16* Wt, float* Cf, u16* Cb, char* lds) {
    for_tiles_xcd(128 * 8, [&](int id) {
        int m, n; tile_mn(id, 128, 8, m, n);
        const size_t o = (size_t)m * 128 * 1024 + n * 128;
        if (Cf) {
            float* df = Cf + o;
            gemm_tile(A + (size_t)m * 128 * K, K, Wt + (size_t)n * 128 * K, K, K, lds,
                      [&](int r, int c, f32x4 v) { *(float4*)(df + (size_t)r * 1024 + c) = make_float4(v[0], v[1], v[2], v[3]); });
        } else {
            u16* db = Cb + o;
            gemm_tile_b(A + (size_t)m * 128 * K, K, Wt + (size_t)n * 128 * K, K, K, lds, db, 1024);
        }
    });
    const int tid = threadIdx.x, lane = tid & 63, w = tid >> 6, fr = lane & 15, fq = lane >> 4;
    float* red = (float*)lds;
    for (int pc = blockIdx.x; pc < 512; pc += gridDim.x) {
        const int row0 = NP + (pc >> 6) * 16, col0 = (pc & 63) * 16;
        const int kq = K >> 2;
        const u16* pa = A + (size_t)(row0 + fr) * K + w * kq + fq * 8;
        const u16* pb = Wt + (size_t)(col0 + fr) * K + w * kq + fq * 8;
        f32x4 acc = (f32x4){0.f, 0.f, 0.f, 0.f};
#pragma unroll 4
        for (int k = 0; k < kq; k += 32)
            acc = __builtin_amdgcn_mfma_f32_16x16x32_bf16(*(const bf16x8*)(pb + k), *(const bf16x8*)(pa + k), acc, 0, 0, 0);
        *(float4*)(red + (w * 64 + lane) * 4) = make_float4(acc[0], acc[1], acc[2], acc[3]);
        __syncthreads();
        if (w == 0) {
            const float4 a0 = *(const float4*)(red + lane * 4), a1 = *(const float4*)(red + (64 + lane) * 4), a2 = *(const float4*)(red + (128 + lane) * 4), a3 = *(const float4*)(red + (192 + lane) * 4);
            const float v0 = a0.x + a1.x + a2.x + a3.x, v1 = a0.y + a1.y + a2.y + a3.y, v2 = a0.z + a1.z + a2.z + a3.z, v3 = a0.w + a1.w + a2.w + a3.w;
            const size_t o = (size_t)(row0 + fr) * 1024 + col0 + fq * 4;
            if (Cf) *(float4*)(Cf + o) = make_float4(v0, v1, v2, v3);
            else *(uint2*)(Cb + o) = make_uint2(pack2(v0, v1), pack2(v2, v3));
        }
        __syncthreads();
    }
}

DEVINL float hgrn_lb(const Params& p, int l, int c) {
    if (l == 0) return 0.f;
    const float b0 = p.in[I_HLB][c], b1 = p.in[I_HLB][512 + c];
    return 1.0f / (1.0f + __expf(b0 - b1));
}

DEVINL void hgrn_prep_unit(const Params& p, int l, int u, char* lds) {
    const int c = u & 63, h = (u >> 6) & 3, b = u >> 8;
    const int tid = threadIdx.x;
    float* tot = (float*)lds;
    const u16* U = (const u16*)(p.ws + OFF_U);
    u16* QG = (u16*)(p.ws + OFF_HQG) + (size_t)u * 4096;
    u16* QM = (u16*)(p.ws + OFF_HQM) + (size_t)u * 4096;
    u16* KM = (u16*)(p.ws + OFF_HKM) + (size_t)u * 4096;
    u16* KD = (u16*)(p.ws + OFF_HKD) + (size_t)u * 4096;
    float* DS = (float*)(p.ws + OFF_HDS) + (size_t)u * 128;
    const int kp = (tid & 63) * 2, tq = tid >> 6;
    const float lb0 = hgrn_lb(p, l, h * 128 + kp), lb1 = hgrn_lb(p, l, h * 128 + kp + 1);
    const u16* pQ = U + ((size_t)b * SEQ + c * 32 + tq * 8) * DINP + 2048 + h * 128 + kp;
    uint32_t rq[8], rf[8];
#pragma unroll
    for (int i = 0; i < 8; ++i) { rq[i] = *(const uint32_t*)(pQ + (size_t)i * DINP); rf[i] = *(const uint32_t*)(pQ + (size_t)i * DINP + 512); }
    float f0[8], f1[8], L0[8], L1[8];
    {
        float a0 = 0.f, a1 = 0.f;
#pragma unroll
        for (int i = 0; i < 8; ++i) {
            f0[i] = lb0 + (1.f - lb0) * sigmoidf_(lo16(rf[i]));
            f1[i] = lb1 + (1.f - lb1) * sigmoidf_(hi16(rf[i]));
            a0 += __logf(f0[i]); a1 += __logf(f1[i]);
            L0[i] = a0; L1[i] = a1;
        }
        *(float2*)(tot + tq * 128 + kp) = make_float2(a0, a1);
    }
    __syncthreads();
    {
        const float2 t0 = *(const float2*)(tot + kp), t1 = *(const float2*)(tot + 128 + kp), t2 = *(const float2*)(tot + 256 + kp), t3 = *(const float2*)(tot + 384 + kp);
        const float off0 = (tq > 0 ? t0.x : 0.f) + (tq > 1 ? t1.x : 0.f) + (tq > 2 ? t2.x : 0.f);
        const float off1 = (tq > 0 ? t0.y : 0.f) + (tq > 1 ? t1.y : 0.f) + (tq > 2 ? t2.y : 0.f);
        const float ref0 = t0.x + t1.x, ref1 = t0.y + t1.y;
        const float last0 = ref0 + t2.x + t3.x, last1 = ref1 + t2.y + t3.y;
        uint32_t kd[8];
#pragma unroll
        for (int i = 0; i < 8; ++i) {
            const int t = tq * 8 + i;
            const float G0 = L0[i] + off0, G1 = L1[i] + off1;
            const float q0 = lo16(rq[i]), q1 = hi16(rq[i]);
            const float k0 = 1.f - f0[i], k1 = 1.f - f1[i];
            *(uint32_t*)(QG + t * 128 + kp) = pack2(q0 * __expf(G0), q1 * __expf(G1));
            *(uint32_t*)(QM + t * 128 + kp) = pack2(q0 * __expf(fminf(G0 - ref0, 60.f)), q1 * __expf(fminf(G1 - ref1, 60.f)));
            *(uint32_t*)(KM + t * 128 + kp) = pack2(k0 * __expf(fminf(ref0 - G0, 60.f)), k1 * __expf(fminf(ref1 - G1, 60.f)));
            kd[i] = pack2(k0 * __expf(last0 - G0), k1 * __expf(last1 - G1));
        }
        *(uint4*)(KD + kp * 32 + tq * 8) = make_uint4((kd[0] & 0xffffu) | (kd[1] << 16), (kd[2] & 0xffffu) | (kd[3] << 16), (kd[4] & 0xffffu) | (kd[5] << 16), (kd[6] & 0xffffu) | (kd[7] << 16));
        *(uint4*)(KD + (kp + 1) * 32 + tq * 8) = make_uint4((kd[0] >> 16) | (kd[1] & 0xffff0000u), (kd[2] >> 16) | (kd[3] & 0xffff0000u), (kd[4] >> 16) | (kd[5] & 0xffff0000u), (kd[6] >> 16) | (kd[7] & 0xffff0000u));
        if (tq == 0) *(float2*)(DS + kp) = make_float2(__expf(last0), __expf(last1));
    }
    __syncthreads();
}

DEVINL void phase_prep(const Params& p, int l, char* lds) {
    for (int u = blockIdx.x; u < 2048; u += gridDim.x) hgrn_prep_unit(p, l, u, lds);
    const u16* U = (const u16*)(p.ws + OFF_U);
    u16* Ycat = (u16*)(p.ws + OFF_YCAT);
    float* XBC = (float*)(p.ws + OFF_XBC);
    float* DT = (float*)(p.ws + OFF_DT);
    const int tid = threadIdx.x;
#pragma unroll 1
    for (int it = blockIdx.x; it < 1024; it += gridDim.x) {
        const int b = it >> 7, t0 = (it & 127) * 16;
        const size_t r0 = (size_t)b * SEQ + t0;
        if (tid < 64) {
            const int c0 = tid * 8;
            const float* cw = p.in[I_CAW] + (size_t)l * 3 * 512 + c0;
            float w0[8], w1[8], w2[8], pm2[8], pm1[8];
            {
                const float4 a0 = *(const float4*)cw, a1 = *(const float4*)(cw + 4), b0 = *(const float4*)(cw + 512), b1 = *(const float4*)(cw + 516), d0 = *(const float4*)(cw + 1024), d1 = *(const float4*)(cw + 1028);
                w0[0] = a0.x; w0[1] = a0.y; w0[2] = a0.z; w0[3] = a0.w; w0[4] = a1.x; w0[5] = a1.y; w0[6] = a1.z; w0[7] = a1.w;
                w1[0] = b0.x; w1[1] = b0.y; w1[2] = b0.z; w1[3] = b0.w; w1[4] = b1.x; w1[5] = b1.y; w1[6] = b1.z; w1[7] = b1.w;
                w2[0] = d0.x; w2[1] = d0.y; w2[2] = d0.z; w2[3] = d0.w; w2[4] = d1.x; w2[5] = d1.y; w2[6] = d1.z; w2[7] = d1.w;
            }
            if (t0 > 0) {
                const u16* Uq = U + (r0 - 2) * DINP;
                const uint4 h2 = *(const uint4*)(Uq + c0), c2 = *(const uint4*)(Uq + 1024 + c0), h1 = *(const uint4*)(Uq + DINP + c0), c1 = *(const uint4*)(Uq + DINP + 1024 + c0);
                float fh[8], fc[8];
                UNPACK8(h2, fh); UNPACK8(c2, fc);
#pragma unroll
                for (int i = 0; i < 8; ++i) pm2[i] = fc[i] * fh[i];
                UNPACK8(h1, fh); UNPACK8(c1, fc);
#pragma unroll
                for (int i = 0; i < 8; ++i) pm1[i] = fc[i] * fh[i];
            } else {
#pragma unroll
                for (int i = 0; i < 8; ++i) { pm2[i] = 0.f; pm1[i] = 0.f; }
            }
            const float dtb = (tid < 16) ? p.in[I_DTB][l * 16 + tid] : 0.f;
#pragma unroll 4
            for (int j = 0; j < 16; ++j) {
                const u16* Ur = U + (r0 + j) * DINP;
                const uint4 vh = *(const uint4*)(Ur + c0), vc = *(const uint4*)(Ur + 1024 + c0), vb = *(const uint4*)(Ur + 512 + c0), vz = *(const uint4*)(Ur + 1536 + c0);
                float fh[8], fc[8], fb[8], fz[8], pc[8], y[8];
                UNPACK8(vh, fh); UNPACK8(vc, fc); UNPACK8(vb, fb); UNPACK8(vz, fz);
#pragma unroll
                for (int i = 0; i < 8; ++i) {
                    pc[i] = fc[i] * fh[i];
                    const float cv = w0[i] * pm2[i] + w1[i] * pm1[i] + w2[i] * pc[i];
                    y[i] = fb[i] * cv * siluf_(fz[i]);
                    pm2[i] = pm1[i]; pm1[i] = pc[i];
                }
                *(uint4*)(Ycat + (r0 + j) * 2048 + c0) = make_uint4(pack2(y[0], y[1]), pack2(y[2], y[3]), pack2(y[4], y[5]), pack2(y[6], y[7]));
                if (t0 + j >= SEQ - 2) {
                    float* o = p.out + O_CAP + (((size_t)l * 8 + b) * 2 + (t0 + j - (SEQ - 2))) * 512 + c0;
                    *(float4*)o = make_float4(pc[0], pc[1], pc[2], pc[3]);
                    *(float4*)(o + 4) = make_float4(pc[4], pc[5], pc[6], pc[7]);
                }
                if (tid < 16) {
                    const float xx = bf2f(Ur[6656 + tid]) + dtb;
                    DT[(r0 + j) * 16 + tid] = xx > 20.f ? xx : log1pf(__expf(xx));
                }
            }
        } else {
            const int c0 = (tid - 64) * 8;
            const float* cw = p.in[I_SCW] + (size_t)l * 4 * 1536 + c0;
            const float* cb = p.in[I_SCB] + (size_t)l * 1536 + c0;
            float w0[8], w1[8], w2[8], w3[8], bs[8], x3[8], x2[8], x1[8];
#pragma unroll
            for (int i = 0; i < 8; ++i) { w0[i] = cw[i]; w1[i] = cw[1536 + i]; w2[i] = cw[3072 + i]; w3[i] = cw[4608 + i]; bs[i] = cb[i]; }
            if (t0 > 0) {
                const u16* Uq = U + (r0 - 3) * DINP + 5120 + c0;
                const uint4 v3 = *(const uint4*)Uq, v2 = *(const uint4*)(Uq + DINP), v1 = *(const uint4*)(Uq + 2 * (size_t)DINP);
                UNPACK8(v3, x3); UNPACK8(v2, x2); UNPACK8(v1, x1);
            } else {
#pragma unroll
                for (int i = 0; i < 8; ++i) { x3[i] = 0.f; x2[i] = 0.f; x1[i] = 0.f; }
            }
#pragma unroll 4
            for (int j = 0; j < 16; ++j) {
                const uint4 v = *(const uint4*)(U + (r0 + j) * DINP + 5120 + c0);
                float x0[8], y[8];
                UNPACK8(v, x0);
#pragma unroll
                for (int i = 0; i < 8; ++i) {
                    y[i] = siluf_(w0[i] * x3[i] + w1[i] * x2[i] + w2[i] * x1[i] + w3[i] * x0[i] + bs[i]);
                    x3[i] = x2[i]; x2[i] = x1[i]; x1[i] = x0[i];
                }
                *(uint4*)((u16*)(p.ws + OFF_XBCB) + (r0 + j) * 1536 + c0) = make_uint4(pack2(y[0], y[1]), pack2(y[2], y[3]), pack2(y[4], y[5]), pack2(y[6], y[7]));
                if (t0 + j >= SEQ - 3) {
                    float* o = p.out + O_SCP + (((size_t)l * 8 + b) * 3 + (t0 + j - (SEQ - 3))) * 1536 + c0;
                    *(float4*)o = make_float4(x0[0], x0[1], x0[2], x0[3]);
                    *(float4*)(o + 4) = make_float4(x0[4], x0[5], x0[6], x0[7]);
                }
            }
        }
    }
    for (int r = NP + blockIdx.x; r < NR; r += gridDim.x) {
        const bool prompt = false;
        const int t = r & (SEQ - 1), b = r >> 11, s = r - NP;
        const u16* Ur = U + (size_t)r * DINP;
        if (tid < 64) {
            const int c0 = tid * 8;
            float pv[3][8];
#pragma unroll
            for (int j = 0; j < 3; ++j) {
                const int back = 2 - j;
                if (prompt ? (t - back >= 0) : (back == 0)) {
                    const u16* Uq = Ur - (size_t)back * DINP;
                    const uint4 vh = *(const uint4*)(Uq + c0), vc = *(const uint4*)(Uq + 1024 + c0);
                    float fh[8], fc[8]; UNPACK8(vh, fh); UNPACK8(vc, fc);
#pragma unroll
                    for (int i = 0; i < 8; ++i) pv[j][i] = fc[i] * fh[i];
                } else if (prompt) {
#pragma unroll
                    for (int i = 0; i < 8; ++i) pv[j][i] = 0.f;
                } else {
                    const float* st = p.in[I_SCA] + (((size_t)l * NS + s) * 2 + j) * 512 + c0;
                    const float4 a = *(const float4*)st, bb = *(const float4*)(st + 4);
                    pv[j][0] = a.x; pv[j][1] = a.y; pv[j][2] = a.z; pv[j][3] = a.w; pv[j][4] = bb.x; pv[j][5] = bb.y; pv[j][6] = bb.z; pv[j][7] = bb.w;
                }
            }
            const float* cw = p.in[I_CAW] + (size_t)l * 3 * 512 + c0;
            const uint4 vb = *(const uint4*)(Ur + 512 + c0), vz = *(const uint4*)(Ur + 1536 + c0);
            float fb[8], fz[8]; UNPACK8(vb, fb); UNPACK8(vz, fz);
            float y[8];
#pragma unroll
            for (int i = 0; i < 8; ++i) {
                const float cv = cw[i] * pv[0][i] + cw[512 + i] * pv[1][i] + cw[1024 + i] * pv[2][i];
                y[i] = fb[i] * cv * siluf_(fz[i]);
            }
            *(uint4*)(Ycat + (size_t)r * 2048 + c0) = make_uint4(pack2(y[0], y[1]), pack2(y[2], y[3]), pack2(y[4], y[5]), pack2(y[6], y[7]));
            if (prompt) {
                if (t >= SEQ - 2) {
                    float* o = p.out + O_CAP + (((size_t)l * 8 + b) * 2 + (t - (SEQ - 2))) * 512 + c0;
                    *(float4*)o = make_float4(pv[2][0], pv[2][1], pv[2][2], pv[2][3]);
                    *(float4*)(o + 4) = make_float4(pv[2][4], pv[2][5], pv[2][6], pv[2][7]);
                }
            } else {
                float* o = p.out + O_CAS + (((size_t)l * NS + s) * 2) * 512 + c0;
                *(float4*)o = make_float4(pv[1][0], pv[1][1], pv[1][2], pv[1][3]);
                *(float4*)(o + 4) = make_float4(pv[1][4], pv[1][5], pv[1][6], pv[1][7]);
                *(float4*)(o + 512) = make_float4(pv[2][0], pv[2][1], pv[2][2], pv[2][3]);
                *(float4*)(o + 516) = make_float4(pv[2][4], pv[2][5], pv[2][6], pv[2][7]);
            }
        } else {
            const int c0 = (tid - 64) * 8;
            float xv[4][8];
#pragma unroll
            for (int j = 0; j < 4; ++j) {
                const int back = 3 - j;
                if (prompt ? (t - back >= 0) : (back == 0)) {
                    const uint4 v = *(const uint4*)(Ur - (size_t)back * DINP + 5120 + c0);
                    UNPACK8(v, xv[j]);
                } else if (prompt) {
#pragma unroll
                    for (int i = 0; i < 8; ++i) xv[j][i] = 0.f;
                } else {
                    const float* st = p.in[I_SSC] + (((size_t)l * NS + s) * 3 + j) * 1536 + c0;
                    const float4 a = *(const float4*)st, bb = *(const float4*)(st + 4);
                    xv[j][0] = a.x; xv[j][1] = a.y; xv[j][2] = a.z; xv[j][3] = a.w; xv[j][4] = bb.x; xv[j][5] = bb.y; xv[j][6] = bb.z; xv[j][7] = bb.w;
                }
            }
            const float* cw = p.in[I_SCW] + (size_t)l * 4 * 1536 + c0;
            const float* cb = p.in[I_SCB] + (size_t)l * 1536 + c0;
            float y[8];
#pragma unroll
            for (int i = 0; i < 8; ++i) {
                const float cv = cw[i] * xv[0][i] + cw[1536 + i] * xv[1][i] + cw[3072 + i] * xv[2][i] + cw[4608 + i] * xv[3][i] + cb[i];
                y[i] = siluf_(cv);
            }
            if (!prompt) {
                float* xo = XBC + (size_t)r * 1536 + c0;
                *(float4*)xo = make_float4(y[0], y[1], y[2], y[3]);
                *(float4*)(xo + 4) = make_float4(y[4], y[5], y[6], y[7]);
            }
            *(uint4*)((u16*)(p.ws + OFF_XBCB) + (size_t)r * 1536 + c0) = make_uint4(pack2(y[0], y[1]), pack2(y[2], y[3]), pack2(y[4], y[5]), pack2(y[6], y[7]));
            if (prompt) {
                if (t >= SEQ - 3) {
                    float* o = p.out + O_SCP + (((size_t)l * 8 + b) * 3 + (t - (SEQ - 3))) * 1536 + c0;
                    *(float4*)o = make_float4(xv[3][0], xv[3][1], xv[3][2], xv[3][3]);
                    *(float4*)(o + 4) = make_float4(xv[3][4], xv[3][5], xv[3][6], xv[3][7]);
                }
            } else {
                float* o = p.out + O_SCS + (((size_t)l * NS + s) * 3) * 1536 + c0;
#pragma unroll
                for (int j = 0; j < 3; ++j) {
                    *(float4*)(o + j * 1536) = make_float4(xv[j + 1][0], xv[j + 1][1], xv[j + 1][2], xv[j + 1][3]);
                    *(float4*)(o + j * 1536 + 4) = make_float4(xv[j + 1][4], xv[j + 1][5], xv[j + 1][6], xv[j + 1][7]);
                }
            }
        }
        if (tid < 16) {
            const float xx = bf2f(Ur[6656 + tid]) + p.in[I_DTB][l * 16 + tid];
            DT[(size_t)r * 16 + tid] = xx > 20.f ? xx : log1pf(__expf(xx));
        }
    }
}


DEVINL void hgrn_prompt_item(const Params& p, int l, int item, char* lds) {
    const int b = item >> 5, h = (item >> 3) & 3, vs = item & 7;
    const int tid = threadIdx.x, lane = tid & 63, wave = tid >> 6;
    const int vl = wave * 4 + (lane >> 4), kg = lane & 15;
    float* fS = (float*)lds;
    float* qS = fS + 2048;
    float* vS = qS + 2048;
    float* part = vS + 256;
    const u16* U = (const u16*)(p.ws + OFF_U);
    float* OB = (float*)(p.ws + OFF_OB);
    const int tl = tid >> 4, kc = (tid & 15) * 8, vi = tid & 15;
    float lbv[8];
#pragma unroll
    for (int j = 0; j < 8; ++j) lbv[j] = hgrn_lb(p, l, h * 128 + kc + j);
    const size_t rowb = (size_t)b * SEQ;
    const u16* Uq = U + (rowb + tl) * DINP + 2048 + h * 128 + kc;
    const u16* Uv = U + (rowb + tl) * DINP + 3072 + h * 128 + vs * 16 + vi;
    float S[8];
#pragma unroll
    for (int i = 0; i < 8; ++i) S[i] = 0.f;
    uint4 rq = *(const uint4*)Uq, rf = *(const uint4*)(Uq + 512);
    u16 rv = *Uv;
    for (int c = 0; c < SEQ / 16; ++c) {
        {
            float q[8], g[8]; UNPACK8(rq, q); UNPACK8(rf, g);
#pragma unroll
            for (int j = 0; j < 8; ++j) g[j] = lbv[j] + (1.0f - lbv[j]) * sigmoidf_(g[j]);
            *(float4*)(qS + tl * 128 + kc) = make_float4(q[0], q[1], q[2], q[3]);
            *(float4*)(qS + tl * 128 + kc + 4) = make_float4(q[4], q[5], q[6], q[7]);
            *(float4*)(fS + tl * 128 + kc) = make_float4(g[0], g[1], g[2], g[3]);
            *(float4*)(fS + tl * 128 + kc + 4) = make_float4(g[4], g[5], g[6], g[7]);
            vS[tl * 16 + vi] = bf2f(rv);
        }
        if (c + 1 < SEQ / 16) {
            const size_t adv = (size_t)(c + 1) * 16 * DINP;
            rq = *(const uint4*)(Uq + adv); rf = *(const uint4*)(Uq + adv + 512); rv = *(Uv + adv);
        }
        __syncthreads();
#pragma unroll 1
        for (int tg = 0; tg < 16; tg += 4) {
        float pa[4];
#pragma unroll
        for (int tt = 0; tt < 4; ++tt) {
            const int t = tg + tt;
            const float4 f0 = *(const float4*)(fS + t * 128 + kg * 4), f1 = *(const float4*)(fS + t * 128 + 64 + kg * 4);
            const float4 q0 = *(const float4*)(qS + t * 128 + kg * 4), q1 = *(const float4*)(qS + t * 128 + 64 + kg * 4);
            const float vv = vS[t * 16 + vl];
            S[0] = f0.x * S[0] + (1.f - f0.x) * vv; S[1] = f0.y * S[1] + (1.f - f0.y) * vv;
            S[2] = f0.z * S[2] + (1.f - f0.z) * vv; S[3] = f0.w * S[3] + (1.f - f0.w) * vv;
            S[4] = f1.x * S[4] + (1.f - f1.x) * vv; S[5] = f1.y * S[5] + (1.f - f1.y) * vv;
            S[6] = f1.z * S[6] + (1.f - f1.z) * vv; S[7] = f1.w * S[7] + (1.f - f1.w) * vv;
            float a = q0.x * S[0] + q0.y * S[1] + q0.z * S[2] + q0.w * S[3];
            a += q1.x * S[4] + q1.y * S[5] + q1.z * S[6] + q1.w * S[7];
            pa[tt] = a;
        }
#pragma unroll
        for (int tt = 0; tt < 4; ++tt) part[(tg + tt) * 256 + vl * 16 + kg] = pa[tt];
        }
        __syncthreads();
        {
            const float* pp = part + tl * 256 + vi * 16;
            const float4 a = *(const float4*)pp, bq = *(const float4*)(pp + 4), cq = *(const float4*)(pp + 8), dq = *(const float4*)(pp + 12);
            const float o = (a.x + a.y + a.z + a.w) + (bq.x + bq.y + bq.z + bq.w) + (cq.x + cq.y + cq.z + cq.w) + (dq.x + dq.y + dq.z + dq.w);
            OB[(rowb + c * 16 + tl) * 512 + h * 128 + vs * 16 + vi] = o;
        }
    }
    float* so = p.out + O_HGP + (((size_t)l * 8 + b) * 4 + h) * 128 * 128;
#pragma unroll
    for (int i = 0; i < 4; ++i) {
        so[(size_t)(kg * 4 + i) * 128 + vs * 16 + vl] = S[i];
        so[(size_t)(64 + kg * 4 + i) * 128 + vs * 16 + vl] = S[4 + i];
    }
    __syncthreads();
}

DEVINL void ssd_prompt_item(const Params& p, int l, int item, char* lds) {
    const int b = item >> 5, head = (item >> 1) & 15, ph = item & 1, g = head >> 3;
    const int tid = threadIdx.x;
    const int pl = tid >> 3, ng = tid & 7;
    float* Bs = (float*)lds;
    float* Cs = Bs + 2048;
    float* xs = Cs + 2048;
    float* xd = xs + 512;
    float* dcs = xd + 512;
    float* part = dcs + 64;
    const float* XBC = (const float*)(p.ws + OFF_XBC);
    const float* DT = (const float*)(p.ws + OFF_DT);
    const u16* U = (const u16*)(p.ws + OFF_U);
    float* YC = (float*)(p.ws + OFF_YC);
    const float Aneg = -__expf(p.in[I_ALOG][l * 16 + head]);
    const float Dsk = p.in[I_DSK][l * 16 + head];
    const int tl = tid >> 4, nc = (tid & 15) * 8, xc = (tid & 15) * 2;
    const size_t rowb = (size_t)b * SEQ;
    const float* pB = XBC + (rowb + tl) * 1536 + 1024 + g * 128 + nc;
    const float* pX = XBC + (rowb + tl) * 1536 + head * 64 + ph * 32 + xc;
    const float* pD = DT + (rowb + tl) * 16 + head;
    float S[16];
#pragma unroll
    for (int i = 0; i < 16; ++i) S[i] = 0.f;
    float4 rb0 = *(const float4*)pB, rb1 = *(const float4*)(pB + 4), rc0 = *(const float4*)(pB + 256), rc1 = *(const float4*)(pB + 260);
    float2 rx = *(const float2*)pX;
    float rd = *pD;
    for (int c = 0; c < SEQ / 16; ++c) {
        *(float4*)(Bs + tl * 128 + nc) = rb0; *(float4*)(Bs + tl * 128 + nc + 4) = rb1;
        *(float4*)(Cs + tl * 128 + nc) = rc0; *(float4*)(Cs + tl * 128 + nc + 4) = rc1;
        xs[tl * 32 + xc] = rx.x; xs[tl * 32 + xc + 1] = rx.y;
        xd[tl * 32 + xc] = rx.x * rd; xd[tl * 32 + xc + 1] = rx.y * rd;
        if ((tid & 15) == 0) dcs[tl] = __expf(rd * Aneg);
        if (c + 1 < SEQ / 16) {
            const size_t adv = (size_t)(c + 1) * 16;
            const float* qB = pB + adv * 1536;
            rb0 = *(const float4*)qB; rb1 = *(const float4*)(qB + 4); rc0 = *(const float4*)(qB + 256); rc1 = *(const float4*)(qB + 260);
            rx = *(const float2*)(pX + adv * 1536);
            rd = *(pD + adv * 16);
        }
        __syncthreads();
#pragma unroll 1
        for (int tg = 0; tg < 16; tg += 4) {
        float pa[4];
#pragma unroll
        for (int tt = 0; tt < 4; ++tt) {
            const int t = tg + tt;
            const float dec = dcs[t], xdt = xd[t * 32 + pl];
            float a = 0.f;
#pragma unroll
            for (int j = 0; j < 4; ++j) {
                const float4 Bv = *(const float4*)(Bs + t * 128 + j * 32 + ng * 4);
                const float4 Cv = *(const float4*)(Cs + t * 128 + j * 32 + ng * 4);
                S[j * 4 + 0] = dec * S[j * 4 + 0] + xdt * Bv.x; S[j * 4 + 1] = dec * S[j * 4 + 1] + xdt * Bv.y;
                S[j * 4 + 2] = dec * S[j * 4 + 2] + xdt * Bv.z; S[j * 4 + 3] = dec * S[j * 4 + 3] + xdt * Bv.w;
                a += Cv.x * S[j * 4 + 0] + Cv.y * S[j * 4 + 1] + Cv.z * S[j * 4 + 2] + Cv.w * S[j * 4 + 3];
            }
            pa[tt] = a;
        }
#pragma unroll
        for (int tt = 0; tt < 4; ++tt) part[(tg + tt) * 256 + tid] = pa[tt];
        }
        __syncthreads();
#pragma unroll
        for (int i = 0; i < 2; ++i) {
            const int idx = tid + 256 * i, t2 = idx >> 5, p2 = idx & 31;
            const float4 a = *(const float4*)(part + t2 * 256 + p2 * 8), bq = *(const float4*)(part + t2 * 256 + p2 * 8 + 4);
            const float y = (a.x + a.y + a.z + a.w) + (bq.x + bq.y + bq.z + bq.w) + Dsk * xs[t2 * 32 + p2];
            const size_t row = rowb + c * 16 + t2;
            const float z = bf2f(U[row * DINP + 4096 + head * 64 + ph * 32 + p2]);
            YC[row * 1024 + head * 64 + ph * 32 + p2] = y * siluf_(z);
        }
        __syncthreads();
    }
    float* so = p.out + O_SSP + ((((size_t)l * 8 + b) * 16 + head) * 64 + ph * 32 + pl) * 128;
#pragma unroll
    for (int j = 0; j < 4; ++j) *(float4*)(so + j * 32 + ng * 4) = make_float4(S[j * 4], S[j * 4 + 1], S[j * 4 + 2], S[j * 4 + 3]);
}

DEVINL void hgrn_sample_item(const Params& p, int l, int item, char* lds) {
    const int s = item >> 2, h = item & 3;
    const int tid = threadIdx.x;
    float* qs = (float*)lds; float* fs = qs + 128; float* vs = fs + 128; float* red = vs + 128;
    const u16* Ur = (const u16*)(p.ws + OFF_U) + (size_t)(NP + s) * DINP;
    if (tid < 128) {
        qs[tid] = bf2f(Ur[2048 + h * 128 + tid]);
        const float lb = hgrn_lb(p, l, h * 128 + tid);
        fs[tid] = lb + (1.f - lb) * sigmoidf_(bf2f(Ur[2560 + h * 128 + tid]));
        vs[tid] = bf2f(Ur[3072 + h * 128 + tid]);
    }
    __syncthreads();
    const int v4 = (tid & 31) * 4, kr = tid >> 5;
    const size_t sb = (((size_t)l * NS + s) * 4 + h) * 128 * 128;
    const float* Sin = p.in[I_SHG] + sb;
    float* Sout = p.out + O_HGS + sb;
    const float4 vv = *(const float4*)(vs + v4);
    float4 acc = make_float4(0.f, 0.f, 0.f, 0.f);
#pragma unroll 1
    for (int hb = 0; hb < 2; ++hb) {
        float4 so[8];
#pragma unroll
        for (int i = 0; i < 8; ++i) so[i] = ldnt4(Sin + (size_t)(kr + 8 * (hb * 8 + i)) * 128 + v4);
#pragma unroll
        for (int i = 0; i < 8; ++i) {
            const int k = kr + 8 * (hb * 8 + i);
            const float f = fs[k], kk = 1.f - f, q = qs[k];
            float4 sn;
            sn.x = f * so[i].x + kk * vv.x; sn.y = f * so[i].y + kk * vv.y; sn.z = f * so[i].z + kk * vv.z; sn.w = f * so[i].w + kk * vv.w;
            stnt4(Sout + (size_t)k * 128 + v4, sn);
            acc.x += q * sn.x; acc.y += q * sn.y; acc.z += q * sn.z; acc.w += q * sn.w;
        }
    }
    *(float4*)(red + kr * 128 + v4) = acc;
    __syncthreads();
    if (tid < 128) {
        float o = 0.f;
#pragma unroll
        for (int i = 0; i < 8; ++i) o += red[i * 128 + tid];
        ((u16*)(p.ws + OFF_OB))[(size_t)(NP + s) * 512 + h * 128 + tid] = (u16)f2bf(o);
    }
    __syncthreads();
}

DEVINL void ssd_sample_item(const Params& p, int l, int item) {
    const int s = item >> 4, head = item & 15, g = head >> 3;
    const int tid = threadIdx.x;
    const size_t row = NP + s;
    const float* xr = (const float*)(p.ws + OFF_XBC) + row * 1536;
    const float dt = ((const float*)(p.ws + OFF_DT))[row * 16 + head];
    const float dec = __expf(-__expf(p.in[I_ALOG][l * 16 + head]) * dt);
    const float Dsk = p.in[I_DSK][l * 16 + head];
    const int n4 = (tid & 31) * 4, pr = tid >> 5;
    const float4 Bv = *(const float4*)(xr + 1024 + g * 128 + n4), Cv = *(const float4*)(xr + 1280 + g * 128 + n4);
    const size_t sb = (((size_t)l * NS + s) * 16 + head) * 64 * 128;
    const float* Sin = p.in[I_SSS] + sb;
    float* Sout = p.out + O_SSS + sb;
    const u16* Ur = (const u16*)(p.ws + OFF_U) + row * DINP;
    u16* YC = (u16*)(p.ws + OFF_YC);
    float4 so[8];
#pragma unroll
    for (int i = 0; i < 8; ++i) so[i] = ldnt4(Sin + (size_t)(pr + 8 * i) * 128 + n4);
#pragma unroll
    for (int i = 0; i < 8; ++i) {
        const int pp = pr + 8 * i;
        const float x = xr[head * 64 + pp], xdt = x * dt;
        float4 sn;
        sn.x = dec * so[i].x + xdt * Bv.x; sn.y = dec * so[i].y + xdt * Bv.y; sn.z = dec * so[i].z + xdt * Bv.z; sn.w = dec * so[i].w + xdt * Bv.w;
        stnt4(Sout + (size_t)pp * 128 + n4, sn);
        float a = Cv.x * sn.x + Cv.y * sn.y + Cv.z * sn.z + Cv.w * sn.w;
#pragma unroll
        for (int o = 16; o; o >>= 1) a += __shfl_xor(a, o);
        if ((tid & 31) == 0) {
            const float y = a + Dsk * x;
            const float z = bf2f(Ur[4096 + head * 64 + pp]);
            YC[row * 1024 + head * 64 + pp] = (u16)f2bf(y * siluf_(z));
        }
    }
}


DEVINL bf16x8 ldfrag(const u16* base, int ld, int row, int k) { return *(const bf16x8*)(base + row * ld + k); }
DEVINL void st4bf(u16* dst, float a, float b, float c, float d) { *(uint2*)dst = make_uint2(pack2(a, b), pack2(c, d)); }

DEVINL void ssd_prompt_mfma(const Params& p, int l, int item, char* lds) {
    const int b = item >> 5, head = (item >> 1) & 15, ph = item & 1, g = head >> 3;
    const int tid = threadIdx.x, lane = tid & 63, w = tid >> 6, fr = lane & 15, fq = lane >> 4;
    u16* Cs = (u16*)lds;
    u16* Bs = Cs + 32 * 136;
    u16* Sb = Bs + 32 * 136;
    u16* BT = Sb + 32 * 136;
    u16* XT = BT + 128 * 40;
    u16* XW = XT + 32 * 40;
    u16* Ms = XW + 32 * 40;
    float* csS = (float*)(Ms + 32 * 40);
    float* dtS = csS + 32;
    const u16* XB = (const u16*)(p.ws + OFF_XBCB);
    const float* DT = (const float*)(p.ws + OFF_DT);
    const u16* U = (const u16*)(p.ws + OFF_U);
    u16* YC = (u16*)(p.ws + OFF_YC);
    const float Aneg = -__expf(p.in[I_ALOG][l * 16 + head]);
    const float Dsk = p.in[I_DSK][l * 16 + head];
    const size_t rowb = (size_t)b * SEQ;
    const int srow = tid >> 3, sc = tid & 7;
    const int ti = w >> 1, pi = w & 1;
    for (int i = tid; i < 32 * 136 / 2; i += 256) ((uint32_t*)Sb)[i] = 0u;
    f32x4 Sacc[2][2];
#pragma unroll
    for (int a = 0; a < 2; ++a)
#pragma unroll
        for (int c = 0; c < 2; ++c) Sacc[a][c] = (f32x4){0.f, 0.f, 0.f, 0.f};
    const u16* pC = XB + (rowb + srow) * 1536 + 1280 + g * 128 + sc * 16;
    const u16* pB = XB + (rowb + srow) * 1536 + 1024 + g * 128 + sc * 16;
    const u16* pX = XB + (rowb + srow) * 1536 + head * 64 + ph * 32 + sc * 4;
    const float* pD = DT + (rowb + (lane & 31)) * 16 + head;
    const u16* pZ = U + (rowb + ti * 16 + fr) * DINP + 4096 + head * 64 + ph * 32 + pi * 16 + fq * 4;
    const u16* pXs = XB + (rowb + ti * 16 + fr) * 1536 + head * 64 + ph * 32 + pi * 16 + fq * 4;
#define SSD_LD(S, CC) do { const size_t adv = (size_t)(CC) * 32; \
        S##C0 = *(const uint4*)(pC + adv * 1536); S##C1 = *(const uint4*)(pC + adv * 1536 + 8); \
        S##B0 = *(const uint4*)(pB + adv * 1536); S##B1 = *(const uint4*)(pB + adv * 1536 + 8); \
        S##x = *(const uint2*)(pX + adv * 1536); S##z = *(const uint2*)(pZ + adv * DINP); S##xs = *(const uint2*)(pXs + adv * 1536); \
        S##dt = *(pD + adv * 16); } while (0)
    uint4 aC0, aC1, aB0, aB1, bC0, bC1, bB0, bB1; uint2 ax, az, axs, bx, bz, bxs; float adt, bdt;
    SSD_LD(a, 0); SSD_LD(b, 1);
    auto stage = [&](uint4 rC0, uint4 rC1, uint4 rB0, uint4 rB1, float rdt) __attribute__((always_inline)) {
        *(uint4*)(Cs + srow * 136 + sc * 16) = rC0; *(uint4*)(Cs + srow * 136 + sc * 16 + 8) = rC1;
        *(uint4*)(Bs + srow * 136 + sc * 16) = rB0; *(uint4*)(Bs + srow * 136 + sc * 16 + 8) = rB1;
        {
            const uint32_t bw[8] = {rB0.x, rB0.y, rB0.z, rB0.w, rB1.x, rB1.y, rB1.z, rB1.w};
#pragma unroll
            for (int j = 0; j < 8; ++j) {
                BT[(sc * 16 + 2 * j) * 40 + srow] = (u16)(bw[j] & 0xffffu);
                BT[(sc * 16 + 2 * j + 1) * 40 + srow] = (u16)(bw[j] >> 16);
            }
        }
        if (w == 0) {
            float a = rdt * Aneg;
#pragma unroll
            for (int o = 1; o < 32; o <<= 1) { const float v = __shfl_up(a, o); if ((lane & 31) >= o) a += v; }
            if (lane < 32) { csS[lane] = a; dtS[lane] = rdt; }
        }
    };
    auto rest = [&](int c, uint2 cx, uint2 cz, uint2 cxs) __attribute__((always_inline)) {
        lds_barrier();
        const float cs31 = csS[31];
        {
            const float wgt = dtS[srow] * __expf(cs31 - csS[srow]);
            const float x0 = lo16(cx.x), x1 = hi16(cx.x), x2 = lo16(cx.y), x3 = hi16(cx.y);
            XT[(sc * 4 + 0) * 40 + srow] = (u16)(cx.x & 0xffffu); XT[(sc * 4 + 1) * 40 + srow] = (u16)(cx.x >> 16);
            XT[(sc * 4 + 2) * 40 + srow] = (u16)(cx.y & 0xffffu); XT[(sc * 4 + 3) * 40 + srow] = (u16)(cx.y >> 16);
            XW[(sc * 4 + 0) * 40 + srow] = (u16)f2bf(x0 * wgt); XW[(sc * 4 + 1) * 40 + srow] = (u16)f2bf(x1 * wgt);
            XW[(sc * 4 + 2) * 40 + srow] = (u16)f2bf(x2 * wgt); XW[(sc * 4 + 3) * 40 + srow] = (u16)f2bf(x3 * wgt);
        }
        {
            const int t = ti * 16 + fr, s0 = pi * 16 + fq * 4;
            if (pi <= ti) {
                f32x4 acc = (f32x4){0.f, 0.f, 0.f, 0.f};
#pragma unroll
                for (int ks = 0; ks < 4; ++ks)
                    acc = __builtin_amdgcn_mfma_f32_16x16x32_bf16(ldfrag(Bs, 136, pi * 16 + fr, ks * 32 + fq * 8), ldfrag(Cs, 136, ti * 16 + fr, ks * 32 + fq * 8), acc, 0, 0, 0);
                const float cst = csS[t];
                float m[4];
#pragma unroll
                for (int r = 0; r < 4; ++r) { const int s = s0 + r; m[r] = (s <= t) ? acc[r] * __expf(cst - csS[s]) * dtS[s] : 0.f; }
                st4bf(Ms + t * 40 + s0, m[0], m[1], m[2], m[3]);
            } else {
                *(uint2*)(Ms + t * 40 + s0) = make_uint2(0u, 0u);
            }
        }
        lds_barrier();
        {
            f32x4 ad = __builtin_amdgcn_mfma_f32_16x16x32_bf16(ldfrag(XT, 40, pi * 16 + fr, fq * 8), ldfrag(Ms, 40, ti * 16 + fr, fq * 8), (f32x4){0.f, 0.f, 0.f, 0.f}, 0, 0, 0);
            f32x4 ao = (f32x4){0.f, 0.f, 0.f, 0.f};
#pragma unroll
            for (int ks = 0; ks < 4; ++ks)
                ao = __builtin_amdgcn_mfma_f32_16x16x32_bf16(ldfrag(Sb, 136, pi * 16 + fr, ks * 32 + fq * 8), ldfrag(Cs, 136, ti * 16 + fr, ks * 32 + fq * 8), ao, 0, 0, 0);
            const int t = ti * 16 + fr;
            const float e = __expf(csS[t]);
            const float xs0 = lo16(cxs.x), xs1 = hi16(cxs.x), xs2 = lo16(cxs.y), xs3 = hi16(cxs.y);
            const float z0 = lo16(cz.x), z1 = hi16(cz.x), z2 = lo16(cz.y), z3 = hi16(cz.y);
            float4 y;
            y.x = (ad[0] + e * ao[0] + Dsk * xs0) * siluf_(z0);
            y.y = (ad[1] + e * ao[1] + Dsk * xs1) * siluf_(z1);
            y.z = (ad[2] + e * ao[2] + Dsk * xs2) * siluf_(z2);
            y.w = (ad[3] + e * ao[3] + Dsk * xs3) * siluf_(z3);
            *(uint2*)(YC + (rowb + (size_t)c * 32 + t) * 1024 + head * 64 + ph * 32 + pi * 16 + fq * 4) = make_uint2(pack2(y.x, y.y), pack2(y.z, y.w));
        }
        {
            const float e31 = __expf(cs31);
#pragma unroll
            for (int a = 0; a < 2; ++a) {
                const bf16x8 bt = ldfrag(BT, 40, (2 * w + a) * 16 + fr, fq * 8);
#pragma unroll
                for (int pt = 0; pt < 2; ++pt) {
                    f32x4 s = Sacc[a][pt];
                    s[0] *= e31; s[1] *= e31; s[2] *= e31; s[3] *= e31;
                    Sacc[a][pt] = __builtin_amdgcn_mfma_f32_16x16x32_bf16(bt, ldfrag(XW, 40, pt * 16 + fr, fq * 8), s, 0, 0, 0);
                }
            }
        }
        lds_barrier();
#pragma unroll
        for (int a = 0; a < 2; ++a)
#pragma unroll
            for (int pt = 0; pt < 2; ++pt)
                st4bf(Sb + (pt * 16 + fr) * 136 + (2 * w + a) * 16 + fq * 4, Sacc[a][pt][0], Sacc[a][pt][1], Sacc[a][pt][2], Sacc[a][pt][3]);
    };
#pragma unroll 1
    for (int c = 0; c < SEQ / 32; c += 2) {
        { stage(aC0, aC1, aB0, aB1, adt); const uint2 cx = ax, cz = az, cxs = axs; if (c + 2 < SEQ / 32) SSD_LD(a, c + 2); rest(c, cx, cz, cxs); }
        { stage(bC0, bC1, bB0, bB1, bdt); const uint2 cx = bx, cz = bz, cxs = bxs; if (c + 3 < SEQ / 32) SSD_LD(b, c + 3); rest(c + 1, cx, cz, cxs); }
    }
#undef SSD_LD
    float* so = p.out + O_SSP + ((((size_t)l * 8 + b) * 16 + head) * 64 + ph * 32) * 128;
#pragma unroll
    for (int a = 0; a < 2; ++a)
#pragma unroll
        for (int pt = 0; pt < 2; ++pt)
            *(float4*)(so + (size_t)(pt * 16 + fr) * 128 + (2 * w + a) * 16 + fq * 4) = make_float4(Sacc[a][pt][0], Sacc[a][pt][1], Sacc[a][pt][2], Sacc[a][pt][3]);
    __syncthreads();
}

DEVINL void hgrn_prompt_mfma(const Params& p, int l, int item, char* lds) {
    const int b = item >> 4, h = (item >> 2) & 3, vq = item & 3;
    const int tid = threadIdx.x, lane = tid & 63, w = tid >> 6, fr = lane & 15, fq = lane >> 4;
    u16* Qg = (u16*)lds;
    u16* Qm = Qg + 32 * 136;
    u16* Km = Qm + 32 * 136;
    u16* ST = Km + 32 * 136;
    u16* KdT = ST + 32 * 136;
    u16* VT = KdT + 128 * 40;
    u16* As = VT + 32 * 40;
    float* dS = (float*)(As + 32 * 40);
    const u16* U = (const u16*)(p.ws + OFF_U);
    u16* OB = (u16*)(p.ws + OFF_OB);
    const size_t rowb = (size_t)b * SEQ;
    const size_t u0 = (size_t)(b * 4 + h) * 64;
    const u16* gQG = (const u16*)(p.ws + OFF_HQG) + u0 * 4096;
    const u16* gQM = (const u16*)(p.ws + OFF_HQM) + u0 * 4096;
    const u16* gKM = (const u16*)(p.ws + OFF_HKM) + u0 * 4096;
    const u16* gKD = (const u16*)(p.ws + OFF_HKD) + u0 * 4096;
    const float* gDS = (const float*)(p.ws + OFF_HDS) + u0 * 128;
    const int vrow = tid >> 3, v4 = (tid & 7) * 4;
    const int ti = w >> 1, ji = w & 1;
    const int r0 = tid >> 4, c0 = (tid & 15) * 8;
    const int k0 = tid >> 2, p0 = (tid & 3) * 8;
    for (int i = tid; i < 32 * 136 / 2; i += 256) ((uint32_t*)ST)[i] = 0u;
    f32x4 Sacc[2][2];
#pragma unroll
    for (int a = 0; a < 2; ++a)
#pragma unroll
        for (int c = 0; c < 2; ++c) Sacc[a][c] = (f32x4){0.f, 0.f, 0.f, 0.f};
    const u16* pV = U + (rowb + vrow) * DINP + 3072 + h * 128 + vq * 32 + v4;
    const int gi0 = r0 * 128 + c0, gi1 = (r0 + 16) * 128 + c0, gk0 = k0 * 32 + p0, gk1 = (k0 + 64) * 32 + p0;
    const int li0 = r0 * 136 + c0, li1 = (r0 + 16) * 136 + c0, lk0 = k0 * 40 + p0, lk1 = (k0 + 64) * 40 + p0;
#define HG_LD(S, CC) do { const size_t au = (size_t)(CC) * 4096; \
        S##g0 = *(const uint4*)(gQG + au + gi0); S##g1 = *(const uint4*)(gQG + au + gi1); S##m0 = *(const uint4*)(gQM + au + gi0); S##m1 = *(const uint4*)(gQM + au + gi1); \
        S##k0 = *(const uint4*)(gKM + au + gi0); S##k1 = *(const uint4*)(gKM + au + gi1); S##d0 = *(const uint4*)(gKD + au + gk0); S##d1 = *(const uint4*)(gKD + au + gk1); \
        S##ds = *(const float4*)(gDS + (size_t)(CC) * 128 + (tid & 31) * 4); S##v = *(const uint2*)(pV + (size_t)(CC) * 32 * DINP); } while (0)
    uint4 ag0, ag1, am0, am1, ak0, ak1, ad0, ad1, bg0, bg1, bm0, bm1, bk0, bk1, bd0, bd1; float4 ads, bds; uint2 av, bv;
    HG_LD(a, 0); HG_LD(b, 1);
    auto stage = [&](uint4 g0, uint4 g1, uint4 m0, uint4 m1, uint4 kk0, uint4 kk1, uint4 d0, uint4 d1, float4 ds, uint2 rv) __attribute__((always_inline)) {
        *(uint4*)(Qg + li0) = g0; *(uint4*)(Qg + li1) = g1; *(uint4*)(Qm + li0) = m0; *(uint4*)(Qm + li1) = m1;
        *(uint4*)(Km + li0) = kk0; *(uint4*)(Km + li1) = kk1; *(uint4*)(KdT + lk0) = d0; *(uint4*)(KdT + lk1) = d1;
        if (tid < 32) *(float4*)(dS + tid * 4) = ds;
        VT[(v4 + 0) * 40 + vrow] = (u16)(rv.x & 0xffffu); VT[(v4 + 1) * 40 + vrow] = (u16)(rv.x >> 16);
        VT[(v4 + 2) * 40 + vrow] = (u16)(rv.y & 0xffffu); VT[(v4 + 3) * 40 + vrow] = (u16)(rv.y >> 16);
    };
    auto rest = [&](int c) __attribute__((always_inline)) {
        lds_barrier();
        {
            const int t = ti * 16 + fr, j0 = ji * 16 + fq * 4;
            if (ji <= ti) {
                f32x4 acc = (f32x4){0.f, 0.f, 0.f, 0.f};
#pragma unroll
                for (int ks = 0; ks < 4; ++ks)
                    acc = __builtin_amdgcn_mfma_f32_16x16x32_bf16(ldfrag(Km, 136, ji * 16 + fr, ks * 32 + fq * 8), ldfrag(Qm, 136, ti * 16 + fr, ks * 32 + fq * 8), acc, 0, 0, 0);
                st4bf(As + t * 40 + j0, (j0 + 0 <= t) ? acc[0] : 0.f, (j0 + 1 <= t) ? acc[1] : 0.f, (j0 + 2 <= t) ? acc[2] : 0.f, (j0 + 3 <= t) ? acc[3] : 0.f);
            } else {
                *(uint2*)(As + t * 40 + j0) = make_uint2(0u, 0u);
            }
        }
        lds_barrier();
        {
            const int vi = ji;
            f32x4 acc = __builtin_amdgcn_mfma_f32_16x16x32_bf16(ldfrag(VT, 40, vi * 16 + fr, fq * 8), ldfrag(As, 40, ti * 16 + fr, fq * 8), (f32x4){0.f, 0.f, 0.f, 0.f}, 0, 0, 0);
#pragma unroll
            for (int ks = 0; ks < 4; ++ks)
                acc = __builtin_amdgcn_mfma_f32_16x16x32_bf16(ldfrag(ST, 136, vi * 16 + fr, ks * 32 + fq * 8), ldfrag(Qg, 136, ti * 16 + fr, ks * 32 + fq * 8), acc, 0, 0, 0);
            *(uint2*)(OB + (rowb + (size_t)c * 32 + ti * 16 + fr) * 512 + h * 128 + vq * 32 + vi * 16 + fq * 4) = make_uint2(pack2(acc[0], acc[1]), pack2(acc[2], acc[3]));
        }
#pragma unroll
        for (int a = 0; a < 2; ++a) {
            const int kt = 2 * w + a;
            const bf16x8 kf = ldfrag(KdT, 40, kt * 16 + fr, fq * 8);
            const float4 dd = *(const float4*)(dS + kt * 16 + fq * 4);
#pragma unroll
            for (int vt = 0; vt < 2; ++vt) {
                f32x4 s = Sacc[a][vt];
                s[0] *= dd.x; s[1] *= dd.y; s[2] *= dd.z; s[3] *= dd.w;
                Sacc[a][vt] = __builtin_amdgcn_mfma_f32_16x16x32_bf16(kf, ldfrag(VT, 40, vt * 16 + fr, fq * 8), s, 0, 0, 0);
            }
        }
        lds_barrier();
#pragma unroll
        for (int a = 0; a < 2; ++a)
#pragma unroll
            for (int vt = 0; vt < 2; ++vt)
                st4bf(ST + (vt * 16 + fr) * 136 + (2 * w + a) * 16 + fq * 4, Sacc[a][vt][0], Sacc[a][vt][1], Sacc[a][vt][2], Sacc[a][vt][3]);
    };
#pragma unroll 1
    for (int c = 0; c < SEQ / 32; c += 2) {
        stage(ag0, ag1, am0, am1, ak0, ak1, ad0, ad1, ads, av); if (c + 2 < SEQ / 32) HG_LD(a, c + 2); rest(c);
        stage(bg0, bg1, bm0, bm1, bk0, bk1, bd0, bd1, bds, bv); if (c + 3 < SEQ / 32) HG_LD(b, c + 3); rest(c + 1);
    }
#undef HG_LD
    float* so = p.out + O_HGP + (((size_t)l * 8 + b) * 4 + h) * 128 * 128;
#pragma unroll
    for (int a = 0; a < 2; ++a)
#pragma unroll
        for (int vt = 0; vt < 2; ++vt)
#pragma unroll
            for (int r = 0; r < 4; ++r)
                so[(size_t)((2 * w + a) * 16 + fq * 4 + r) * 128 + vq * 32 + vt * 16 + fr] = Sacc[a][vt][r];
    __syncthreads();
}

DEVINL int scan_next_item(unsigned* ctr, int* slot) {
    __syncthreads();
    if (threadIdx.x == 0) *slot = (int)gridDim.x + (int)__hip_atomic_fetch_add(ctr, 1u, __ATOMIC_RELAXED, __HIP_MEMORY_SCOPE_AGENT);
    __syncthreads();
    return *slot;
}
DEVINL void phase_scan(const Params& p, int l, char* lds) {
    unsigned* ctr = (unsigned*)(p.ws + OFF_BAR) + 3520 + l * 64;
    __shared__ int nxt_item;
    int it = blockIdx.x;
#pragma unroll 1
    while (it < 256) { ssd_prompt_mfma(p, l, it, lds); it = scan_next_item(ctr, &nxt_item); }
#pragma unroll 1
    while (it < 384) { hgrn_prompt_mfma(p, l, it - 256, lds); it = scan_next_item(ctr, &nxt_item); }
#pragma unroll 1
    while (it < 896) { hgrn_sample_item(p, l, it - 384, lds); it = scan_next_item(ctr, &nxt_item); }
#pragma unroll 1
    while (it < 2944) { ssd_sample_item(p, l, it - 896); it = scan_next_item(ctr, &nxt_item); }
}

DEVINL void phase_mixnorm(const Params& p, int l) {
    const int wave = threadIdx.x >> 6, lane = threadIdx.x & 63;
    const u16* OB = (const u16*)(p.ws + OFF_OB);
    const u16* YC = (const u16*)(p.ws + OFF_YC);
    const u16* U = (const u16*)(p.ws + OFF_U);
    u16* Ycat = (u16*)(p.ws + OFF_YCAT);
    const float* gn = p.in[I_HGN] + (size_t)l * 512;
    const float* sn = p.in[I_SNORM] + (size_t)l * 1024;
    for (int it = blockIdx.x; it < NR / 4; it += gridDim.x) {
        const size_t r = (size_t)it * 4 + wave;
        {
            const uint4 ov = *(const uint4*)(OB + r * 512 + lane * 8);
            float x[8]; UNPACK8(ov, x);
            float ss = 0.f;
#pragma unroll
            for (int i = 0; i < 8; ++i) ss += x[i] * x[i];
            ss += __shfl_xor(ss, 1); ss += __shfl_xor(ss, 2); ss += __shfl_xor(ss, 4); ss += __shfl_xor(ss, 8);
            const float rstd = rsqrtf(ss * (1.0f / 128.0f) + EPS);
            const uint4 zz = *(const uint4*)(U + r * DINP + 3584 + lane * 8);
            float z[8]; UNPACK8(zz, z);
            const float4 g0 = *(const float4*)(gn + lane * 8), g1 = *(const float4*)(gn + lane * 8 + 4);
            const float gg[8] = {g0.x, g0.y, g0.z, g0.w, g1.x, g1.y, g1.z, g1.w};
            float y[8];
#pragma unroll
            for (int i = 0; i < 8; ++i) y[i] = x[i] * rstd * gg[i] * siluf_(z[i]);
            *(uint4*)(Ycat + r * 2048 + 512 + lane * 8) = make_uint4(pack2(y[0], y[1]), pack2(y[2], y[3]), pack2(y[4], y[5]), pack2(y[6], y[7]));
        }
        {
            float x[16];
#pragma unroll
            for (int h = 0; h < 2; ++h) {
                const uint4 yv = *(const uint4*)(YC + r * 1024 + h * 512 + lane * 8);
                x[h * 8 + 0] = lo16(yv.x); x[h * 8 + 1] = hi16(yv.x); x[h * 8 + 2] = lo16(yv.y); x[h * 8 + 3] = hi16(yv.y); x[h * 8 + 4] = lo16(yv.z); x[h * 8 + 5] = hi16(yv.z); x[h * 8 + 6] = lo16(yv.w); x[h * 8 + 7] = hi16(yv.w);
            }
            float ss = 0.f;
#pragma unroll
            for (int i = 0; i < 16; ++i) ss += x[i] * x[i];
            ss = wave_sum(ss);
            const float rstd = rsqrtf(ss * (1.0f / 1024.0f) + EPS);
#pragma unroll
            for (int h = 0; h < 2; ++h) {
                const float4 g0 = *(const float4*)(sn + h * 512 + lane * 8), g1 = *(const float4*)(sn + h * 512 + lane * 8 + 4);
                uint4 o;
                o.x = pack2(x[h * 8 + 0] * rstd * g0.x, x[h * 8 + 1] * rstd * g0.y);
                o.y = pack2(x[h * 8 + 2] * rstd * g0.z, x[h * 8 + 3] * rstd * g0.w);
                o.z = pack2(x[h * 8 + 4] * rstd * g1.x, x[h * 8 + 5] * rstd * g1.y);
                o.w = pack2(x[h * 8 + 6] * rstd * g1.z, x[h * 8 + 7] * rstd * g1.w);
                *(uint4*)(Ycat + r * 2048 + 1024 + h * 512 + lane * 8) = o;
            }
        }
    }
}

DEVINL void phase_rowpass(const Params& p, int l, int which) {
    const int wave = threadIdx.x >> 6, lane = threadIdx.x & 63;
    float* X = (float*)(p.ws + OFF_X);
    const u16* T = (const u16*)(p.ws + OFF_T);
    u16* Hb = (u16*)(p.ws + OFF_HB);
    u16* Mb = (u16*)(p.ws + OFF_MB);
    const bool last = (which == 1 && l == 1);
    const float* gpost = p.in[which == 0 ? I_GQM : I_GQX] + (size_t)l * 1024;
    const float* gnext = which == 0 ? p.in[I_GPX] + (size_t)l * 1024 : (last ? nullptr : p.in[I_GPM] + (size_t)(l + 1) * 1024);
    const int nrows = (which == 1 && !last) ? NR + 2048 : NR;
    for (int it = blockIdx.x; it < nrows / 4; it += gridDim.x) {
        const int r = it * 4 + wave;
        if (r < NR) {
            float* xd = X + (size_t)r * 1024;
            if (last) xd = r < NP ? p.out + O_YP + (size_t)r * 1024 : p.out + O_YS + (size_t)(r - NP) * 1024;
            const float* xb = X + (size_t)r * 1024;
            if (which == 0 && l == 0) xb = r < NP ? p.in[I_XP] + (size_t)r * 1024 : p.in[I_XS] + (size_t)(r - NP) * 1024;
            rowpass_row(xb, T + (size_t)r * 1024, gpost, xd, gnext, Hb + (size_t)r * 1024, lane);
        } else {
            const int m = r - NR;
            rowpass_row(p.in[I_MEM] + (size_t)m * 1024, nullptr, nullptr, nullptr, p.in[I_GMEM] + (size_t)(l + 1) * 1024, Mb + (size_t)m * 1024, lane);
        }
    }
}

DEVINL void attn_prompt_item(const Params& p, int item, char* lds) {
    const int b = item >> 6, h = (item >> 4) & 3, qt = item & 15;
    const int tid = threadIdx.x, lane = tid & 63, wave = tid >> 6;
    const u16* Qt = (const u16*)(p.ws + OFF_Q) + ((size_t)b * SEQ + qt * 128) * 1024 + h * 256;
    const u16* Kb = (const u16*)(p.ws + OFF_MK) + (size_t)b * 256 * 1024 + h * 256;
    const u16* Vt = (const u16*)(p.ws + OFF_MVT) + (size_t)(b * 4 + h) * 256 * 256;
    float* Ss = (float*)(p.ws + OFF_SCR + (size_t)blockIdx.x * SCR_PER_BLOCK);
    u16* Ps = (u16*)((char*)Ss + 128 * 256 * 4);
    u16* Ob = (u16*)(p.ws + OFF_O) + ((size_t)b * SEQ + qt * 128) * 1024 + h * 256;
#pragma unroll 1
    for (int nt = 0; nt < 2; ++nt)
        gemm_tile1(Qt, 1024, Kb + (size_t)nt * 128 * 1024, 1024, 256, lds,
                  [&](int r, int c, f32x4 v) { *(float4*)(Ss + r * 256 + nt * 128 + c) = make_float4(v[0] * 0.0625f, v[1] * 0.0625f, v[2] * 0.0625f, v[3] * 0.0625f); });
    __syncthreads();
    for (int i = 0; i < 32; ++i) {
        const int r = wave * 32 + i;
        const float4 x = *(const float4*)(Ss + r * 256 + lane * 4);
        const float m = wave_max(fmaxf(fmaxf(x.x, x.y), fmaxf(x.z, x.w)));
        const float e0 = __expf(x.x - m), e1 = __expf(x.y - m), e2 = __expf(x.z - m), e3 = __expf(x.w - m);
        const float inv = 1.0f / wave_sum(e0 + e1 + e2 + e3);
        *(uint2*)(Ps + r * 256 + lane * 4) = make_uint2(pack2(e0 * inv, e1 * inv), pack2(e2 * inv, e3 * inv));
    }
    __syncthreads();
#pragma unroll 1
    for (int nt = 0; nt < 2; ++nt)
        gemm_tile1(Ps, 256, Vt + (size_t)nt * 128 * 256, 256, 256, lds,
                  [&](int r, int c, f32x4 v) { *(uint2*)(Ob + (size_t)r * 1024 + nt * 128 + c) = make_uint2(pack2(v[0], v[1]), pack2(v[2], v[3])); });
    __syncthreads();
}


DEVINL void attn_prompt_item2(const Params& p, int item, char* lds) {
    const int b = item >> 7, h = (item >> 5) & 3, qt = item & 31;
    const int tid = threadIdx.x, lane = tid & 63, w = tid >> 6, fr = lane & 15, fq = lane >> 4;
    char* Kbuf = lds;
    char* Vbuf = lds + 33792;
    const size_t qrow = (size_t)b * SEQ + qt * 64 + w * 16 + fr;
    const u16* Qp = (const u16*)(p.ws + OFF_Q) + qrow * 1024 + h * 256 + fq * 8;
    const int krow = tid >> 5, kch = tid & 31;
    const u16* Kg = (const u16*)(p.ws + OFF_MK) + ((size_t)b * 256 + krow) * 1024 + h * 256 + kch * 8;
    const int klds = krow * 528 + kch * 16;
    const int vrow = tid >> 2, vch = tid & 3;
    const u16* Vg = (const u16*)(p.ws + OFF_MVT) + ((size_t)(b * 4 + h) * 256 + vrow) * 256 + vch * 8;
    const int vlds = vrow * 80 + vch * 16;
    bf16x8 qf[8];
#pragma unroll
    for (int ks = 0; ks < 8; ++ks) qf[ks] = *(const bf16x8*)(Qp + ks * 32);
    uint4 r0, r1, r2, r3, r4, r5, r6, r7;
#define KLOAD(KB) do { const u16* g_ = Kg + (size_t)(KB) * 64 * 1024; \
        r0 = *(const uint4*)(g_); r1 = *(const uint4*)(g_ + 8 * 1024); r2 = *(const uint4*)(g_ + 16 * 1024); r3 = *(const uint4*)(g_ + 24 * 1024); \
        r4 = *(const uint4*)(g_ + 32 * 1024); r5 = *(const uint4*)(g_ + 40 * 1024); r6 = *(const uint4*)(g_ + 48 * 1024); r7 = *(const uint4*)(g_ + 56 * 1024); } while (0)
#define KSTORE() do { char* d_ = Kbuf + klds; \
        *(uint4*)(d_) = r0; *(uint4*)(d_ + 8 * 528) = r1; *(uint4*)(d_ + 16 * 528) = r2; *(uint4*)(d_ + 24 * 528) = r3; \
        *(uint4*)(d_ + 32 * 528) = r4; *(uint4*)(d_ + 40 * 528) = r5; *(uint4*)(d_ + 48 * 528) = r6; *(uint4*)(d_ + 56 * 528) = r7; } while (0)
#define VLOAD(VB) do { const u16* g_ = Vg + (VB) * 32; \
        r0 = *(const uint4*)(g_); r1 = *(const uint4*)(g_ + 64 * 256); r2 = *(const uint4*)(g_ + 128 * 256); r3 = *(const uint4*)(g_ + 192 * 256); } while (0)
#define VSTORE() do { char* d_ = Vbuf + vlds; \
        *(uint4*)(d_) = r0; *(uint4*)(d_ + 64 * 80) = r1; *(uint4*)(d_ + 128 * 80) = r2; *(uint4*)(d_ + 192 * 80) = r3; } while (0)
    f32x4 sacc[16];
    KLOAD(0);
#pragma unroll
    for (int kb = 0; kb < 4; ++kb) {
        KSTORE();
        if (kb < 3) KLOAD(kb + 1); else VLOAD(0);
        lds_barrier();
#pragma unroll
        for (int kl = 0; kl < 4; ++kl) {
            f32x4 acc = (f32x4){0.f, 0.f, 0.f, 0.f};
#pragma unroll
            for (int ks = 0; ks < 8; ++ks)
                acc = __builtin_amdgcn_mfma_f32_16x16x32_bf16(*(const bf16x8*)(Kbuf + (kl * 16 + fr) * 528 + (ks * 32 + fq * 8) * 2), qf[ks], acc, 0, 0, 0);
            sacc[kb * 4 + kl] = acc;
        }
        lds_barrier();
    }
    float m = -3.0e38f;
#pragma unroll
    for (int kt = 0; kt < 16; ++kt) m = fmaxf(m, fmaxf(fmaxf(sacc[kt][0], sacc[kt][1]), fmaxf(sacc[kt][2], sacc[kt][3])));
    m = fmaxf(m, __shfl_xor(m, 16)); m = fmaxf(m, __shfl_xor(m, 32));
    float sum = 0.f;
#pragma unroll
    for (int kt = 0; kt < 16; ++kt)
#pragma unroll
        for (int r = 0; r < 4; ++r) { const float e = __expf((sacc[kt][r] - m) * 0.0625f); sacc[kt][r] = e; sum += e; }
    sum += __shfl_xor(sum, 16); sum += __shfl_xor(sum, 32);
    const float inv = __builtin_amdgcn_rcpf(sum);
    bf16x8 pf[8];
#pragma unroll
    for (int ks = 0; ks < 8; ++ks) {
        uint4 u;
        u.x = pack2(sacc[2 * ks][0] * inv, sacc[2 * ks][1] * inv); u.y = pack2(sacc[2 * ks][2] * inv, sacc[2 * ks][3] * inv);
        u.z = pack2(sacc[2 * ks + 1][0] * inv, sacc[2 * ks + 1][1] * inv); u.w = pack2(sacc[2 * ks + 1][2] * inv, sacc[2 * ks + 1][3] * inv);
        pf[ks] = __builtin_bit_cast(bf16x8, u);
    }
    f32x4 oacc[16];
#pragma unroll
    for (int dt = 0; dt < 16; ++dt) oacc[dt] = (f32x4){0.f, 0.f, 0.f, 0.f};
#pragma unroll
    for (int vb = 0; vb < 8; ++vb) {
        VSTORE();
        if (vb < 7) VLOAD(vb + 1);
        lds_barrier();
#pragma unroll
        for (int dt = 0; dt < 16; ++dt) {
            const uint2 lo = *(const uint2*)(Vbuf + (dt * 16 + fr) * 80 + fq * 8), hi = *(const uint2*)(Vbuf + (dt * 16 + fr) * 80 + fq * 8 + 32);
            const uint4 u = make_uint4(lo.x, lo.y, hi.x, hi.y);
            oacc[dt] = __builtin_amdgcn_mfma_f32_16x16x32_bf16(__builtin_bit_cast(bf16x8, u), pf[vb], oacc[dt], 0, 0, 0);
        }
        lds_barrier();
    }
#undef KLOAD
#undef KSTORE
#undef VLOAD
#undef VSTORE
    {
        char* img = lds + w * 8448 + fr * 528 + fq * 8;
#pragma unroll
        for (int dt = 0; dt < 16; ++dt)
            *(uint2*)(img + dt * 32) = make_uint2(pack2(oacc[dt][0], oacc[dt][1]), pack2(oacc[dt][2], oacc[dt][3]));
        const char* rd = lds + w * 8448 + (lane >> 5) * 528 + (lane & 31) * 16;
        u16* o0 = (u16*)(p.ws + OFF_O) + ((size_t)b * SEQ + qt * 64 + w * 16 + (lane >> 5)) * 1024 + h * 256 + (lane & 31) * 8;
#pragma unroll
        for (int it = 0; it < 8; ++it) *(uint4*)(o0 + (size_t)it * 2048) = *(const uint4*)(rd + it * 1056);
    }
    lds_barrier();
}

DEVINL void attn_sample_item(const Params& p, int l, int item, char* lds) {
    const int s = item >> 2, h = item & 3;
    const int tid = threadIdx.x, lane = tid & 63, wave = tid >> 6;
    float* sc = (float*)lds;
    float* red = sc + 256;
    float* wred = red + 1024;
    const int rsub = lane >> 4, part = lane & 15;
    const u16* qp = (const u16*)(p.ws + OFF_Q) + (size_t)(NP + s) * 1024 + h * 256 + part * 4;
    float qv[16];
#pragma unroll
    for (int j = 0; j < 4; ++j) {
        const uint2 qq = *(const uint2*)(qp + j * 64);
        qv[j * 4 + 0] = lo16(qq.x); qv[j * 4 + 1] = hi16(qq.x); qv[j * 4 + 2] = lo16(qq.y); qv[j * 4 + 3] = hi16(qq.y);
    }
    const size_t cb0 = (((size_t)l * NS + s) * 256) * 1024 + h * 256;
    const float* Kc = p.in[I_CK] + cb0 + part * 4;
    const float* Vc = p.in[I_CV] + cb0 + lane * 4;
#pragma unroll 1
    for (int i = 0; i < 4; ++i) {
        float4 kv[4][4];
#pragma unroll
        for (int pp = 0; pp < 4; ++pp)
#pragma unroll
            for (int j = 0; j < 4; ++j) kv[pp][j] = ldnt4(Kc + (size_t)(wave * 64 + (i * 4 + pp) * 4 + rsub) * 1024 + j * 64);
#pragma unroll
        for (int pp = 0; pp < 4; ++pp) {
            float d = 0.f;
#pragma unroll
            for (int j = 0; j < 4; ++j) d += kv[pp][j].x * qv[j * 4] + kv[pp][j].y * qv[j * 4 + 1] + kv[pp][j].z * qv[j * 4 + 2] + kv[pp][j].w * qv[j * 4 + 3];
            d += __shfl_xor(d, 1); d += __shfl_xor(d, 2); d += __shfl_xor(d, 4); d += __shfl_xor(d, 8);
            if (part == 0) sc[wave * 64 + (i * 4 + pp) * 4 + rsub] = d * 0.0625f;
        }
    }
    __syncthreads();
    const float x = sc[tid];
    const float wm = wave_max(x);
    if (lane == 0) wred[wave] = wm;
    __syncthreads();
    const float m = fmaxf(fmaxf(wred[0], wred[1]), fmaxf(wred[2], wred[3]));
    const float e = __expf(x - m);
    const float ws_ = wave_sum(e);
    if (lane == 0) wred[4 + wave] = ws_;
    __syncthreads();
    const float inv = 1.0f / (wred[4] + wred[5] + wred[6] + wred[7]);
    sc[tid] = e * inv;
    __syncthreads();
    float4 acc = make_float4(0.f, 0.f, 0.f, 0.f);
#pragma unroll 1
    for (int i = 0; i < 4; ++i) {
        float4 vv[16];
#pragma unroll
        for (int j = 0; j < 16; ++j) vv[j] = ldnt4(Vc + (size_t)(wave * 64 + i * 16 + j) * 1024);
#pragma unroll
        for (int j = 0; j < 16; ++j) {
            const float pw = sc[wave * 64 + i * 16 + j];
            acc.x += pw * vv[j].x; acc.y += pw * vv[j].y; acc.z += pw * vv[j].z; acc.w += pw * vv[j].w;
        }
    }
    *(float4*)(red + wave * 256 + lane * 4) = acc;
    __syncthreads();
    {
        const float o = red[tid] + red[256 + tid] + red[512 + tid] + red[768 + tid];
        ((u16*)(p.ws + OFF_O))[(size_t)(NP + s) * 1024 + h * 256 + tid] = (u16)f2bf(o);
    }
    __syncthreads();
}

DEVINL void phase_attn(const Params& p, int l, char* lds) {
    const int G = gridDim.x;
    const bool sample_first = (int)blockIdx.x >= (G >> 1);
#pragma unroll 1
    for (int pass = 0; pass < 2; ++pass) {
        const bool do_sample = (pass == 0) == sample_first;
        if (do_sample) {
#pragma unroll 1
            for (int it = blockIdx.x; it < 512; it += G) attn_sample_item(p, l, it, lds);
        } else {
#pragma unroll 1
            for (int it = blockIdx.x; it < 1024; it += G) attn_prompt_item2(p, it, lds);
        }
    }
}

#define XB_TMO      128
#define XB_XCNT(j)  (256  + 64 * (j))
#define XB_XSUB(j)  (1280 + 64 * (j))
#define XB_XGEN(j)  (2304 + 64 * (j))
#define XB_TOP      3328
#define XB_TOPGEN   3392
#define XCD_BAR_WORDS 3456
#define XB_SPIN_CAP (1u << 22)
#define LAS __attribute__((address_space(3)))
DEVINL unsigned xb_ld(unsigned* p) { return __hip_atomic_load(p, __ATOMIC_RELAXED, __HIP_MEMORY_SCOPE_AGENT); }
DEVINL unsigned xb_add(unsigned* p, unsigned v) { return __hip_atomic_fetch_add(p, v, __ATOMIC_RELAXED, __HIP_MEMORY_SCOPE_AGENT); }
DEVINL unsigned xb_xcc_id() { return (unsigned)__builtin_amdgcn_s_getreg((3 << 11) | 20) & 0xFu; }
#define XB_SPIN(cond, bar) do { unsigned _sp = 0; while (cond) { __builtin_amdgcn_s_sleep(1); \
    if ((++_sp & 255u) == 0u) { if (xb_ld(&(bar)[XB_TMO])) break; if (_sp > XB_SPIN_CAP) { atomicAdd(&(bar)[XB_TMO], 1u); break; } } } } while (0)
struct XcdBarrier { unsigned* bar; unsigned x; volatile LAS unsigned* st; };
DEVINL XcdBarrier xcd_barrier_post(unsigned* bar, volatile LAS unsigned* st) {
    XcdBarrier b; b.bar = bar; b.x = xb_xcc_id(); b.st = st;
    if (threadIdx.x == 0) (void)xb_add(&bar[XB_XCNT(b.x)], 1u);
    return b;
}
DEVINL void xcd_barrier_complete(unsigned* bar, unsigned x, unsigned& nloc, unsigned& nx) {
    const unsigned G = gridDim.x * gridDim.y * gridDim.z;
    unsigned sum, cnt, mine, sp = 0u;
    for (;;) {
        sum = 0u; cnt = 0u; mine = 0u;
#pragma unroll
        for (unsigned j = 0; j < 16; ++j) { const unsigned c = xb_ld(&bar[XB_XCNT(j)]); sum += c; cnt += (c > 0u) ? 1u : 0u; mine = (j == x) ? c : mine; }
        if (sum == G) break;
        __builtin_amdgcn_s_sleep(1);
        if ((++sp & 255u) == 0u) { if (xb_ld(&bar[XB_TMO])) break; if (sp > XB_SPIN_CAP) { atomicAdd(&bar[XB_TMO], 1u); break; } }
    }
    nloc = mine > 0u ? mine : 1u; nx = cnt > 0u ? cnt : 1u;
}
DEVINL void xcd_barrier(const XcdBarrier& b) {
    asm volatile("s_waitcnt vmcnt(0)" ::: "memory");
    __syncthreads();
    if (threadIdx.x == 0) {
        unsigned* bar = b.bar;
        __builtin_amdgcn_s_waitcnt(0);
        unsigned nloc = b.st[0], nx = b.st[1];
        if (nloc == 0u) { xcd_barrier_complete(bar, b.x, nloc, nx); b.st[0] = nloc; b.st[1] = nx; }
        const unsigned old = xb_add(&bar[XB_XSUB(b.x)], 1u);
        const unsigned gen = old / nloc;
        if (old + 1u == (gen + 1u) * nloc) {
            __builtin_amdgcn_fence(__ATOMIC_RELEASE, "agent");
            asm volatile("s_waitcnt vmcnt(0)" ::: "memory");
            const unsigned og = xb_add(&bar[XB_TOP], 1u);
            const unsigned tg = og / nx;
            if (og + 1u == (tg + 1u) * nx) xb_add(&bar[XB_TOPGEN], 1u);
            else XB_SPIN(xb_ld(&bar[XB_TOPGEN]) == tg, bar);
            __builtin_amdgcn_fence(__ATOMIC_ACQUIRE, "agent");
            xb_add(&bar[XB_XGEN(b.x)], 1u);
            asm volatile("s_waitcnt vmcnt(0)" ::: "memory");
        } else {
            XB_SPIN(xb_ld(&bar[XB_XGEN(b.x)]) == gen, bar);
            __builtin_amdgcn_fence(__ATOMIC_ACQUIRE, "agent");
            asm volatile("s_waitcnt vmcnt(0)" ::: "memory");
        }
    }
    __syncthreads();
}

#ifndef ONLYQ
#define ONLYQ -1
#endif
#ifndef REP_MASK
#define REP_MASK 0
#endif
__global__ void __launch_bounds__(256, 2) mega(Params p) {
    __shared__ __attribute__((aligned(16))) char lds[65536];
    __shared__ uint4 xb_words;
    XcdBarrier bar; bar.bar = (unsigned*)(p.ws + OFF_BAR); bar.x = 0; bar.st = (volatile LAS unsigned*)&xb_words;
    if (p.coop) {
        if (threadIdx.x == 0) xb_words = make_uint4(0u, 0u, 0u, 0u);
        __syncthreads();
        bar = xcd_barrier_post((unsigned*)(p.ws + OFF_BAR), (volatile LAS unsigned*)&xb_words);
    }
#define RUNPH(PH, Q, BODY) if ((ONLYQ < 0 || ONLYQ == (Q)) && p.ph_lo <= (PH) && (PH) < p.ph_hi) { BODY; if (REP_MASK & (1 << (Q))) { BODY; } \
        if (p.coop && (PH) + 1 < p.ph_hi) { if (p.pad == 0x5a5a5a5a) cg::this_grid().sync(); else xcd_barrier(bar); } }
#define LAYER(L) \
    RUNPH(1 + (L) * 10 + 0, 0, phase_gemm_in(p, L, lds)) \
    RUNPH(1 + (L) * 10 + 1, 1, phase_prep(p, L, lds)) \
    RUNPH(1 + (L) * 10 + 2, 2, phase_scan(p, L, lds)) \
    RUNPH(1 + (L) * 10 + 3, 3, phase_mixnorm(p, L)) \
    RUNPH(1 + (L) * 10 + 4, 4, phase_gemm_n1024((const u16*)(p.ws + OFF_YCAT), 2048, (const u16*)(p.ws + OFF_WOUT) + (size_t)(L) * 1024 * 2048, nullptr, (u16*)(p.ws + OFF_T), lds)) \
    RUNPH(1 + (L) * 10 + 5, 15, phase_rowpass(p, L, 0)) \
    RUNPH(1 + (L) * 10 + 6, 6, phase_gemm_n1024((const u16*)(p.ws + OFF_HB), 1024, (const u16*)(p.ws + OFF_WQ) + (size_t)(L) * 1024 * 1024, nullptr, (u16*)(p.ws + OFF_Q), lds)) \
    RUNPH(1 + (L) * 10 + 7, 7, phase_attn(p, L, lds)) \
    RUNPH(1 + (L) * 10 + 8, 8, phase_gemm_n1024((const u16*)(p.ws + OFF_O), 1024, (const u16*)(p.ws + OFF_WO) + (size_t)(L) * 1024 * 1024, nullptr, (u16*)(p.ws + OFF_T), lds)) \
    RUNPH(1 + (L) * 10 + 9, 15, phase_rowpass(p, L, 1))
    RUNPH(0, 10, phase_prologue(p, lds))
    LAYER(0)
    LAYER(1)
}

extern "C" void kernel_launch(void* const* d_in, const int* in_sizes, int n_in, void* d_out, int out_size, void* d_ws, size_t ws_size,
                              hipStream_t stream) {
    static int grid = 0;
    if (!grid) {
        int dev = 0, cus = 0, per_cu = 0;
        hipGetDevice(&dev);
        hipDeviceGetAttribute(&cus, hipDeviceAttributeMultiprocessorCount, dev);
        hipOccupancyMaxActiveBlocksPerMultiprocessor(&per_cu, mega, 256, 0);
        if (per_cu > 2) per_cu = 2;
        if (per_cu < 1) per_cu = 1;
        grid = cus * per_cu;
        if (grid > MAX_GRID) grid = MAX_GRID;
        if (n_in != 29 || ws_size < WS_END) { fprintf(stderr, "kernel_launch: unexpected n_in %d or ws_size %zu (< %zu)\n", n_in, ws_size, (size_t)WS_END); }
    }
    Params p{};
    for (int i = 0; i < 29; ++i) p.in[i] = (const float*)d_in[i];
    p.out = (float*)d_out; p.ws = (char*)d_ws;
#if MULTI_LAUNCH
    for (int ph = 0; ph < NPHASE; ++ph) {
        p.ph_lo = ph; p.ph_hi = ph + 1; p.coop = 0;
        hipLaunchKernelGGL(mega, dim3(grid), dim3(256), 0, stream, p);
    }
#else
    p.ph_lo = 0; p.ph_hi = NPHASE; p.coop = 1;
    (void)hipMemsetAsync((char*)d_ws + OFF_BAR, 0, 16384, stream);
    void* args[] = {&p};
    hipError_t e = hipLaunchCooperativeKernel((void*)mega, dim3(grid), dim3(256), args, 0, stream);
    if (e != hipSuccess) fprintf(stderr, "cooperative launch failed: %s (grid %d)\n", hipGetErrorString(e), grid);
#endif
}
```

```cpp
#include <hip/hip_runtime.h>
#include <hip/hip_cooperative_groups.h>
#include <stdint.h>
#include <cstdio>
namespace cg = cooperative_groups;

#ifndef MULTI_LAUNCH
#define MULTI_LAUNCH 0
#endif

typedef unsigned short u16;
typedef short bf16x8 __attribute__((ext_vector_type(8)));
typedef float f32x4 __attribute__((ext_vector_type(4)));
#define DEVINL __device__ __forceinline__

constexpr int D = 1024, NP = 16384, NS = 128, NR = 16512, SEQ = 2048, DINP = 6784, DIN = 6672;
constexpr int NPHASE = 21;
constexpr float EPS = 1e-6f;

constexpr size_t SZ_WIN = (size_t)DINP * 1024 * 2, SZ_WOUT = (size_t)1024 * 2048 * 2, SZ_SQ = (size_t)1024 * 1024 * 2;
constexpr size_t OFF_WIN = 0;
constexpr size_t OFF_WOUT = OFF_WIN + 2 * SZ_WIN;
constexpr size_t OFF_WQ = OFF_WOUT + 2 * SZ_WOUT;
constexpr size_t OFF_WK = OFF_WQ + 2 * SZ_SQ;
constexpr size_t OFF_WV = OFF_WK + 2 * SZ_SQ;
constexpr size_t OFF_WO = OFF_WV + 2 * SZ_SQ;
constexpr size_t OFF_X = OFF_WO + 2 * SZ_SQ;
constexpr size_t OFF_HB = OFF_X + (size_t)NR * 1024 * 4;
constexpr size_t OFF_MB = OFF_HB + (size_t)NR * 1024 * 2;
constexpr size_t OFF_U = OFF_MB + (size_t)2048 * 1024 * 2;
constexpr size_t OFF_XBC = OFF_U + (size_t)NR * DINP * 2;
constexpr size_t OFF_DT = OFF_XBC + (size_t)NR * 1536 * 4;
constexpr size_t OFF_OB = OFF_DT + (size_t)NR * 16 * 4;
constexpr size_t OFF_YC = OFF_OB + (size_t)NR * 512 * 4;
constexpr size_t OFF_YCAT = OFF_YC + (size_t)NR * 1024 * 4;
constexpr size_t OFF_T = OFF_YCAT + (size_t)NR * 2048 * 2;
constexpr size_t OFF_Q = OFF_T + (size_t)NR * 1024 * 4;
constexpr size_t OFF_O = OFF_Q + (size_t)NR * 1024 * 2;
constexpr size_t OFF_MK = OFF_O + (size_t)NR * 1024 * 2;
constexpr size_t OFF_MVT = OFF_MK + (size_t)2048 * 1024 * 2;
constexpr size_t OFF_SCR = OFF_MVT + (size_t)2048 * 1024 * 2;
constexpr size_t SCR_PER_BLOCK = 128 * 256 * 4 + 128 * 256 * 2;
constexpr int MAX_GRID = 1024;
constexpr size_t OFF_XBCB = OFF_SCR + SCR_PER_BLOCK * MAX_GRID;
constexpr size_t OFF_HQG = OFF_XBCB + (size_t)NR * 1536 * 2;
constexpr size_t OFF_HQM = OFF_HQG + (size_t)2048 * 4096 * 2;
constexpr size_t OFF_HKM = OFF_HQM + (size_t)2048 * 4096 * 2;
constexpr size_t OFF_HKD = OFF_HKM + (size_t)2048 * 4096 * 2;
constexpr size_t OFF_HDS = OFF_HKD + (size_t)2048 * 4096 * 2;
constexpr size_t OFF_BAR = OFF_HDS + (size_t)2048 * 128 * 4;
constexpr size_t WS_END = OFF_BAR + 16384;

constexpr size_t O_YP = 0;
constexpr size_t O_YS = O_YP + (size_t)NP * 1024;
constexpr size_t O_CAP = O_YS + (size_t)NS * 1024;
constexpr size_t O_HGP = O_CAP + (size_t)2 * 8 * 2 * 512;
constexpr size_t O_SCP = O_HGP + (size_t)2 * 8 * 4 * 128 * 128;
constexpr size_t O_SSP = O_SCP + (size_t)2 * 8 * 3 * 1536;
constexpr size_t O_MKP = O_SSP + (size_t)2 * 8 * 16 * 64 * 128;
constexpr size_t O_MVP = O_MKP + (size_t)2 * 8 * 256 * 1024;
constexpr size_t O_CAS = O_MVP + (size_t)2 * 8 * 256 * 1024;
constexpr size_t O_HGS = O_CAS + (size_t)2 * 128 * 2 * 512;
constexpr size_t O_SCS = O_HGS + (size_t)2 * 128 * 4 * 128 * 128;
constexpr size_t O_SSS = O_SCS + (size_t)2 * 128 * 3 * 1536;

enum { I_XP = 0, I_XS, I_MEM, I_SCA, I_SHG, I_SSC, I_SSS, I_CK, I_CV, I_WIN, I_CAW, I_HLB, I_HGN, I_SCW, I_SCB, I_DTB, I_ALOG, I_DSK,
       I_SNORM, I_WOUT, I_GPM, I_GQM, I_GPX, I_GQX, I_GMEM, I_WQ, I_WK, I_WV, I_WO };

struct Params {
    const float* in[29];
    float* out;
    char* ws;
    int ph_lo, ph_hi, coop, pad;
};

DEVINL float bf2f(uint32_t h) { return __uint_as_float(h << 16); }
DEVINL uint32_t f2bf(float f) { uint32_t u = __float_as_uint(f); return (u + 0x7fffu + ((u >> 16) & 1u)) >> 16; }
DEVINL uint32_t pack2(float a, float b) { return f2bf(a) | (f2bf(b) << 16); }
DEVINL float lo16(uint32_t v) { return __uint_as_float(v << 16); }
DEVINL float hi16(uint32_t v) { return __uint_as_float(v & 0xffff0000u); }
DEVINL float sigmoidf_(float x) { return __builtin_amdgcn_rcpf(1.0f + __expf(-x)); }
DEVINL float siluf_(float x) { return x * __builtin_amdgcn_rcpf(1.0f + __expf(-x)); }
DEVINL float wave_sum(float v) {
#pragma unroll
    for (int o = 32; o; o >>= 1) v += __shfl_xor(v, o);
    return v;
}
DEVINL float wave_max(float v) {
#pragma unroll
    for (int o = 32; o; o >>= 1) v = fmaxf(v, __shfl_xor(v, o));
    return v;
}
DEVINL void lds_barrier() { asm volatile("s_waitcnt lgkmcnt(0)\n\ts_barrier" ::: "memory"); }
DEVINL float4 ldnt4(const float* p) { const f32x4 v = __builtin_nontemporal_load((const f32x4*)p); return make_float4(v[0], v[1], v[2], v[3]); }
DEVINL void stnt4(float* p, float4 v) { const f32x4 t = (f32x4){v.x, v.y, v.z, v.w}; __builtin_nontemporal_store(t, (f32x4*)p); }
#define UNPACK8(v, f) do { f[0] = lo16(v.x); f[1] = hi16(v.x); f[2] = lo16(v.y); f[3] = hi16(v.y); f[4] = lo16(v.z); f[5] = hi16(v.z); f[6] = lo16(v.w); f[7] = hi16(v.w); } while (0)

template <class Epi>
DEVINL void gemm_tile(const u16* __restrict__ A, int lda, const u16* __restrict__ Bt, int ldb, int K, char* lds, Epi epi) {
    const int tid = threadIdx.x, lane = tid & 63, wave = tid >> 6, wr = wave >> 1, wc = wave & 1, fr = lane & 15, fq = lane >> 4;
    f32x4 acc[4][4];
#pragma unroll
    for (int m = 0; m < 4; ++m)
#pragma unroll
        for (int n = 0; n < 4; ++n) acc[m][n] = (f32x4){0.f, 0.f, 0.f, 0.f};
    const int srow = tid >> 2, sch = tid & 3;
    const u16* Ag = A + (size_t)srow * lda + sch * 8;
    const u16* Bg = Bt + (size_t)srow * ldb + sch * 8;
    const int soff = srow * 64 + ((sch ^ (((srow >> 3) & 1) << 1)) << 4);
    const int swz = ((fq ^ (((fr >> 3) & 1) << 1)) << 4);
    const int fa = (wr * 64 + fr) * 64 + swz;
    const int fb = 16384 + (wc * 64 + fr) * 64 + swz;
    uint4 pa0, pa1, pa2, pa3, pb0, pb1, pb2, pb3, qa0, qa1, qa2, qa3, qb0, qb1, qb2, qb3;
    const int nt = K >> 6;
    const size_t sA1 = (size_t)64 * lda, sB1 = (size_t)64 * ldb;
#define G_LOAD(P, T) do { const int k0_ = (T) << 6; \
        P##a0 = *(const uint4*)(Ag + k0_); P##a1 = *(const uint4*)(Ag + k0_ + 32); P##a2 = *(const uint4*)(Ag + sA1 + k0_); P##a3 = *(const uint4*)(Ag + sA1 + k0_ + 32); \
        P##b0 = *(const uint4*)(Bg + k0_); P##b1 = *(const uint4*)(Bg + k0_ + 32); P##b2 = *(const uint4*)(Bg + sB1 + k0_); P##b3 = *(const uint4*)(Bg + sB1 + k0_ + 32); } while (0)
#define G_STORE(P, ST) do { char* nb_ = lds + (ST) * 32768 + soff; \
        *(uint4*)(nb_) = P##a0; *(uint4*)(nb_ + 8192) = P##a1; *(uint4*)(nb_ + 4096) = P##a2; *(uint4*)(nb_ + 4096 + 8192) = P##a3; \
        *(uint4*)(nb_ + 16384) = P##b0; *(uint4*)(nb_ + 16384 + 8192) = P##b1; *(uint4*)(nb_ + 16384 + 4096) = P##b2; *(uint4*)(nb_ + 16384 + 4096 + 8192) = P##b3; } while (0)
    auto g_compute = [&](int ST) __attribute__((always_inline)) {
        const char* base = lds + ST * 32768;
#pragma unroll
        for (int s = 0; s < 2; ++s) {
            bf16x8 a[4], b[4];
#pragma unroll
            for (int m = 0; m < 4; ++m) a[m] = *(const bf16x8*)(base + fa + m * 1024 + s * 8192);
#pragma unroll
            for (int n = 0; n < 4; ++n) b[n] = *(const bf16x8*)(base + fb + n * 1024 + s * 8192);
            __builtin_amdgcn_s_setprio(1);
#pragma unroll
            for (int m = 0; m < 4; ++m)
#pragma unroll
                for (int n = 0; n < 4; ++n) acc[m][n] = __builtin_amdgcn_mfma_f32_16x16x32_bf16(b[n], a[m], acc[m][n], 0, 0, 0);
            __builtin_amdgcn_s_setprio(0);
        }
    };
#define G_COMPUTE(ST) g_compute(ST)
    G_LOAD(p, 0);
    if (nt > 1) G_LOAD(q, 1);
    G_STORE(p, 0);
    if (nt > 2) G_LOAD(p, 2);
    lds_barrier();
#pragma unroll 1
    for (int t = 0; t < nt; t += 2) {
        if (t + 1 < nt) G_STORE(q, 1);
        if (t + 3 < nt) G_LOAD(q, t + 3);
        G_COMPUTE(0);
        lds_barrier();
        if (t + 1 < nt) {
            if (t + 2 < nt) G_STORE(p, 0);
            if (t + 4 < nt) G_LOAD(p, t + 4);
            G_COMPUTE(1);
            lds_barrier();
        }
    }
#undef G_LOAD
#undef G_STORE
#undef G_COMPUTE
#pragma unroll
    for (int m = 0; m < 4; ++m)
#pragma unroll
        for (int n = 0; n < 4; ++n) epi(wr * 64 + m * 16 + fr, wc * 64 + n * 16 + fq * 4, acc[m][n]);
}

DEVINL void gemm_tile_b(const u16* __restrict__ A, int lda, const u16* __restrict__ Bt, int ldb, int K, char* lds, u16* __restrict__ dst, int ldd) {
    const int tid = threadIdx.x, lane = tid & 63, wave = tid >> 6, wr = wave >> 1, wc = wave & 1, fr = lane & 15, fq = lane >> 4;
    f32x4 acc[4][4];
#pragma unroll
    for (int m = 0; m < 4; ++m)
#pragma unroll
        for (int n = 0; n < 4; ++n) acc[m][n] = (f32x4){0.f, 0.f, 0.f, 0.f};
    const int srow = tid >> 2, sch = tid & 3;
    const u16* Ag = A + (size_t)srow * lda + sch * 8;
    const u16* Bg = Bt + (size_t)srow * ldb + sch * 8;
    const int soff = srow * 64 + ((sch ^ (((srow >> 3) & 1) << 1)) << 4);
    const int swz = ((fq ^ (((fr >> 3) & 1) << 1)) << 4);
    const int fa = (wr * 64 + fr) * 64 + swz;
    const int fb = 16384 + (wc * 64 + fr) * 64 + swz;
    uint4 pa0, pa1, pa2, pa3, pb0, pb1, pb2, pb3, qa0, qa1, qa2, qa3, qb0, qb1, qb2, qb3;
    const int nt = K >> 6;
    const size_t sA1 = (size_t)64 * lda, sB1 = (size_t)64 * ldb;
#define G_LOAD(P, T) do { const int k0_ = (T) << 6; \
        P##a0 = *(const uint4*)(Ag + k0_); P##a1 = *(const uint4*)(Ag + k0_ + 32); P##a2 = *(const uint4*)(Ag + sA1 + k0_); P##a3 = *(const uint4*)(Ag + sA1 + k0_ + 32); \
        P##b0 = *(const uint4*)(Bg + k0_); P##b1 = *(const uint4*)(Bg + k0_ + 32); P##b2 = *(const uint4*)(Bg + sB1 + k0_); P##b3 = *(const uint4*)(Bg + sB1 + k0_ + 32); } while (0)
#define G_STORE(P, ST) do { char* nb_ = lds + (ST) * 32768 + soff; \
        *(uint4*)(nb_) = P##a0; *(uint4*)(nb_ + 8192) = P##a1; *(uint4*)(nb_ + 4096) = P##a2; *(uint4*)(nb_ + 4096 + 8192) = P##a3; \
        *(uint4*)(nb_ + 16384) = P##b0; *(uint4*)(nb_ + 16384 + 8192) = P##b1; *(uint4*)(nb_ + 16384 + 4096) = P##b2; *(uint4*)(nb_ + 16384 + 4096 + 8192) = P##b3; } while (0)
    auto g_compute = [&](int ST) __attribute__((always_inline)) {
        const char* base = lds + ST * 32768;
#pragma unroll
        for (int s = 0; s < 2; ++s) {
            bf16x8 a[4], b[4];
#pragma unroll
            for (int m = 0; m < 4; ++m) a[m] = *(const bf16x8*)(base + fa + m * 1024 + s * 8192);
#pragma unroll
            for (int n = 0; n < 4; ++n) b[n] = *(const bf16x8*)(base + fb + n * 1024 + s * 8192);
            __builtin_amdgcn_s_setprio(1);
#pragma unroll
            for (int m = 0; m < 4; ++m)
#pragma unroll
                for (int n = 0; n < 4; ++n) acc[m][n] = __builtin_amdgcn_mfma_f32_16x16x32_bf16(b[n], a[m], acc[m][n], 0, 0, 0);
            __builtin_amdgcn_s_setprio(0);
        }
    };
#define G_COMPUTE(ST) g_compute(ST)
    G_LOAD(p, 0);
    if (nt > 1) G_LOAD(q, 1);
    G_STORE(p, 0);
    if (nt > 2) G_LOAD(p, 2);
    lds_barrier();
#pragma unroll 1
    for (int t = 0; t < nt; t += 2) {
        if (t + 1 < nt) G_STORE(q, 1);
        if (t + 3 < nt) G_LOAD(q, t + 3);
        G_COMPUTE(0);
        lds_barrier();
        if (t + 1 < nt) {
            if (t + 2 < nt) G_STORE(p, 0);
            if (t + 4 < nt) G_LOAD(p, t + 4);
            G_COMPUTE(1);
            lds_barrier();
        }
    }
#undef G_LOAD
#undef G_STORE
#undef G_COMPUTE
    {
        char* img = lds + wave * 9216;
#pragma unroll
        for (int m = 0; m < 4; ++m)
#pragma unroll
            for (int n = 0; n < 4; ++n)
                *(uint2*)(img + (m * 16 + fr) * 144 + (n * 16 + fq * 4) * 2) = make_uint2(pack2(acc[m][n][0], acc[m][n][1]), pack2(acc[m][n][2], acc[m][n][3]));
        u16* d0 = dst + (size_t)(wr * 64) * ldd + wc * 64 + (lane & 7) * 8;
#pragma unroll
        for (int it = 0; it < 8; ++it) {
            const int row = it * 8 + (lane >> 3);
            const uint4 v = *(const uint4*)(img + row * 144 + (lane & 7) * 16);
            *(uint4*)(d0 + (size_t)row * ldd) = v;
        }
    }
    lds_barrier();
}

template <class Epi>
DEVINL void gemm_tile1(const u16* __restrict__ A, int lda, const u16* __restrict__ Bt, int ldb, int K, char* lds, Epi epi) {
    const int tid = threadIdx.x, lane = tid & 63, wave = tid >> 6, wr = wave >> 1, wc = wave & 1, fr = lane & 15, fq = lane >> 4;
    f32x4 acc[4][4];
#pragma unroll
    for (int m = 0; m < 4; ++m)
#pragma unroll
        for (int n = 0; n < 4; ++n) acc[m][n] = (f32x4){0.f, 0.f, 0.f, 0.f};
    const int srow = tid >> 3, sch = tid & 7;
    const u16* Ag = A + (size_t)srow * lda + sch * 8;
    const u16* Bg = Bt + (size_t)srow * ldb + sch * 8;
    const int soff = (sch >> 2) * 8192 + srow * 64 + ((((sch & 3) ^ (((srow >> 3) & 1) << 1))) << 4);
    const int swz = ((fq ^ (((fr >> 3) & 1) << 1)) << 4);
    const int fa = (wr * 64 + fr) * 64 + swz;
    const int fb = 16384 + (wc * 64 + fr) * 64 + swz;
    uint4 ra[4], rb[4];
    const int nt = K >> 6;
#pragma unroll
    for (int i = 0; i < 4; ++i) {
        ra[i] = *(const uint4*)(Ag + (size_t)i * 32 * lda);
        rb[i] = *(const uint4*)(Bg + (size_t)i * 32 * ldb);
    }
#pragma unroll
    for (int i = 0; i < 4; ++i) {
        *(uint4*)(lds + soff + i * 2048) = ra[i];
        *(uint4*)(lds + 16384 + soff + i * 2048) = rb[i];
    }
    __syncthreads();
    for (int t = 0; t < nt; ++t) {
        const bool more = (t + 1 < nt);
        if (more) {
            const int k0 = (t + 1) << 6;
#pragma unroll
            for (int i = 0; i < 4; ++i) {
                ra[i] = *(const uint4*)(Ag + (size_t)i * 32 * lda + k0);
                rb[i] = *(const uint4*)(Bg + (size_t)i * 32 * ldb + k0);
            }
        }
        const char* base = lds + (t & 1) * 32768;
#pragma unroll
        for (int s = 0; s < 2; ++s) {
            bf16x8 a[4], b[4];
#pragma unroll
            for (int m = 0; m < 4; ++m) a[m] = *(const bf16x8*)(base + fa + m * 1024 + s * 8192);
#pragma unroll
            for (int n = 0; n < 4; ++n) b[n] = *(const bf16x8*)(base + fb + n * 1024 + s * 8192);
#pragma unroll
            for (int m = 0; m < 4; ++m)
#pragma unroll
                for (int n = 0; n < 4; ++n) acc[m][n] = __builtin_amdgcn_mfma_f32_16x16x32_bf16(b[n], a[m], acc[m][n], 0, 0, 0);
        }
        if (more) {
            char* nb = lds + ((t + 1) & 1) * 32768;
#pragma unroll
            for (int i = 0; i < 4; ++i) {
                *(uint4*)(nb + soff + i * 2048) = ra[i];
                *(uint4*)(nb + 16384 + soff + i * 2048) = rb[i];
            }
        }
        __syncthreads();
    }
#pragma unroll
    for (int m = 0; m < 4; ++m)
#pragma unroll
        for (int n = 0; n < 4; ++n) epi(wr * 64 + m * 16 + fr, wc * 64 + n * 16 + fq * 4, acc[m][n]);
}

DEVINL void tile_mn(int id, int nM, int nN, int& m, int& n) {
    const int grp = id / (8 * nN), fm = grp * 8;
    const int gsz = (nM - fm) < 8 ? (nM - fm) : 8;
    const int rem = id - grp * 8 * nN;
    m = fm + rem % gsz; n = rem / gsz;
}

template <class F>
DEVINL void for_tiles_xcd(int T, F f) {
    const int G = gridDim.x;
    if ((G & 7) == 0) {
        const int x = blockIdx.x & 7, s = blockIdx.x >> 3, GS = G >> 3, per = ((((T + 7) >> 3) + 63) >> 6) << 6;
        for (int i = s; i < per; i += GS) { const int id = x * per + i; if (id < T) f(id); }
    } else {
        for (int id = blockIdx.x; id < T; id += G) f(id);
    }
}

DEVINL void transpose_tile(const float* __restrict__ W, int K, int N, u16* __restrict__ Wt, int k0, int n0, float* tile) {
    const int tid = threadIdx.x, tx = tid & 15, ty = tid >> 4;
#pragma unroll
    for (int i = 0; i < 4; ++i) {
        const int k = ty + 16 * i, n = n0 + tx * 4;
        float4 v = make_float4(0.f, 0.f, 0.f, 0.f);
        if (n < N) v = ldnt4(W + (size_t)(k0 + k) * N + n);
        float* t = tile + k * 65 + tx * 4;
        t[0] = v.x; t[1] = v.y; t[2] = v.z; t[3] = v.w;
    }
    __syncthreads();
    const int n = tid >> 2, kc = (tid & 3) * 16;
    uint32_t w[8];
#pragma unroll
    for (int j = 0; j < 8; ++j) w[j] = pack2(tile[(kc + 2 * j) * 65 + n], tile[(kc + 2 * j + 1) * 65 + n]);
    uint4* dst = (uint4*)(Wt + (size_t)(n0 + n) * K + k0 + kc);
    dst[0] = make_uint4(w[0], w[1], w[2], w[3]);
    dst[1] = make_uint4(w[4], w[5], w[6], w[7]);
    __syncthreads();
}

DEVINL void rowpass_row(const float* __restrict__ base, const u16* __restrict__ trow, const float* __restrict__ gpost,
                        float* __restrict__ xdst, const float* __restrict__ gnext, u16* __restrict__ hb, int lane, bool ntx = false) {
    float x[16];
    {
        const float4 a = *(const float4*)(base + lane * 8), b = *(const float4*)(base + lane * 8 + 4);
        const float4 c = *(const float4*)(base + 512 + lane * 8), d = *(const float4*)(base + 512 + lane * 8 + 4);
        x[0] = a.x; x[1] = a.y; x[2] = a.z; x[3] = a.w; x[4] = b.x; x[5] = b.y; x[6] = b.z; x[7] = b.w;
        x[8] = c.x; x[9] = c.y; x[10] = c.z; x[11] = c.w; x[12] = d.x; x[13] = d.y; x[14] = d.z; x[15] = d.w;
    }
    if (trow) {
        float t[16], g[16];
        {
            const uint4 t0 = *(const uint4*)(trow + lane * 8), t1 = *(const uint4*)(trow + 512 + lane * 8);
            t[0] = lo16(t0.x); t[1] = hi16(t0.x); t[2] = lo16(t0.y); t[3] = hi16(t0.y); t[4] = lo16(t0.z); t[5] = hi16(t0.z); t[6] = lo16(t0.w); t[7] = hi16(t0.w);
            t[8] = lo16(t1.x); t[9] = hi16(t1.x); t[10] = lo16(t1.y); t[11] = hi16(t1.y); t[12] = lo16(t1.z); t[13] = hi16(t1.z); t[14] = lo16(t1.w); t[15] = hi16(t1.w);
        }
#pragma unroll
        for (int h = 0; h < 2; ++h)
#pragma unroll
            for (int q = 0; q < 2; ++q) {
                const float4 gg = *(const float4*)(gpost + h * 512 + lane * 8 + q * 4);
                g[h * 8 + q * 4 + 0] = gg.x; g[h * 8 + q * 4 + 1] = gg.y; g[h * 8 + q * 4 + 2] = gg.z; g[h * 8 + q * 4 + 3] = gg.w;
            }
        float ss = 0.f;
#pragma unroll
        for (int i = 0; i < 16; ++i) ss += t[i] * t[i];
        ss = wave_sum(ss);
        const float rstd = rsqrtf(ss * (1.0f / 1024.0f) + EPS);
#pragma unroll
        for (int i = 0; i < 16; ++i) x[i] += t[i] * rstd * g[i];
    }
    if (xdst) {
#pragma unroll
        for (int h = 0; h < 2; ++h)
#pragma unroll
            for (int q = 0; q < 2; ++q)
            {
                const float4 xv = make_float4(x[h * 8 + q * 4], x[h * 8 + q * 4 + 1], x[h * 8 + q * 4 + 2], x[h * 8 + q * 4 + 3]);
                if (ntx) stnt4(xdst + h * 512 + lane * 8 + q * 4, xv); else *(float4*)(xdst + h * 512 + lane * 8 + q * 4) = xv;
            }
    }
    if (gnext) {
        float ss = 0.f;
#pragma unroll
        for (int i = 0; i < 16; ++i) ss += x[i] * x[i];
        ss = wave_sum(ss);
        const float rstd = rsqrtf(ss * (1.0f / 1024.0f) + EPS);
#pragma unroll
        for (int h = 0; h < 2; ++h) {
            const float4 g0 = *(const float4*)(gnext + h * 512 + lane * 8), g1 = *(const float4*)(gnext + h * 512 + lane * 8 + 4);
            uint4 o;
            o.x = pack2(x[h * 8 + 0] * rstd * g0.x, x[h * 8 + 1] * rstd * g0.y);
            o.y = pack2(x[h * 8 + 2] * rstd * g0.z, x[h * 8 + 3] * rstd * g0.w);
            o.z = pack2(x[h * 8 + 4] * rstd * g1.x, x[h * 8 + 5] * rstd * g1.y);
            o.w = pack2(x[h * 8 + 6] * rstd * g1.z, x[h * 8 + 7] * rstd * g1.w);
            *(uint4*)(hb + h * 512 + lane * 8) = o;
        }
    }
}

DEVINL void phase_prologue(const Params& p, char* lds) {
    const int G = gridDim.x;
    u16* WinT = (u16*)(p.ws + OFF_WIN);
    u16* WoutT = (u16*)(p.ws + OFF_WOUT);
    for (int it = blockIdx.x; it < 6464; it += G) {
        const int l = it / 3232; int r = it % 3232;
        const float* W; u16* Wt; int K, N, kt, nt;
        if (r < 1696) { W = p.in[I_WIN] + (size_t)l * 1024 * DIN; K = 1024; N = DIN; Wt = WinT + (size_t)l * DINP * 1024; kt = r & 15; nt = r >> 4; }
        else if (r < 2208) { r -= 1696; W = p.in[I_WOUT] + (size_t)l * 2048 * 1024; K = 2048; N = 1024; Wt = WoutT + (size_t)l * 1024 * 2048; kt = r & 31; nt = r >> 5; }
        else {
            r -= 2208; const int j = r >> 8; r &= 255;
            W = p.in[j == 0 ? I_WQ : j == 1 ? I_WK : j == 2 ? I_WV : I_WO] + (size_t)l * 1024 * 1024;
            Wt = (u16*)(p.ws + (j == 0 ? OFF_WQ : j == 1 ? OFF_WK : j == 2 ? OFF_WV : OFF_WO)) + (size_t)l * 1024 * 1024;
            K = 1024; N = 1024; kt = r & 15; nt = r >> 4;
        }
        transpose_tile(W, K, N, Wt, kt * 64, nt * 64, (float*)lds);
    }
    const int wave = threadIdx.x >> 6, lane = threadIdx.x & 63;
    float* X = (float*)(p.ws + OFF_X);
    u16* Hb = (u16*)(p.ws + OFF_HB);
    u16* Mb = (u16*)(p.ws + OFF_MB);
    for (int it = blockIdx.x; it < (NR + 2048) / 4; it += G) {
        const int r = it * 4 + wave;
        if (r < NR) {
            const float* src = r < NP ? p.in[I_XP] + (size_t)r * 1024 : p.in[I_XS] + (size_t)(r - NP) * 1024;
            rowpass_row(src, nullptr, nullptr, nullptr, p.in[I_GPM], Hb + (size_t)r * 1024, lane);
        } else {
            const int m = r - NR;
            rowpass_row(p.in[I_MEM] + (size_t)m * 1024, nullptr, nullptr, nullptr, p.in[I_GMEM], Mb + (size_t)m * 1024, lane);
        }
    }
}

DEVINL void phase_gemm_in(const Params& p, int l, char* lds) {
    const u16* Hb = (const u16*)(p.ws + OFF_HB);
    const u16* Mb = (const u16*)(p.ws + OFF_MB);
    const u16* WinT = (const u16*)(p.ws + OFF_WIN) + (size_t)l * DINP * 1024;
    const u16* WkT = (const u16*)(p.ws + OFF_WK) + (size_t)l * 1024 * 1024;
    const u16* WvT = (const u16*)(p.ws + OFF_WV) + (size_t)l * 1024 * 1024;
    u16* U = (u16*)(p.ws + OFF_U);
    u16* MKb = (u16*)(p.ws + OFF_MK);
    u16* MVT = (u16*)(p.ws + OFF_MVT);
    float* omk = p.out + O_MKP + (size_t)l * 2048 * 1024;
    float* omv = p.out + O_MVP + (size_t)l * 2048 * 1024;
    constexpr int TU = 129 * 53;
    for_tiles_xcd(TU + 256, [&](int id) {
        if (id < TU) {
            int m, n; tile_mn(id, 129, 53, m, n);
            u16* dst = U + (size_t)m * 128 * DINP + n * 128;
            gemm_tile_b(Hb + (size_t)m * 128 * 1024, 1024, WinT + (size_t)n * 128 * 1024, 1024, 1024, lds, dst, DINP);
        } else {
            int id2 = id - TU; const int isv = id2 >> 7; id2 &= 127;
            const int m = id2 & 15, n = id2 >> 4;
            if (!isv) {
                float* df = omk + (size_t)m * 128 * 1024 + n * 128;
                u16* db = MKb + (size_t)m * 128 * 1024 + n * 128;
                gemm_tile(Mb + (size_t)m * 128 * 1024, 1024, WkT + (size_t)n * 128 * 1024, 1024, 1024, lds,
                          [&](int r, int c, f32x4 v) {
                              stnt4(df + (size_t)r * 1024 + c, make_float4(v[0], v[1], v[2], v[3]));
                              *(uint2*)(db + (size_t)r * 1024 + c) = make_uint2(pack2(v[0], v[1]), pack2(v[2], v[3]));
                          });
            } else {
                float* df = omv + (size_t)m * 128 * 1024 + n * 128;
                gemm_tile(Mb + (size_t)m * 128 * 1024, 1024, WvT + (size_t)n * 128 * 1024, 1024, 1024, lds,
                          [&](int r, int c, f32x4 v) {
                              stnt4(df + (size_t)r * 1024 + c, make_float4(v[0], v[1], v[2], v[3]));
                              const int row = m * 128 + r, col = n * 128 + c;
                              const int b = row >> 8, mm = row & 255, h = col >> 8, d = col & 255;
                              u16* t = MVT + ((size_t)((b * 4 + h) * 256 + d)) * 256 + mm;
                              t[0] = (u16)f2bf(v[0]); t[256] = (u16)f2bf(v[1]); t[512] = (u16)f2bf(v[2]); t[768] = (u16)f2bf(v[3]);
                          });
            }
        }
    });
}

DEVINL void phase_gemm_n1024(const u16* A, int K, const u16* Wt, float* Cf, u16* Cb, char* lds) {
    for_tiles_xcd(128 * 8, [&](int id) {
        int m, n; tile_mn(id, 128, 8, m, n);
        const size_t o = (size_t)m * 128 * 1024 + n * 128;
        if (Cf) {
            float* df = Cf + o;
            gemm_tile(A + (size_t)m * 128 * K, K, Wt + (size_t)n * 128 * K, K, K, lds,
                      [&](int r, int c, f32x4 v) { *(float4*)(df + (size_t)r * 1024 + c) = make_float4(v[0], v[1], v[2], v[3]); });
        } else {
            u16* db = Cb + o;
            gemm_tile_b(A + (size_t)m * 128 * K, K, Wt + (size_t)n * 128 * K, K, K, lds, db, 1024);
        }
    });
    const int tid = threadIdx.x, lane = tid & 63, w = tid >> 6, fr = lane & 15, fq = lane >> 4;
    float* red = (float*)lds;
    for (int pc = blockIdx.x; pc < 512; pc += gridDim.x) {
        const int row0 = NP + (pc >> 6) * 16, col0 = (pc & 63) * 16;
        const int kq = K >> 2;
        const u16* pa = A + (size_t)(row0 + fr) * K + w * kq + fq * 8;
        const u16* pb = Wt + (size_t)(col0 + fr) * K + w * kq + fq * 8;
        f32x4 acc = (f32x4){0.f, 0.f, 0.f, 0.f};
#pragma unroll 4
        for (int k = 0; k < kq; k += 32)
            acc = __builtin_amdgcn_mfma_f32_16x16x32_bf16(*(const bf16x8*)(pb + k), *(const bf16x8*)(pa + k), acc, 0, 0, 0);
        *(float4*)(red + (w * 64 + lane) * 4) = make_float4(acc[0], acc[1], acc[2], acc[3]);
        __syncthreads();
        if (w == 0) {
            const float4 a0 = *(const float4*)(red + lane * 4), a1 = *(const float4*)(red + (64 + lane) * 4), a2 = *(const float4*)(red + (128 + lane) * 4), a3 = *(const float4*)(red + (192 + lane) * 4);
            const float v0 = a0.x + a1.x + a2.x + a3.x, v1 = a0.y + a1.y + a2.y + a3.y, v2 = a0.z + a1.z + a2.z + a3.z, v3 = a0.w + a1.w + a2.w + a3.w;
            const size_t o = (size_t)(row0 + fr) * 1024 + col0 + fq * 4;
            if (Cf) *(float4*)(Cf + o) = make_float4(v0, v1, v2, v3);
            else *(uint2*)(Cb + o) = make_uint2(pack2(v0, v1), pack2(v2, v3));
        }
        __syncthreads();
    }
}

DEVINL float hgrn_lb(const Params& p, int l, int c) {
    if (l == 0) return 0.f;
    const float b0 = p.in[I_HLB][c], b1 = p.in[I_HLB][512 + c];
    return 1.0f / (1.0f + __expf(b0 - b1));
}

DEVINL void hgrn_prep_unit(const Params& p, int l, int u, char* lds) {
    const int c = u & 63, h = (u >> 6) & 3, b = u >> 8;
    const int tid = threadIdx.x;
    float* tot = (float*)lds;
    const u16* U = (const u16*)(p.ws + OFF_U);
    u16* QG = (u16*)(p.ws + OFF_HQG) + (size_t)u * 4096;
    u16* QM = (u16*)(p.ws + OFF_HQM) + (size_t)u * 4096;
    u16* KM = (u16*)(p.ws + OFF_HKM) + (size_t)u * 4096;
    u16* KD = (u16*)(p.ws + OFF_HKD) + (size_t)u * 4096;
    float* DS = (float*)(p.ws + OFF_HDS) + (size_t)u * 128;
    const int kp = (tid & 63) * 2, tq = tid >> 6;
    const float lb0 = hgrn_lb(p, l, h * 128 + kp), lb1 = hgrn_lb(p, l, h * 128 + kp + 1);
    const u16* pQ = U + ((size_t)b * SEQ + c * 32 + tq * 8) * DINP + 2048 + h * 128 + kp;
    uint32_t rq[8], rf[8];
#pragma unroll
    for (int i = 0; i < 8; ++i) { rq[i] = *(const uint32_t*)(pQ + (size_t)i * DINP); rf[i] = *(const uint32_t*)(pQ + (size_t)i * DINP + 512); }
    float f0[8], f1[8], L0[8], L1[8];
    {
        float a0 = 0.f, a1 = 0.f;
#pragma unroll
        for (int i = 0; i < 8; ++i) {
            f0[i] = lb0 + (1.f - lb0) * sigmoidf_(lo16(rf[i]));
            f1[i] = lb1 + (1.f - lb1) * sigmoidf_(hi16(rf[i]));
            a0 += __logf(f0[i]); a1 += __logf(f1[i]);
            L0[i] = a0; L1[i] = a1;
        }
        *(float2*)(tot + tq * 128 + kp) = make_float2(a0, a1);
    }
    __syncthreads();
    {
        const float2 t0 = *(const float2*)(tot + kp), t1 = *(const float2*)(tot + 128 + kp), t2 = *(const float2*)(tot + 256 + kp), t3 = *(const float2*)(tot + 384 + kp);
        const float off0 = (tq > 0 ? t0.x : 0.f) + (tq > 1 ? t1.x : 0.f) + (tq > 2 ? t2.x : 0.f);
        const float off1 = (tq > 0 ? t0.y : 0.f) + (tq > 1 ? t1.y : 0.f) + (tq > 2 ? t2.y : 0.f);
        const float ref0 = t0.x + t1.x, ref1 = t0.y + t1.y;
        const float last0 = ref0 + t2.x + t3.x, last1 = ref1 + t2.y + t3.y;
        uint32_t kd[8];
#pragma unroll
        for (int i = 0; i < 8; ++i) {
            const int t = tq * 8 + i;
            const float G0 = L0[i] + off0, G1 = L1[i] + off1;
            const float q0 = lo16(rq[i]), q1 = hi16(rq[i]);
            const float k0 = 1.f - f0[i], k1 = 1.f - f1[i];
            *(uint32_t*)(QG + t * 128 + kp) = pack2(q0 * __expf(G0), q1 * __expf(G1));
            *(uint32_t*)(QM + t * 128 + kp) = pack2(q0 * __expf(fminf(G0 - ref0, 60.f)), q1 * __expf(fminf(G1 - ref1, 60.f)));
            *(uint32_t*)(KM + t * 128 + kp) = pack2(k0 * __expf(fminf(ref0 - G0, 60.f)), k1 * __expf(fminf(ref1 - G1, 60.f)));
            kd[i] = pack2(k0 * __expf(last0 - G0), k1 * __expf(last1 - G1));
        }
        *(uint4*)(KD + kp * 32 + tq * 8) = make_uint4((kd[0] & 0xffffu) | (kd[1] << 16), (kd[2] & 0xffffu) | (kd[3] << 16), (kd[4] & 0xffffu) | (kd[5] << 16), (kd[6] & 0xffffu) | (kd[7] << 16));
        *(uint4*)(KD + (kp + 1) * 32 + tq * 8) = make_uint4((kd[0] >> 16) | (kd[1] & 0xffff0000u), (kd[2] >> 16) | (kd[3] & 0xffff0000u), (kd[4] >> 16) | (kd[5] & 0xffff0000u), (kd[6] >> 16) | (kd[7] & 0xffff0000u));
        if (tq == 0) *(float2*)(DS + kp) = make_float2(__expf(last0), __expf(last1));
    }
    __syncthreads();
}

DEVINL void phase_prep(const Params& p, int l, char* lds) {
    for (int u = blockIdx.x; u < 2048; u += gridDim.x) hgrn_prep_unit(p, l, u, lds);
    const u16* U = (const u16*)(p.ws + OFF_U);
    u16* Ycat = (u16*)(p.ws + OFF_YCAT);
    float* XBC = (float*)(p.ws + OFF_XBC);
    float* DT = (float*)(p.ws + OFF_DT);
    const int tid = threadIdx.x;
#pragma unroll 1
    for (int it = blockIdx.x; it < 1024; it += gridDim.x) {
        const int b = it >> 7, t0 = (it & 127) * 16;
        const size_t r0 = (size_t)b * SEQ + t0;
        if (tid < 64) {
            const int c0 = tid * 8;
            const float* cw = p.in[I_CAW] + (size_t)l * 3 * 512 + c0;
            float w0[8], w1[8], w2[8], pm2[8], pm1[8];
            {
                const float4 a0 = *(const float4*)cw, a1 = *(const float4*)(cw + 4), b0 = *(const float4*)(cw + 512), b1 = *(const float4*)(cw + 516), d0 = *(const float4*)(cw + 1024), d1 = *(const float4*)(cw + 1028);
                w0[0] = a0.x; w0[1] = a0.y; w0[2] = a0.z; w0[3] = a0.w; w0[4] = a1.x; w0[5] = a1.y; w0[6] = a1.z; w0[7] = a1.w;
                w1[0] = b0.x; w1[1] = b0.y; w1[2] = b0.z; w1[3] = b0.w; w1[4] = b1.x; w1[5] = b1.y; w1[6] = b1.z; w1[7] = b1.w;
                w2[0] = d0.x; w2[1] = d0.y; w2[2] = d0.z; w2[3] = d0.w; w2[4] = d1.x; w2[5] = d1.y; w2[6] = d1.z; w2[7] = d1.w;
            }
            if (t0 > 0) {
                const u16* Uq = U + (r0 - 2) * DINP;
                const uint4 h2 = *(const uint4*)(Uq + c0), c2 = *(const uint4*)(Uq + 1024 + c0), h1 = *(const uint4*)(Uq + DINP + c0), c1 = *(const uint4*)(Uq + DINP + 1024 + c0);
                float fh[8], fc[8];
                UNPACK8(h2, fh); UNPACK8(c2, fc);
#pragma unroll
                for (int i = 0; i < 8; ++i) pm2[i] = fc[i] * fh[i];
                UNPACK8(h1, fh); UNPACK8(c1, fc);
#pragma unroll
                for (int i = 0; i < 8; ++i) pm1[i] = fc[i] * fh[i];
            } else {
#pragma unroll
                for (int i = 0; i < 8; ++i) { pm2[i] = 0.f; pm1[i] = 0.f; }
            }
            const float dtb = (tid < 16) ? p.in[I_DTB][l * 16 + tid] : 0.f;
#pragma unroll 4
            for (int j = 0; j < 16; ++j) {
                const u16* Ur = U + (r0 + j) * DINP;
                const uint4 vh = *(const uint4*)(Ur + c0), vc = *(const uint4*)(Ur + 1024 + c0), vb = *(const uint4*)(Ur + 512 + c0), vz = *(const uint4*)(Ur + 1536 + c0);
                float fh[8], fc[8], fb[8], fz[8], pc[8], y[8];
                UNPACK8(vh, fh); UNPACK8(vc, fc); UNPACK8(vb, fb); UNPACK8(vz, fz);
#pragma unroll
                for (int i = 0; i < 8; ++i) {
                    pc[i] = fc[i] * fh[i];
                    const float cv = w0[i] * pm2[i] + w1[i] * pm1[i] + w2[i] * pc[i];
                    y[i] = fb[i] * cv * siluf_(fz[i]);
                    pm2[i] = pm1[i]; pm1[i] = pc[i];
                }
                *(uint4*)(Ycat + (r0 + j) * 2048 + c0) = make_uint4(pack2(y[0], y[1]), pack2(y[2], y[3]), pack2(y[4], y[5]), pack2(y[6], y[7]));
                if (t0 + j >= SEQ - 2) {
                    float* o = p.out + O_CAP + (((size_t)l * 8 + b) * 2 + (t0 + j - (SEQ - 2))) * 512 + c0;
                    *(float4*)o = make_float4(pc[0], pc[1], pc[2], pc[3]);
                    *(float4*)(o + 4) = make_float4(pc[4], pc[5], pc[6], pc[7]);
                }
                if (tid < 16) {
                    const float xx = bf2f(Ur[6656 + tid]) + dtb;
                    DT[(r0 + j) * 16 + tid] = xx > 20.f ? xx : log1pf(__expf(xx));
                }
            }
        } else {
            const int c0 = (tid - 64) * 8;
            const float* cw = p.in[I_SCW] + (size_t)l * 4 * 1536 + c0;
            const float* cb = p.in[I_SCB] + (size_t)l * 1536 + c0;
            float w0[8], w1[8], w2[8], w3[8], bs[8], x3[8], x2[8], x1[8];
#pragma unroll
            for (int i = 0; i < 8; ++i) { w0[i] = cw[i]; w1[i] = cw[1536 + i]; w2[i] = cw[3072 + i]; w3[i] = cw[4608 + i]; bs[i] = cb[i]; }
            if (t0 > 0) {
                const u16* Uq = U + (r0 - 3) * DINP + 5120 + c0;
                const uint4 v3 = *(const uint4*)Uq, v2 = *(const uint4*)(Uq + DINP), v1 = *(const uint4*)(Uq + 2 * (size_t)DINP);
                UNPACK8(v3, x3); UNPACK8(v2, x2); UNPACK8(v1, x1);
            } else {
#pragma unroll
                for (int i = 0; i < 8; ++i) { x3[i] = 0.f; x2[i] = 0.f; x1[i] = 0.f; }
            }
#pragma unroll 4
            for (int j = 0; j < 16; ++j) {
                const uint4 v = *(const uint4*)(U + (r0 + j) * DINP + 5120 + c0);
                float x0[8], y[8];
                UNPACK8(v, x0);
#pragma unroll
                for (int i = 0; i < 8; ++i) {
                    y[i] = siluf_(w0[i] * x3[i] + w1[i] * x2[i] + w2[i] * x1[i] + w3[i] * x0[i] + bs[i]);
                    x3[i] = x2[i]; x2[i] = x1[i]; x1[i] = x0[i];
                }
                *(uint4*)((u16*)(p.ws + OFF_XBCB) + (r0 + j) * 1536 + c0) = make_uint4(pack2(y[0], y[1]), pack2(y[2], y[3]), pack2(y[4], y[5]), pack2(y[6], y[7]));
                if (t0 + j >= SEQ - 3) {
                    float* o = p.out + O_SCP + (((size_t)l * 8 + b) * 3 + (t0 + j - (SEQ - 3))) * 1536 + c0;
                    *(float4*)o = make_float4(x0[0], x0[1], x0[2], x0[3]);
                    *(float4*)(o + 4) = make_float4(x0[4], x0[5], x0[6], x0[7]);
                }
            }
        }
    }
    for (int r = NP + blockIdx.x; r < NR; r += gridDim.x) {
        const bool prompt = false;
        const int t = r & (SEQ - 1), b = r >> 11, s = r - NP;
        const u16* Ur = U + (size_t)r * DINP;
        if (tid < 64) {
            const int c0 = tid * 8;
            float pv[3][8];
#pragma unroll
            for (int j = 0; j < 3; ++j) {
                const int back = 2 - j;
                if (prompt ? (t - back >= 0) : (back == 0)) {
                    const u16* Uq = Ur - (size_t)back * DINP;
                    const uint4 vh = *(const uint4*)(Uq + c0), vc = *(const uint4*)(Uq + 1024 + c0);
                    float fh[8], fc[8]; UNPACK8(vh, fh); UNPACK8(vc, fc);
#pragma unroll
                    for (int i = 0; i < 8; ++i) pv[j][i] = fc[i] * fh[i];
                } else if (prompt) {
#pragma unroll
                    for (int i = 0; i < 8; ++i) pv[j][i] = 0.f;
                } else {
                    const float* st = p.in[I_SCA] + (((size_t)l * NS + s) * 2 + j) * 512 + c0;
                    const float4 a = *(const float4*)st, bb = *(const float4*)(st + 4);
                    pv[j][0] = a.x; pv[j][1] = a.y; pv[j][2] = a.z; pv[j][3] = a.w; pv[j][4] = bb.x; pv[j][5] = bb.y; pv[j][6] = bb.z; pv[j][7] = bb.w;
                }
            }
            const float* cw = p.in[I_CAW] + (size_t)l * 3 * 512 + c0;
            const uint4 vb = *(const uint4*)(Ur + 512 + c0), vz = *(const uint4*)(Ur + 1536 + c0);
            float fb[8], fz[8]; UNPACK8(vb, fb); UNPACK8(vz, fz);
            float y[8];
#pragma unroll
            for (int i = 0; i < 8; ++i) {
                const float cv = cw[i] * pv[0][i] + cw[512 + i] * pv[1][i] + cw[1024 + i] * pv[2][i];
                y[i] = fb[i] * cv * siluf_(fz[i]);
            }
            *(uint4*)(Ycat + (size_t)r * 2048 + c0) = make_uint4(pack2(y[0], y[1]), pack2(y[2], y[3]), pack2(y[4], y[5]), pack2(y[6], y[7]));
            if (prompt) {
                if (t >= SEQ - 2) {
                    float* o = p.out + O_CAP + (((size_t)l * 8 + b) * 2 + (t - (SEQ - 2))) * 512 + c0;
                    *(float4*)o = make_float4(pv[2][0], pv[2][1], pv[2][2], pv[2][3]);
                    *(float4*)(o + 4) = make_float4(pv[2][4], pv[2][5], pv[2][6], pv[2][7]);
                }
            } else {
                float* o = p.out + O_CAS + (((size_t)l * NS + s) * 2) * 512 + c0;
                *(float4*)o = make_float4(pv[1][0], pv[1][1], pv[1][2], pv[1][3]);
                *(float4*)(o + 4) = make_float4(pv[1][4], pv[1][5], pv[1][6], pv[1][7]);
                *(float4*)(o + 512) = make_float4(pv[2][0], pv[2][1], pv[2][2], pv[2][3]);
                *(float4*)(o + 516) = make_float4(pv[2][4], pv[2][5], pv[2][6], pv[2][7]);
            }
        } else {
            const int c0 = (tid - 64) * 8;
            float xv[4][8];
#pragma unroll
            for (int j = 0; j < 4; ++j) {
                const int back = 3 - j;
                if (prompt ? (t - back >= 0) : (back == 0)) {
                    const uint4 v = *(const uint4*)(Ur - (size_t)back * DINP + 5120 + c0);
                    UNPACK8(v, xv[j]);
                } else if (prompt) {
#pragma unroll
                    for (int i = 0; i < 8; ++i) xv[j][i] = 0.f;
                } else {
                    const float* st = p.in[I_SSC] + (((size_t)l * NS + s) * 3 + j) * 1536 + c0;
                    const float4 a = *(const float4*)st, bb = *(const float4*)(st + 4);
                    xv[j][0] = a.x; xv[j][1] = a.y; xv[j][2] = a.z; xv[j][3] = a.w; xv[j][4] = bb.x; xv[j][5] = bb.y; xv[j][6] = bb.z; xv[j][7] = bb.w;
                }
            }
            const float* cw = p.in[I_SCW] + (size_t)l * 4 * 1536 + c0;
            const float* cb = p.in[I_SCB] + (size_t)l * 1536 + c0;
            float y[8];
#pragma unroll
            for (int i = 0; i < 8; ++i) {
                const float cv = cw[i] * xv[0][i] + cw[1536 + i] * xv[1][i] + cw[3072 + i] * xv[2][i] + cw[4608 + i] * xv[3][i] + cb[i];
                y[i] = siluf_(cv);
            }
            if (!prompt) {
                float* xo = XBC + (size_t)r * 1536 + c0;
                *(float4*)xo = make_float4(y[0], y[1], y[2], y[3]);
                *(float4*)(xo + 4) = make_float4(y[4], y[5], y[6], y[7]);
            }
            *(uint4*)((u16*)(p.ws + OFF_XBCB) + (size_t)r * 1536 + c0) = make_uint4(pack2(y[0], y[1]), pack2(y[2], y[3]), pack2(y[4], y[5]), pack2(y[6], y[7]));
            if (prompt) {
                if (t >= SEQ - 3) {
                    float* o = p.out + O_SCP + (((size_t)l * 8 + b) * 3 + (t - (SEQ - 3))) * 1536 + c0;
                    *(float4*)o = make_float4(xv[3][0], xv[3][1], xv[3][2], xv[3][3]);
                    *(float4*)(o + 4) = make_float4(xv[3][4], xv[3][5], xv[3][6], xv[3][7]);
                }
            } else {
                float* o = p.out + O_SCS + (((size_t)l * NS + s) * 3) * 1536 + c0;
#pragma unroll
                for (int j = 0; j < 3; ++j) {
                    *(float4*)(o + j * 1536) = make_float4(xv[j + 1][0], xv[j + 1][1], xv[j + 1][2], xv[j + 1][3]);
                    *(float4*)(o + j * 1536 + 4) = make_float4(xv[j + 1][4], xv[j + 1][5], xv[j + 1][6], xv[j + 1][7]);
                }
            }
        }
        if (tid < 16) {
            const float xx = bf2f(Ur[6656 + tid]) + p.in[I_DTB][l * 16 + tid];
            DT[(size_t)r * 16 + tid] = xx > 20.f ? xx : log1pf(__expf(xx));
        }
    }
}


DEVINL void hgrn_prompt_item(const Params& p, int l, int item, char* lds) {
    const int b = item >> 5, h = (item >> 3) & 3, vs = item & 7;
    const int tid = threadIdx.x, lane = tid & 63, wave = tid >> 6;
    const int vl = wave * 4 + (lane >> 4), kg = lane & 15;
    float* fS = (float*)lds;
    float* qS = fS + 2048;
    float* vS = qS + 2048;
    float* part = vS + 256;
    const u16* U = (const u16*)(p.ws + OFF_U);
    float* OB = (float*)(p.ws + OFF_OB);
    const int tl = tid >> 4, kc = (tid & 15) * 8, vi = tid & 15;
    float lbv[8];
#pragma unroll
    for (int j = 0; j < 8; ++j) lbv[j] = hgrn_lb(p, l, h * 128 + kc + j);
    const size_t rowb = (size_t)b * SEQ;
    const u16* Uq = U + (rowb + tl) * DINP + 2048 + h * 128 + kc;
    const u16* Uv = U + (rowb + tl) * DINP + 3072 + h * 128 + vs * 16 + vi;
    float S[8];
#pragma unroll
    for (int i = 0; i < 8; ++i) S[i] = 0.f;
    uint4 rq = *(const uint4*)Uq, rf = *(const uint4*)(Uq + 512);
    u16 rv = *Uv;
    for (int c = 0; c < SEQ / 16; ++c) {
        {
            float q[8], g[8]; UNPACK8(rq, q); UNPACK8(rf, g);
#pragma unroll
            for (int j = 0; j < 8; ++j) g[j] = lbv[j] + (1.0f - lbv[j]) * sigmoidf_(g[j]);
            *(float4*)(qS + tl * 128 + kc) = make_float4(q[0], q[1], q[2], q[3]);
            *(float4*)(qS + tl * 128 + kc + 4) = make_float4(q[4], q[5], q[6], q[7]);
            *(float4*)(fS + tl * 128 + kc) = make_float4(g[0], g[1], g[2], g[3]);
            *(float4*)(fS + tl * 128 + kc + 4) = make_float4(g[4], g[5], g[6], g[7]);
            vS[tl * 16 + vi] = bf2f(rv);
        }
        if (c + 1 < SEQ / 16) {
            const size_t adv = (size_t)(c + 1) * 16 * DINP;
            rq = *(const uint4*)(Uq + adv); rf = *(const uint4*)(Uq + adv + 512); rv = *(Uv + adv);
        }
        __syncthreads();
#pragma unroll 1
        for (int tg = 0; tg < 16; tg += 4) {
        float pa[4];
#pragma unroll
        for (int tt = 0; tt < 4; ++tt) {
            const int t = tg + tt;
            const float4 f0 = *(const float4*)(fS + t * 128 + kg * 4), f1 = *(const float4*)(fS + t * 128 + 64 + kg * 4);
            const float4 q0 = *(const float4*)(qS + t * 128 + kg * 4), q1 = *(const float4*)(qS + t * 128 + 64 + kg * 4);
            const float vv = vS[t * 16 + vl];
            S[0] = f0.x * S[0] + (1.f - f0.x) * vv; S[1] = f0.y * S[1] + (1.f - f0.y) * vv;
            S[2] = f0.z * S[2] + (1.f - f0.z) * vv; S[3] = f0.w * S[3] + (1.f - f0.w) * vv;
            S[4] = f1.x * S[4] + (1.f - f1.x) * vv; S[5] = f1.y * S[5] + (1.f - f1.y) * vv;
            S[6] = f1.z * S[6] + (1.f - f1.z) * vv; S[7] = f1.w * S[7] + (1.f - f1.w) * vv;
            float a = q0.x * S[0] + q0.y * S[1] + q0.z * S[2] + q0.w * S[3];
            a += q1.x * S[4] + q1.y * S[5] + q1.z * S[6] + q1.w * S[7];
            pa[tt] = a;
        }
#pragma unroll
        for (int tt = 0; tt < 4; ++tt) part[(tg + tt) * 256 + vl * 16 + kg] = pa[tt];
        }
        __syncthreads();
        {
            const float* pp = part + tl * 256 + vi * 16;
            const float4 a = *(const float4*)pp, bq = *(const float4*)(pp + 4), cq = *(const float4*)(pp + 8), dq = *(const float4*)(pp + 12);
            const float o = (a.x + a.y + a.z + a.w) + (bq.x + bq.y + bq.z + bq.w) + (cq.x + cq.y + cq.z + cq.w) + (dq.x + dq.y + dq.z + dq.w);
            OB[(rowb + c * 16 + tl) * 512 + h * 128 + vs * 16 + vi] = o;
        }
    }
    float* so = p.out + O_HGP + (((size_t)l * 8 + b) * 4 + h) * 128 * 128;
#pragma unroll
    for (int i = 0; i < 4; ++i) {
        so[(size_t)(kg * 4 + i) * 128 + vs * 16 + vl] = S[i];
        so[(size_t)(64 + kg * 4 + i) * 128 + vs * 16 + vl] = S[4 + i];
    }
    __syncthreads();
}

DEVINL void ssd_prompt_item(const Params& p, int l, int item, char* lds) {
    const int b = item >> 5, head = (item >> 1) & 15, ph = item & 1, g = head >> 3;
    const int tid = threadIdx.x;
    const int pl = tid >> 3, ng = tid & 7;
    float* Bs = (float*)lds;
    float* Cs = Bs + 2048;
    float* xs = Cs + 2048;
    float* xd = xs + 512;
    float* dcs = xd + 512;
    float* part = dcs + 64;
    const float* XBC = (const float*)(p.ws + OFF_XBC);
    const float* DT = (const float*)(p.ws + OFF_DT);
    const u16* U = (const u16*)(p.ws + OFF_U);
    float* YC = (float*)(p.ws + OFF_YC);
    const float Aneg = -__expf(p.in[I_ALOG][l * 16 + head]);
    const float Dsk = p.in[I_DSK][l * 16 + head];
    const int tl = tid >> 4, nc = (tid & 15) * 8, xc = (tid & 15) * 2;
    const size_t rowb = (size_t)b * SEQ;
    const float* pB = XBC + (rowb + tl) * 1536 + 1024 + g * 128 + nc;
    const float* pX = XBC + (rowb + tl) * 1536 + head * 64 + ph * 32 + xc;
    const float* pD = DT + (rowb + tl) * 16 + head;
    float S[16];
#pragma unroll
    for (int i = 0; i < 16; ++i) S[i] = 0.f;
    float4 rb0 = *(const float4*)pB, rb1 = *(const float4*)(pB + 4), rc0 = *(const float4*)(pB + 256), rc1 = *(const float4*)(pB + 260);
    float2 rx = *(const float2*)pX;
    float rd = *pD;
    for (int c = 0; c < SEQ / 16; ++c) {
        *(float4*)(Bs + tl * 128 + nc) = rb0; *(float4*)(Bs + tl * 128 + nc + 4) = rb1;
        *(float4*)(Cs + tl * 128 + nc) = rc0; *(float4*)(Cs + tl * 128 + nc + 4) = rc1;
        xs[tl * 32 + xc] = rx.x; xs[tl * 32 + xc + 1] = rx.y;
        xd[tl * 32 + xc] = rx.x * rd; xd[tl * 32 + xc + 1] = rx.y * rd;
        if ((tid & 15) == 0) dcs[tl] = __expf(rd * Aneg);
        if (c + 1 < SEQ / 16) {
            const size_t adv = (size_t)(c + 1) * 16;
            const float* qB = pB + adv * 1536;
            rb0 = *(const float4*)qB; rb1 = *(const float4*)(qB + 4); rc0 = *(const float4*)(qB + 256); rc1 = *(const float4*)(qB + 260);
            rx = *(const float2*)(pX + adv * 1536);
            rd = *(pD + adv * 16);
        }
        __syncthreads();
#pragma unroll 1
        for (int tg = 0; tg < 16; tg += 4) {
        float pa[4];
#pragma unroll
        for (int tt = 0; tt < 4; ++tt) {
            const int t = tg + tt;
            const float dec = dcs[t], xdt = xd[t * 32 + pl];
            float a = 0.f;
#pragma unroll
            for (int j = 0; j < 4; ++j) {
                const float4 Bv = *(const float4*)(Bs + t * 128 + j * 32 + ng * 4);
                const float4 Cv = *(const float4*)(Cs + t * 128 + j * 32 + ng * 4);
                S[j * 4 + 0] = dec * S[j * 4 + 0] + xdt * Bv.x; S[j * 4 + 1] = dec * S[j * 4 + 1] + xdt * Bv.y;
                S[j * 4 + 2] = dec * S[j * 4 + 2] + xdt * Bv.z; S[j * 4 + 3] = dec * S[j * 4 + 3] + xdt * Bv.w;
                a += Cv.x * S[j * 4 + 0] + Cv.y * S[j * 4 + 1] + Cv.z * S[j * 4 + 2] + Cv.w * S[j * 4 + 3];
            }
            pa[tt] = a;
        }
#pragma unroll
        for (int tt = 0; tt < 4; ++tt) part[(tg + tt) * 256 + tid] = pa[tt];
        }
        __syncthreads();
#pragma unroll
        for (int i = 0; i < 2; ++i) {
            const int idx = tid + 256 * i, t2 = idx >> 5, p2 = idx & 31;
            const float4 a = *(const float4*)(part + t2 * 256 + p2 * 8), bq = *(const float4*)(part + t2 * 256 + p2 * 8 + 4);
            const float y = (a.x + a.y + a.z + a.w) + (bq.x + bq.y + bq.z + bq.w) + Dsk * xs[t2 * 32 + p2];
            const size_t row = rowb + c * 16 + t2;
            const float z = bf2f(U[row * DINP + 4096 + head * 64 + ph * 32 + p2]);
            YC[row * 1024 + head * 64 + ph * 32 + p2] = y * siluf_(z);
        }
        __syncthreads();
    }
    float* so = p.out + O_SSP + ((((size_t)l * 8 + b) * 16 + head) * 64 + ph * 32 + pl) * 128;
#pragma unroll
    for (int j = 0; j < 4; ++j) *(float4*)(so + j * 32 + ng * 4) = make_float4(S[j * 4], S[j * 4 + 1], S[j * 4 + 2], S[j * 4 + 3]);
}

DEVINL void hgrn_sample_item(const Params& p, int l, int item, char* lds) {
    const int s = item >> 2, h = item & 3;
    const int tid = threadIdx.x;
    float* qs = (float*)lds; float* fs = qs + 128; float* vs = fs + 128; float* red = vs + 128;
    const u16* Ur = (const u16*)(p.ws + OFF_U) + (size_t)(NP + s) * DINP;
    if (tid < 128) {
        qs[tid] = bf2f(Ur[2048 + h * 128 + tid]);
        const float lb = hgrn_lb(p, l, h * 128 + tid);
        fs[tid] = lb + (1.f - lb) * sigmoidf_(bf2f(Ur[2560 + h * 128 + tid]));
        vs[tid] = bf2f(Ur[3072 + h * 128 + tid]);
    }
    __syncthreads();
    const int v4 = (tid & 31) * 4, kr = tid >> 5;
    const size_t sb = (((size_t)l * NS + s) * 4 + h) * 128 * 128;
    const float* Sin = p.in[I_SHG] + sb;
    float* Sout = p.out + O_HGS + sb;
    const float4 vv = *(const float4*)(vs + v4);
    float4 acc = make_float4(0.f, 0.f, 0.f, 0.f);
#pragma unroll 1
    for (int hb = 0; hb < 2; ++hb) {
        float4 so[8];
#pragma unroll
        for (int i = 0; i < 8; ++i) so[i] = ldnt4(Sin + (size_t)(kr + 8 * (hb * 8 + i)) * 128 + v4);
#pragma unroll
        for (int i = 0; i < 8; ++i) {
            const int k = kr + 8 * (hb * 8 + i);
            const float f = fs[k], kk = 1.f - f, q = qs[k];
            float4 sn;
            sn.x = f * so[i].x + kk * vv.x; sn.y = f * so[i].y + kk * vv.y; sn.z = f * so[i].z + kk * vv.z; sn.w = f * so[i].w + kk * vv.w;
            stnt4(Sout + (size_t)k * 128 + v4, sn);
            acc.x += q * sn.x; acc.y += q * sn.y; acc.z += q * sn.z; acc.w += q * sn.w;
        }
    }
    *(float4*)(red + kr * 128 + v4) = acc;
    __syncthreads();
    if (tid < 128) {
        float o = 0.f;
#pragma unroll
        for (int i = 0; i < 8; ++i) o += red[i * 128 + tid];
        ((u16*)(p.ws + OFF_OB))[(size_t)(NP + s) * 512 + h * 128 + tid] = (u16)f2bf(o);
    }
    __syncthreads();
}

DEVINL void ssd_sample_item(const Params& p, int l, int item) {
    const int s = item >> 4, head = item & 15, g = head >> 3;
    const int tid = threadIdx.x;
    const size_t row = NP + s;
    const float* xr = (const float*)(p.ws + OFF_XBC) + row * 1536;
    const float dt = ((const float*)(p.ws + OFF_DT))[row * 16 + head];
    const float dec = __expf(-__expf(p.in[I_ALOG][l * 16 + head]) * dt);
    const float Dsk = p.in[I_DSK][l * 16 + head];
    const int n4 = (tid & 31) * 4, pr = tid >> 5;
    const float4 Bv = *(const float4*)(xr + 1024 + g * 128 + n4), Cv = *(const float4*)(xr + 1280 + g * 128 + n4);
    const size_t sb = (((size_t)l * NS + s) * 16 + head) * 64 * 128;
    const float* Sin = p.in[I_SSS] + sb;
    float* Sout = p.out + O_SSS + sb;
    const u16* Ur = (const u16*)(p.ws + OFF_U) + row * DINP;
    u16* YC = (u16*)(p.ws + OFF_YC);
    float4 so[8];
#pragma unroll
    for (int i = 0; i < 8; ++i) so[i] = ldnt4(Sin + (size_t)(pr + 8 * i) * 128 + n4);
#pragma unroll
    for (int i = 0; i < 8; ++i) {
        const int pp = pr + 8 * i;
        const float x = xr[head * 64 + pp], xdt = x * dt;
        float4 sn;
        sn.x = dec * so[i].x + xdt * Bv.x; sn.y = dec * so[i].y + xdt * Bv.y; sn.z = dec * so[i].z + xdt * Bv.z; sn.w = dec * so[i].w + xdt * Bv.w;
        stnt4(Sout + (size_t)pp * 128 + n4, sn);
        float a = Cv.x * sn.x + Cv.y * sn.y + Cv.z * sn.z + Cv.w * sn.w;
#pragma unroll
        for (int o = 16; o; o >>= 1) a += __shfl_xor(a, o);
        if ((tid & 31) == 0) {
            const float y = a + Dsk * x;
            const float z = bf2f(Ur[4096 + head * 64 + pp]);
            YC[row * 1024 + head * 64 + pp] = (u16)f2bf(y * siluf_(z));
        }
    }
}


DEVINL bf16x8 ldfrag(const u16* base, int ld, int row, int k) { return *(const bf16x8*)(base + row * ld + k); }
DEVINL void st4bf(u16* dst, float a, float b, float c, float d) { *(uint2*)dst = make_uint2(pack2(a, b), pack2(c, d)); }

DEVINL void ssd_prompt_mfma(const Params& p, int l, int item, char* lds) {
    const int b = item >> 5, head = (item >> 1) & 15, ph = item & 1, g = head >> 3;
    const int tid = threadIdx.x, lane = tid & 63, w = tid >> 6, fr = lane & 15, fq = lane >> 4;
    u16* Cs = (u16*)lds;
    u16* Bs = Cs + 32 * 136;
    u16* Sb = Bs + 32 * 136;
    u16* BT = Sb + 32 * 136;
    u16* XT = BT + 128 * 40;
    u16* XW = XT + 32 * 40;
    u16* Ms = XW + 32 * 40;
    float* csS = (float*)(Ms + 32 * 40);
    float* dtS = csS + 32;
    const u16* XB = (const u16*)(p.ws + OFF_XBCB);
    const float* DT = (const float*)(p.ws + OFF_DT);
    const u16* U = (const u16*)(p.ws + OFF_U);
    u16* YC = (u16*)(p.ws + OFF_YC);
    const float Aneg = -__expf(p.in[I_ALOG][l * 16 + head]);
    const float Dsk = p.in[I_DSK][l * 16 + head];
    const size_t rowb = (size_t)b * SEQ;
    const int srow = tid >> 3, sc = tid & 7;
    const int ti = w >> 1, pi = w & 1;
    for (int i = tid; i < 32 * 136 / 2; i += 256) ((uint32_t*)Sb)[i] = 0u;
    f32x4 Sacc[2][2];
#pragma unroll
    for (int a = 0; a < 2; ++a)
#pragma unroll
        for (int c = 0; c < 2; ++c) Sacc[a][c] = (f32x4){0.f, 0.f, 0.f, 0.f};
    const u16* pC = XB + (rowb + srow) * 1536 + 1280 + g * 128 + sc * 16;
    const u16* pB = XB + (rowb + srow) * 1536 + 1024 + g * 128 + sc * 16;
    const u16* pX = XB + (rowb + srow) * 1536 + head * 64 + ph * 32 + sc * 4;
    const float* pD = DT + (rowb + (lane & 31)) * 16 + head;
    const u16* pZ = U + (rowb + ti * 16 + fr) * DINP + 4096 + head * 64 + ph * 32 + pi * 16 + fq * 4;
    const u16* pXs = XB + (rowb + ti * 16 + fr) * 1536 + head * 64 + ph * 32 + pi * 16 + fq * 4;
#define SSD_LD(S, CC) do { const size_t adv = (size_t)(CC) * 32; \
        S##C0 = *(const uint4*)(pC + adv * 1536); S##C1 = *(const uint4*)(pC + adv * 1536 + 8); \
        S##B0 = *(const uint4*)(pB + adv * 1536); S##B1 = *(const uint4*)(pB + adv * 1536 + 8); \
        S##x = *(const uint2*)(pX + adv * 1536); S##z = *(const uint2*)(pZ + adv * DINP); S##xs = *(const uint2*)(pXs + adv * 1536); \
        S##dt = *(pD + adv * 16); } while (0)
    uint4 aC0, aC1, aB0, aB1, bC0, bC1, bB0, bB1; uint2 ax, az, axs, bx, bz, bxs; float adt, bdt;
    SSD_LD(a, 0); SSD_LD(b, 1);
    auto stage = [&](uint4 rC0, uint4 rC1, uint4 rB0, uint4 rB1, float rdt) __attribute__((always_inline)) {
        *(uint4*)(Cs + srow * 136 + sc * 16) = rC0; *(uint4*)(Cs + srow * 136 + sc * 16 + 8) = rC1;
        *(uint4*)(Bs + srow * 136 + sc * 16) = rB0; *(uint4*)(Bs + srow * 136 + sc * 16 + 8) = rB1;
        {
            const uint32_t bw[8] = {rB0.x, rB0.y, rB0.z, rB0.w, rB1.x, rB1.y, rB1.z, rB1.w};
#pragma unroll
            for (int j = 0; j < 8; ++j) {
                BT[(sc * 16 + 2 * j) * 40 + srow] = (u16)(bw[j] & 0xffffu);
                BT[(sc * 16 + 2 * j + 1) * 40 + srow] = (u16)(bw[j] >> 16);
            }
        }
        if (w == 0) {
            float a = rdt * Aneg;
#pragma unroll
            for (int o = 1; o < 32; o <<= 1) { const float v = __shfl_up(a, o); if ((lane & 31) >= o) a += v; }
            if (lane < 32) { csS[lane] = a; dtS[lane] = rdt; }
        }
    };
    auto rest = [&](int c, uint2 cx, uint2 cz, uint2 cxs) __attribute__((always_inline)) {
        lds_barrier();
        const float cs31 = csS[31];
        {
            const float wgt = dtS[srow] * __expf(cs31 - csS[srow]);
            const float x0 = lo16(cx.x), x1 = hi16(cx.x), x2 = lo16(cx.y), x3 = hi16(cx.y);
            XT[(sc * 4 + 0) * 40 + srow] = (u16)(cx.x & 0xffffu); XT[(sc * 4 + 1) * 40 + srow] = (u16)(cx.x >> 16);
            XT[(sc * 4 + 2) * 40 + srow] = (u16)(cx.y & 0xffffu); XT[(sc * 4 + 3) * 40 + srow] = (u16)(cx.y >> 16);
            XW[(sc * 4 + 0) * 40 + srow] = (u16)f2bf(x0 * wgt); XW[(sc * 4 + 1) * 40 + srow] = (u16)f2bf(x1 * wgt);
            XW[(sc * 4 + 2) * 40 + srow] = (u16)f2bf(x2 * wgt); XW[(sc * 4 + 3) * 40 + srow] = (u16)f2bf(x3 * wgt);
        }
        {
            const int t = ti * 16 + fr, s0 = pi * 16 + fq * 4;
            if (pi <= ti) {
                f32x4 acc = (f32x4){0.f, 0.f, 0.f, 0.f};
#pragma unroll
                for (int ks = 0; ks < 4; ++ks)
                    acc = __builtin_amdgcn_mfma_f32_16x16x32_bf16(ldfrag(Bs, 136, pi * 16 + fr, ks * 32 + fq * 8), ldfrag(Cs, 136, ti * 16 + fr, ks * 32 + fq * 8), acc, 0, 0, 0);
                const float cst = csS[t];
                float m[4];
#pragma unroll
                for (int r = 0; r < 4; ++r) { const int s = s0 + r; m[r] = (s <= t) ? acc[r] * __expf(cst - csS[s]) * dtS[s] : 0.f; }
                st4bf(Ms + t * 40 + s0, m[0], m[1], m[2], m[3]);
            } else {
                *(uint2*)(Ms + t * 40 + s0) = make_uint2(0u, 0u);
            }
        }
        lds_barrier();
        {
            f32x4 ad = __builtin_amdgcn_mfma_f32_16x16x32_bf16(ldfrag(XT, 40, pi * 16 + fr, fq * 8), ldfrag(Ms, 40, ti * 16 + fr, fq * 8), (f32x4){0.f, 0.f, 0.f, 0.f}, 0, 0, 0);
            f32x4 ao = (f32x4){0.f, 0.f, 0.f, 0.f};
#pragma unroll
            for (int ks = 0; ks < 4; ++ks)
                ao = __builtin_amdgcn_mfma_f32_16x16x32_bf16(ldfrag(Sb, 136, pi * 16 + fr, ks * 32 + fq * 8), ldfrag(Cs, 136, ti * 16 + fr, ks * 32 + fq * 8), ao, 0, 0, 0);
            const int t = ti * 16 + fr;
            const float e = __expf(csS[t]);
            const float xs0 = lo16(cxs.x), xs1 = hi16(cxs.x), xs2 = lo16(cxs.y), xs3 = hi16(cxs.y);
            const float z0 = lo16(cz.x), z1 = hi16(cz.x), z2 = lo16(cz.y), z3 = hi16(cz.y);
            float4 y;
            y.x = (ad[0] + e * ao[0] + Dsk * xs0) * siluf_(z0);
            y.y = (ad[1] + e * ao[1] + Dsk * xs1) * siluf_(z1);
            y.z = (ad[2] + e * ao[2] + Dsk * xs2) * siluf_(z2);
            y.w = (ad[3] + e * ao[3] + Dsk * xs3) * siluf_(z3);
            *(uint2*)(YC + (rowb + (size_t)c * 32 + t) * 1024 + head * 64 + ph * 32 + pi * 16 + fq * 4) = make_uint2(pack2(y.x, y.y), pack2(y.z, y.w));
        }
        {
            const float e31 = __expf(cs31);
#pragma unroll
            for (int a = 0; a < 2; ++a) {
                const bf16x8 bt = ldfrag(BT, 40, (2 * w + a) * 16 + fr, fq * 8);
#pragma unroll
                for (int pt = 0; pt < 2; ++pt) {
                    f32x4 s = Sacc[a][pt];
                    s[0] *= e31; s[1] *= e31; s[2] *= e31; s[3] *= e31;
                    Sacc[a][pt] = __builtin_amdgcn_mfma_f32_16x16x32_bf16(bt, ldfrag(XW, 40, pt * 16 + fr, fq * 8), s, 0, 0, 0);
                }
            }
        }
        lds_barrier();
#pragma unroll
        for (int a = 0; a < 2; ++a)
#pragma unroll
            for (int pt = 0; pt < 2; ++pt)
                st4bf(Sb + (pt * 16 + fr) * 136 + (2 * w + a) * 16 + fq * 4, Sacc[a][pt][0], Sacc[a][pt][1], Sacc[a][pt][2], Sacc[a][pt][3]);
    };
#pragma unroll 1
    for (int c = 0; c < SEQ / 32; c += 2) {
        { stage(aC0, aC1, aB0, aB1, adt); const uint2 cx = ax, cz = az, cxs = axs; if (c + 2 < SEQ / 32) SSD_LD(a, c + 2); rest(c, cx, cz, cxs); }
        { stage(bC0, bC1, bB0, bB1, bdt); const uint2 cx = bx, cz = bz, cxs = bxs; if (c + 3 < SEQ / 32) SSD_LD(b, c + 3); rest(c + 1, cx, cz, cxs); }
    }
#undef SSD_LD
    float* so = p.out + O_SSP + ((((size_t)l * 8 + b) * 16 + head) * 64 + ph * 32) * 128;
#pragma unroll
    for (int a = 0; a < 2; ++a)
#pragma unroll
        for (int pt = 0; pt < 2; ++pt)
            *(float4*)(so + (size_t)(pt * 16 + fr) * 128 + (2 * w + a) * 16 + fq * 4) = make_float4(Sacc[a][pt][0], Sacc[a][pt][1], Sacc[a][pt][2], Sacc[a][pt][3]);
    __syncthreads();
}

DEVINL void hgrn_prompt_mfma(const Params& p, int l, int item, char* lds) {
    const int b = item >> 4, h = (item >> 2) & 3, vq = item & 3;
    const int tid = threadIdx.x, lane = tid & 63, w = tid >> 6, fr = lane & 15, fq = lane >> 4;
    u16* Qg = (u16*)lds;
    u16* Qm = Qg + 32 * 136;
    u16* Km = Qm + 32 * 136;
    u16* ST = Km + 32 * 136;
    u16* KdT = ST + 32 * 136;
    u16* VT = KdT + 128 * 40;
    u16* As = VT + 32 * 40;
    float* dS = (float*)(As + 32 * 40);
    const u16* U = (const u16*)(p.ws + OFF_U);
    u16* OB = (u16*)(p.ws + OFF_OB);
    const size_t rowb = (size_t)b * SEQ;
    const size_t u0 = (size_t)(b * 4 + h) * 64;
    const u16* gQG = (const u16*)(p.ws + OFF_HQG) + u0 * 4096;
    const u16* gQM = (const u16*)(p.ws + OFF_HQM) + u0 * 4096;
    const u16* gKM = (const u16*)(p.ws + OFF_HKM) + u0 * 4096;
    const u16* gKD = (const u16*)(p.ws + OFF_HKD) + u0 * 4096;
    const float* gDS = (const float*)(p.ws + OFF_HDS) + u0 * 128;
    const int vrow = tid >> 3, v4 = (tid & 7) * 4;
    const int ti = w >> 1, ji = w & 1;
    const int r0 = tid >> 4, c0 = (tid & 15) * 8;
    const int k0 = tid >> 2, p0 = (tid & 3) * 8;
    for (int i = tid; i < 32 * 136 / 2; i += 256) ((uint32_t*)ST)[i] = 0u;
    f32x4 Sacc[2][2];
#pragma unroll
    for (int a = 0; a < 2; ++a)
#pragma unroll
        for (int c = 0; c < 2; ++c) Sacc[a][c] = (f32x4){0.f, 0.f, 0.f, 0.f};
    const u16* pV = U + (rowb + vrow) * DINP + 3072 + h * 128 + vq * 32 + v4;
    const int gi0 = r0 * 128 + c0, gi1 = (r0 + 16) * 128 + c0, gk0 = k0 * 32 + p0, gk1 = (k0 + 64) * 32 + p0;
    const int li0 = r0 * 136 + c0, li1 = (r0 + 16) * 136 + c0, lk0 = k0 * 40 + p0, lk1 = (k0 + 64) * 40 + p0;
#define HG_LD(S, CC) do { const size_t au = (size_t)(CC) * 4096; \
        S##g0 = *(const uint4*)(gQG + au + gi0); S##g1 = *(const uint4*)(gQG + au + gi1); S##m0 = *(const uint4*)(gQM + au + gi0); S##m1 = *(const uint4*)(gQM + au + gi1); \
        S##k0 = *(const uint4*)(gKM + au + gi0); S##k1 = *(const uint4*)(gKM + au + gi1); S##d0 = *(const uint4*)(gKD + au + gk0); S##d1 = *(const uint4*)(gKD + au + gk1); \
        S##ds = *(const float4*)(gDS + (size_t)(CC) * 128 + (tid & 31) * 4); S##v = *(const uint2*)(pV + (size_t)(CC) * 32 * DINP); } while (0)
    uint4 ag0, ag1, am0, am1, ak0, ak1, ad0, ad1, bg0, bg1, bm0, bm1, bk0, bk1, bd0, bd1; float4 ads, bds; uint2 av, bv;
    HG_LD(a, 0); HG_LD(b, 1);
    auto stage = [&](uint4 g0, uint4 g1, uint4 m0, uint4 m1, uint4 kk0, uint4 kk1, uint4 d0, uint4 d1, float4 ds, uint2 rv) __attribute__((always_inline)) {
        *(uint4*)(Qg + li0) = g0; *(uint4*)(Qg + li1) = g1; *(uint4*)(Qm + li0) = m0; *(uint4*)(Qm + li1) = m1;
        *(uint4*)(Km + li0) = kk0; *(uint4*)(Km + li1) = kk1; *(uint4*)(KdT + lk0) = d0; *(uint4*)(KdT + lk1) = d1;
        if (tid < 32) *(float4*)(dS + tid * 4) = ds;
        VT[(v4 + 0) * 40 + vrow] = (u16)(rv.x & 0xffffu); VT[(v4 + 1) * 40 + vrow] = (u16)(rv.x >> 16);
        VT[(v4 + 2) * 40 + vrow] = (u16)(rv.y & 0xffffu); VT[(v4 + 3) * 40 + vrow] = (u16)(rv.y >> 16);
    };
    auto rest = [&](int c) __attribute__((always_inline)) {
        lds_barrier();
        {
            const int t = ti * 16 + fr, j0 = ji * 16 + fq * 4;
            if (ji <= ti) {
                f32x4 acc = (f32x4){0.f, 0.f, 0.f, 0.f};
#pragma unroll
                for (int ks = 0; ks < 4; ++ks)
                    acc = __builtin_amdgcn_mfma_f32_16x16x32_bf16(ldfrag(Km, 136, ji * 16 + fr, ks * 32 + fq * 8), ldfrag(Qm, 136, ti * 16 + fr, ks * 32 + fq * 8), acc, 0, 0, 0);
                st4bf(As + t * 40 + j0, (j0 + 0 <= t) ? acc[0] : 0.f, (j0 + 1 <= t) ? acc[1] : 0.f, (j0 + 2 <= t) ? acc[2] : 0.f, (j0 + 3 <= t) ? acc[3] : 0.f);
            } else {
                *(uint2*)(As + t * 40 + j0) = make_uint2(0u, 0u);
            }
        }
        lds_barrier();
        {
            const int vi = ji;
            f32x4 acc = __builtin_amdgcn_mfma_f32_16x16x32_bf16(ldfrag(VT, 40, vi * 16 + fr, fq * 8), ldfrag(As, 40, ti * 16 + fr, fq * 8), (f32x4){0.f, 0.f, 0.f, 0.f}, 0, 0, 0);
#pragma unroll
            for (int ks = 0; ks < 4; ++ks)
                acc = __builtin_amdgcn_mfma_f32_16x16x32_bf16(ldfrag(ST, 136, vi * 16 + fr, ks * 32 + fq * 8), ldfrag(Qg, 136, ti * 16 + fr, ks * 32 + fq * 8), acc, 0, 0, 0);
            *(uint2*)(OB + (rowb + (size_t)c * 32 + ti * 16 + fr) * 512 + h * 128 + vq * 32 + vi * 16 + fq * 4) = make_uint2(pack2(acc[0], acc[1]), pack2(acc[2], acc[3]));
        }
#pragma unroll
        for (int a = 0; a < 2; ++a) {
            const int kt = 2 * w + a;
            const bf16x8 kf = ldfrag(KdT, 40, kt * 16 + fr, fq * 8);
            const float4 dd = *(const float4*)(dS + kt * 16 + fq * 4);
#pragma unroll
            for (int vt = 0; vt < 2; ++vt) {
                f32x4 s = Sacc[a][vt];
                s[0] *= dd.x; s[1] *= dd.y; s[2] *= dd.z; s[3] *= dd.w;
                Sacc[a][vt] = __builtin_amdgcn_mfma_f32_16x16x32_bf16(kf, ldfrag(VT, 40, vt * 16 + fr, fq * 8), s, 0, 0, 0);
            }
        }
        lds_barrier();
#pragma unroll
        for (int a = 0; a < 2; ++a)
#pragma unroll
            for (int vt = 0; vt < 2; ++vt)
                st4bf(ST + (vt * 16 + fr) * 136 + (2 * w + a) * 16 + fq * 4, Sacc[a][vt][0], Sacc[a][vt][1], Sacc[a][vt][2], Sacc[a][vt][3]);
    };
#pragma unroll 1
    for (int c = 0; c < SEQ / 32; c += 2) {
        stage(ag0, ag1, am0, am1, ak0, ak1, ad0, ad1, ads, av); if (c + 2 < SEQ / 32) HG_LD(a, c + 2); rest(c);
        stage(bg0, bg1, bm0, bm1, bk0, bk1, bd0, bd1, bds, bv); if (c + 3 < SEQ / 32) HG_LD(b, c + 3); rest(c + 1);
    }
#undef HG_LD
    float* so = p.out + O_HGP + (((size_t)l * 8 + b) * 4 + h) * 128 * 128;
#pragma unroll
    for (int a = 0; a < 2; ++a)
#pragma unroll
        for (int vt = 0; vt < 2; ++vt)
#pragma unroll
            for (int r = 0; r < 4; ++r)
                so[(size_t)((2 * w + a) * 16 + fq * 4 + r) * 128 + vq * 32 + vt * 16 + fr] = Sacc[a][vt][r];
    __syncthreads();
}

DEVINL int scan_next_item(unsigned* ctr, int* slot) {
    __syncthreads();
    if (threadIdx.x == 0) *slot = (int)gridDim.x + (int)__hip_atomic_fetch_add(ctr, 1u, __ATOMIC_RELAXED, __HIP_MEMORY_SCOPE_AGENT);
    __syncthreads();
    return *slot;
}
DEVINL void phase_scan(const Params& p, int l, char* lds) {
    unsigned* ctr = (unsigned*)(p.ws + OFF_BAR) + 3520 + l * 64;
    __shared__ int nxt_item;
    int it = blockIdx.x;
#pragma unroll 1
    while (it < 256) { ssd_prompt_mfma(p, l, it, lds); it = scan_next_item(ctr, &nxt_item); }
#pragma unroll 1
    while (it < 384) { hgrn_prompt_mfma(p, l, it - 256, lds); it = scan_next_item(ctr, &nxt_item); }
#pragma unroll 1
    while (it < 896) { hgrn_sample_item(p, l, it - 384, lds); it = scan_next_item(ctr, &nxt_item); }
#pragma unroll 1
    while (it < 2944) { ssd_sample_item(p, l, it - 896); it = scan_next_item(ctr, &nxt_item); }
}

DEVINL void phase_mixnorm(const Params& p, int l) {
    const int wave = threadIdx.x >> 6, lane = threadIdx.x & 63;
    const u16* OB = (const u16*)(p.ws + OFF_OB);
    const u16* YC = (const u16*)(p.ws + OFF_YC);
    const u16* U = (const u16*)(p.ws + OFF_U);
    u16* Ycat = (u16*)(p.ws + OFF_YCAT);
    const float* gn = p.in[I_HGN] + (size_t)l * 512;
    const float* sn = p.in[I_SNORM] + (size_t)l * 1024;
    for (int it = blockIdx.x; it < NR / 4; it += gridDim.x) {
        const size_t r = (size_t)it * 4 + wave;
        {
            const uint4 ov = *(const uint4*)(OB + r * 512 + lane * 8);
            float x[8]; UNPACK8(ov, x);
            float ss = 0.f;
#pragma unroll
            for (int i = 0; i < 8; ++i) ss += x[i] * x[i];
            ss += __shfl_xor(ss, 1); ss += __shfl_xor(ss, 2); ss += __shfl_xor(ss, 4); ss += __shfl_xor(ss, 8);
            const float rstd = rsqrtf(ss * (1.0f / 128.0f) + EPS);
            const uint4 zz = *(const uint4*)(U + r * DINP + 3584 + lane * 8);
            float z[8]; UNPACK8(zz, z);
            const float4 g0 = *(const float4*)(gn + lane * 8), g1 = *(const float4*)(gn + lane * 8 + 4);
            const float gg[8] = {g0.x, g0.y, g0.z, g0.w, g1.x, g1.y, g1.z, g1.w};
            float y[8];
#pragma unroll
            for (int i = 0; i < 8; ++i) y[i] = x[i] * rstd * gg[i] * siluf_(z[i]);
            *(uint4*)(Ycat + r * 2048 + 512 + lane * 8) = make_uint4(pack2(y[0], y[1]), pack2(y[2], y[3]), pack2(y[4], y[5]), pack2(y[6], y[7]));
        }
        {
            float x[16];
#pragma unroll
            for (int h = 0; h < 2; ++h) {
                const uint4 yv = *(const uint4*)(YC + r * 1024 + h * 512 + lane * 8);
                x[h * 8 + 0] = lo16(yv.x); x[h * 8 + 1] = hi16(yv.x); x[h * 8 + 2] = lo16(yv.y); x[h * 8 + 3] = hi16(yv.y); x[h * 8 + 4] = lo16(yv.z); x[h * 8 + 5] = hi16(yv.z); x[h * 8 + 6] = lo16(yv.w); x[h * 8 + 7] = hi16(yv.w);
            }
            float ss = 0.f;
#pragma unroll
            for (int i = 0; i < 16; ++i) ss += x[i] * x[i];
            ss = wave_sum(ss);
            const float rstd = rsqrtf(ss * (1.0f / 1024.0f) + EPS);
#pragma unroll
            for (int h = 0; h < 2; ++h) {
                const float4 g0 = *(const float4*)(sn + h * 512 + lane * 8), g1 = *(const float4*)(sn + h * 512 + lane * 8 + 4);
                uint4 o;
                o.x = pack2(x[h * 8 + 0] * rstd * g0.x, x[h * 8 + 1] * rstd * g0.y);
                o.y = pack2(x[h * 8 + 2] * rstd * g0.z, x[h * 8 + 3] * rstd * g0.w);
                o.z = pack2(x[h * 8 + 4] * rstd * g1.x, x[h * 8 + 5] * rstd * g1.y);
                o.w = pack2(x[h * 8 + 6] * rstd * g1.z, x[h * 8 + 7] * rstd * g1.w);
                *(uint4*)(Ycat + r * 2048 + 1024 + h * 512 + lane * 8) = o;
            }
        }
    }
}

DEVINL void phase_rowpass(const Params& p, int l, int which) {
    const int wave = threadIdx.x >> 6, lane = threadIdx.x & 63;
    float* X = (float*)(p.ws + OFF_X);
    const u16* T = (const u16*)(p.ws + OFF_T);
    u16* Hb = (u16*)(p.ws + OFF_HB);
    u16* Mb = (u16*)(p.ws + OFF_MB);
    const bool last = (which == 1 && l == 1);
    const float* gpost = p.in[which == 0 ? I_GQM : I_GQX] + (size_t)l * 1024;
    const float* gnext = which == 0 ? p.in[I_GPX] + (size_t)l * 1024 : (last ? nullptr : p.in[I_GPM] + (size_t)(l + 1) * 1024);
    const int nrows = (which == 1 && !last) ? NR + 2048 : NR;
    for (int it = blockIdx.x; it < nrows / 4; it += gridDim.x) {
        const int r = it * 4 + wave;
        if (r < NR) {
            float* xd = X + (size_t)r * 1024;
            if (last) xd = r < NP ? p.out + O_YP + (size_t)r * 1024 : p.out + O_YS + (size_t)(r - NP) * 1024;
            const float* xb = X + (size_t)r * 1024;
            if (which == 0 && l == 0) xb = r < NP ? p.in[I_XP] + (size_t)r * 1024 : p.in[I_XS] + (size_t)(r - NP) * 1024;
            rowpass_row(xb, T + (size_t)r * 1024, gpost, xd, gnext, Hb + (size_t)r * 1024, lane, last);
        } else {
            const int m = r - NR;
            rowpass_row(p.in[I_MEM] + (size_t)m * 1024, nullptr, nullptr, nullptr, p.in[I_GMEM] + (size_t)(l + 1) * 1024, Mb + (size_t)m * 1024, lane);
        }
    }
}

DEVINL void attn_prompt_item(const Params& p, int item, char* lds) {
    const int b = item >> 6, h = (item >> 4) & 3, qt = item & 15;
    const int tid = threadIdx.x, lane = tid & 63, wave = tid >> 6;
    const u16* Qt = (const u16*)(p.ws + OFF_Q) + ((size_t)b * SEQ + qt * 128) * 1024 + h * 256;
    const u16* Kb = (const u16*)(p.ws + OFF_MK) + (size_t)b * 256 * 1024 + h * 256;
    const u16* Vt = (const u16*)(p.ws + OFF_MVT) + (size_t)(b * 4 + h) * 256 * 256;
    float* Ss = (float*)(p.ws + OFF_SCR + (size_t)blockIdx.x * SCR_PER_BLOCK);
    u16* Ps = (u16*)((char*)Ss + 128 * 256 * 4);
    u16* Ob = (u16*)(p.ws + OFF_O) + ((size_t)b * SEQ + qt * 128) * 1024 + h * 256;
#pragma unroll 1
    for (int nt = 0; nt < 2; ++nt)
        gemm_tile1(Qt, 1024, Kb + (size_t)nt * 128 * 1024, 1024, 256, lds,
                  [&](int r, int c, f32x4 v) { *(float4*)(Ss + r * 256 + nt * 128 + c) = make_float4(v[0] * 0.0625f, v[1] * 0.0625f, v[2] * 0.0625f, v[3] * 0.0625f); });
    __syncthreads();
    for (int i = 0; i < 32; ++i) {
        const int r = wave * 32 + i;
        const float4 x = *(const float4*)(Ss + r * 256 + lane * 4);
        const float m = wave_max(fmaxf(fmaxf(x.x, x.y), fmaxf(x.z, x.w)));
        const float e0 = __expf(x.x - m), e1 = __expf(x.y - m), e2 = __expf(x.z - m), e3 = __expf(x.w - m);
        const float inv = 1.0f / wave_sum(e0 + e1 + e2 + e3);
        *(uint2*)(Ps + r * 256 + lane * 4) = make_uint2(pack2(e0 * inv, e1 * inv), pack2(e2 * inv, e3 * inv));
    }
    __syncthreads();
#pragma unroll 1
    for (int nt = 0; nt < 2; ++nt)
        gemm_tile1(Ps, 256, Vt + (size_t)nt * 128 * 256, 256, 256, lds,
                  [&](int r, int c, f32x4 v) { *(uint2*)(Ob + (size_t)r * 1024 + nt * 128 + c) = make_uint2(pack2(v[0], v[1]), pack2(v[2], v[3])); });
    __syncthreads();
}


DEVINL void attn_prompt_item2(const Params& p, int item, char* lds) {
    const int b = item >> 7, h = (item >> 5) & 3, qt = item & 31;
    const int tid = threadIdx.x, lane = tid & 63, w = tid >> 6, fr = lane & 15, fq = lane >> 4;
    char* Kbuf = lds;
    char* Vbuf = lds + 33792;
    const size_t qrow = (size_t)b * SEQ + qt * 64 + w * 16 + fr;
    const u16* Qp = (const u16*)(p.ws + OFF_Q) + qrow * 1024 + h * 256 + fq * 8;
    const int krow = tid >> 5, kch = tid & 31;
    const u16* Kg = (const u16*)(p.ws + OFF_MK) + ((size_t)b * 256 + krow) * 1024 + h * 256 + kch * 8;
    const int klds = krow * 528 + kch * 16;
    const int vrow = tid >> 2, vch = tid & 3;
    const u16* Vg = (const u16*)(p.ws + OFF_MVT) + ((size_t)(b * 4 + h) * 256 + vrow) * 256 + vch * 8;
    const int vlds = vrow * 80 + vch * 16;
    bf16x8 qf[8];
#pragma unroll
    for (int ks = 0; ks < 8; ++ks) qf[ks] = *(const bf16x8*)(Qp + ks * 32);
    uint4 r0, r1, r2, r3, r4, r5, r6, r7;
#define KLOAD(KB) do { const u16* g_ = Kg + (size_t)(KB) * 64 * 1024; \
        r0 = *(const uint4*)(g_); r1 = *(const uint4*)(g_ + 8 * 1024); r2 = *(const uint4*)(g_ + 16 * 1024); r3 = *(const uint4*)(g_ + 24 * 1024); \
        r4 = *(const uint4*)(g_ + 32 * 1024); r5 = *(const uint4*)(g_ + 40 * 1024); r6 = *(const uint4*)(g_ + 48 * 1024); r7 = *(const uint4*)(g_ + 56 * 1024); } while (0)
#define KSTORE() do { char* d_ = Kbuf + klds; \
        *(uint4*)(d_) = r0; *(uint4*)(d_ + 8 * 528) = r1; *(uint4*)(d_ + 16 * 528) = r2; *(uint4*)(d_ + 24 * 528) = r3; \
        *(uint4*)(d_ + 32 * 528) = r4; *(uint4*)(d_ + 40 * 528) = r5; *(uint4*)(d_ + 48 * 528) = r6; *(uint4*)(d_ + 56 * 528) = r7; } while (0)
#define VLOAD(VB) do { const u16* g_ = Vg + (VB) * 32; \
        r0 = *(const uint4*)(g_); r1 = *(const uint4*)(g_ + 64 * 256); r2 = *(const uint4*)(g_ + 128 * 256); r3 = *(const uint4*)(g_ + 192 * 256); } while (0)
#define VSTORE() do { char* d_ = Vbuf + vlds; \
        *(uint4*)(d_) = r0; *(uint4*)(d_ + 64 * 80) = r1; *(uint4*)(d_ + 128 * 80) = r2; *(uint4*)(d_ + 192 * 80) = r3; } while (0)
    f32x4 sacc[16];
    KLOAD(0);
#pragma unroll
    for (int kb = 0; kb < 4; ++kb) {
        KSTORE();
        if (kb < 3) KLOAD(kb + 1); else VLOAD(0);
        lds_barrier();
#pragma unroll
        for (int kl = 0; kl < 4; ++kl) {
            f32x4 acc = (f32x4){0.f, 0.f, 0.f, 0.f};
#pragma unroll
            for (int ks = 0; ks < 8; ++ks)
                acc = __builtin_amdgcn_mfma_f32_16x16x32_bf16(*(const bf16x8*)(Kbuf + (kl * 16 + fr) * 528 + (ks * 32 + fq * 8) * 2), qf[ks], acc, 0, 0, 0);
            sacc[kb * 4 + kl] = acc;
        }
        lds_barrier();
    }
    float m = -3.0e38f;
#pragma unroll
    for (int kt = 0; kt < 16; ++kt) m = fmaxf(m, fmaxf(fmaxf(sacc[kt][0], sacc[kt][1]), fmaxf(sacc[kt][2], sacc[kt][3])));
    m = fmaxf(m, __shfl_xor(m, 16)); m = fmaxf(m, __shfl_xor(m, 32));
    float sum = 0.f;
#pragma unroll
    for (int kt = 0; kt < 16; ++kt)
#pragma unroll
        for (int r = 0; r < 4; ++r) { const float e = __expf((sacc[kt][r] - m) * 0.0625f); sacc[kt][r] = e; sum += e; }
    sum += __shfl_xor(sum, 16); sum += __shfl_xor(sum, 32);
    const float inv = __builtin_amdgcn_rcpf(sum);
    bf16x8 pf[8];
#pragma unroll
    for (int ks = 0; ks < 8; ++ks) {
        uint4 u;
        u.x = pack2(sacc[2 * ks][0] * inv, sacc[2 * ks][1] * inv); u.y = pack2(sacc[2 * ks][2] * inv, sacc[2 * ks][3] * inv);
        u.z = pack2(sacc[2 * ks + 1][0] * inv, sacc[2 * ks + 1][1] * inv); u.w = pack2(sacc[2 * ks + 1][2] * inv, sacc[2 * ks + 1][3] * inv);
        pf[ks] = __builtin_bit_cast(bf16x8, u);
    }
    f32x4 oacc[16];
#pragma unroll
    for (int dt = 0; dt < 16; ++dt) oacc[dt] = (f32x4){0.f, 0.f, 0.f, 0.f};
#pragma unroll
    for (int vb = 0; vb < 8; ++vb) {
        VSTORE();
        if (vb < 7) VLOAD(vb + 1);
        lds_barrier();
#pragma unroll
        for (int dt = 0; dt < 16; ++dt) {
            const uint2 lo = *(const uint2*)(Vbuf + (dt * 16 + fr) * 80 + fq * 8), hi = *(const uint2*)(Vbuf + (dt * 16 + fr) * 80 + fq * 8 + 32);
            const uint4 u = make_uint4(lo.x, lo.y, hi.x, hi.y);
            oacc[dt] = __builtin_amdgcn_mfma_f32_16x16x32_bf16(__builtin_bit_cast(bf16x8, u), pf[vb], oacc[dt], 0, 0, 0);
        }
        lds_barrier();
    }
#undef KLOAD
#undef KSTORE
#undef VLOAD
#undef VSTORE
    {
        char* img = lds + w * 8448 + fr * 528 + fq * 8;
#pragma unroll
        for (int dt = 0; dt < 16; ++dt)
            *(uint2*)(img + dt * 32) = make_uint2(pack2(oacc[dt][0], oacc[dt][1]), pack2(oacc[dt][2], oacc[dt][3]));
        const char* rd = lds + w * 8448 + (lane >> 5) * 528 + (lane & 31) * 16;
        u16* o0 = (u16*)(p.ws + OFF_O) + ((size_t)b * SEQ + qt * 64 + w * 16 + (lane >> 5)) * 1024 + h * 256 + (lane & 31) * 8;
#pragma unroll
        for (int it = 0; it < 8; ++it) *(uint4*)(o0 + (size_t)it * 2048) = *(const uint4*)(rd + it * 1056);
    }
    lds_barrier();
}

DEVINL void attn_sample_item(const Params& p, int l, int item, char* lds) {
    const int s = item >> 2, h = item & 3;
    const int tid = threadIdx.x, lane = tid & 63, wave = tid >> 6;
    float* sc = (float*)lds;
    float* red = sc + 256;
    float* wred = red + 1024;
    const int rsub = lane >> 4, part = lane & 15;
    const u16* qp = (const u16*)(p.ws + OFF_Q) + (size_t)(NP + s) * 1024 + h * 256 + part * 4;
    float qv[16];
#pragma unroll
    for (int j = 0; j < 4; ++j) {
        const uint2 qq = *(const uint2*)(qp + j * 64);
        qv[j * 4 + 0] = lo16(qq.x); qv[j * 4 + 1] = hi16(qq.x); qv[j * 4 + 2] = lo16(qq.y); qv[j * 4 + 3] = hi16(qq.y);
    }
    const size_t cb0 = (((size_t)l * NS + s) * 256) * 1024 + h * 256;
    const float* Kc = p.in[I_CK] + cb0 + part * 4;
    const float* Vc = p.in[I_CV] + cb0 + lane * 4;
#pragma unroll 1
    for (int i = 0; i < 4; ++i) {
        float4 kv[4][4];
#pragma unroll
        for (int pp = 0; pp < 4; ++pp)
#pragma unroll
            for (int j = 0; j < 4; ++j) kv[pp][j] = ldnt4(Kc + (size_t)(wave * 64 + (i * 4 + pp) * 4 + rsub) * 1024 + j * 64);
#pragma unroll
        for (int pp = 0; pp < 4; ++pp) {
            float d = 0.f;
#pragma unroll
            for (int j = 0; j < 4; ++j) d += kv[pp][j].x * qv[j * 4] + kv[pp][j].y * qv[j * 4 + 1] + kv[pp][j].z * qv[j * 4 + 2] + kv[pp][j].w * qv[j * 4 + 3];
            d += __shfl_xor(d, 1); d += __shfl_xor(d, 2); d += __shfl_xor(d, 4); d += __shfl_xor(d, 8);
            if (part == 0) sc[wave * 64 + (i * 4 + pp) * 4 + rsub] = d * 0.0625f;
        }
    }
    __syncthreads();
    const float x = sc[tid];
    const float wm = wave_max(x);
    if (lane == 0) wred[wave] = wm;
    __syncthreads();
    const float m = fmaxf(fmaxf(wred[0], wred[1]), fmaxf(wred[2], wred[3]));
    const float e = __expf(x - m);
    const float ws_ = wave_sum(e);
    if (lane == 0) wred[4 + wave] = ws_;
    __syncthreads();
    const float inv = 1.0f / (wred[4] + wred[5] + wred[6] + wred[7]);
    sc[tid] = e * inv;
    __syncthreads();
    float4 acc = make_float4(0.f, 0.f, 0.f, 0.f);
#pragma unroll 1
    for (int i = 0; i < 4; ++i) {
        float4 vv[16];
#pragma unroll
        for (int j = 0; j < 16; ++j) vv[j] = ldnt4(Vc + (size_t)(wave * 64 + i * 16 + j) * 1024);
#pragma unroll
        for (int j = 0; j < 16; ++j) {
            const float pw = sc[wave * 64 + i * 16 + j];
            acc.x += pw * vv[j].x; acc.y += pw * vv[j].y; acc.z += pw * vv[j].z; acc.w += pw * vv[j].w;
        }
    }
    *(float4*)(red + wave * 256 + lane * 4) = acc;
    __syncthreads();
    {
        const float o = red[tid] + red[256 + tid] + red[512 + tid] + red[768 + tid];
        ((u16*)(p.ws + OFF_O))[(size_t)(NP + s) * 1024 + h * 256 + tid] = (u16)f2bf(o);
    }
    __syncthreads();
}

DEVINL void phase_attn(const Params& p, int l, char* lds) {
    const int G = gridDim.x;
    const bool sample_first = (int)blockIdx.x >= (G >> 1);
#pragma unroll 1
    for (int pass = 0; pass < 2; ++pass) {
        const bool do_sample = (pass == 0) == sample_first;
        if (do_sample) {
#pragma unroll 1
            for (int it = blockIdx.x; it < 512; it += G) attn_sample_item(p, l, it, lds);
        } else {
#pragma unroll 1
            for (int it = blockIdx.x; it < 1024; it += G) attn_prompt_item2(p, it, lds);
        }
    }
}

#define XB_TMO      128
#define XB_XCNT(j)  (256  + 64 * (j))
#define XB_XSUB(j)  (1280 + 64 * (j))
#define XB_XGEN(j)  (2304 + 64 * (j))
#define XB_TOP      3328
#define XB_TOPGEN   3392
#define XCD_BAR_WORDS 3456
#define XB_SPIN_CAP (1u << 22)
#define LAS __attribute__((address_space(3)))
DEVINL unsigned xb_ld(unsigned* p) { return __hip_atomic_load(p, __ATOMIC_RELAXED, __HIP_MEMORY_SCOPE_AGENT); }
DEVINL unsigned xb_add(unsigned* p, unsigned v) { return __hip_atomic_fetch_add(p, v, __ATOMIC_RELAXED, __HIP_MEMORY_SCOPE_AGENT); }
DEVINL unsigned xb_xcc_id() { return (unsigned)__builtin_amdgcn_s_getreg((3 << 11) | 20) & 0xFu; }
#define XB_SPIN(cond, bar) do { unsigned _sp = 0; while (cond) { __builtin_amdgcn_s_sleep(1); \
    if ((++_sp & 255u) == 0u) { if (xb_ld(&(bar)[XB_TMO])) break; if (_sp > XB_SPIN_CAP) { atomicAdd(&(bar)[XB_TMO], 1u); break; } } } } while (0)
struct XcdBarrier { unsigned* bar; unsigned x; volatile LAS unsigned* st; };
DEVINL XcdBarrier xcd_barrier_post(unsigned* bar, volatile LAS unsigned* st) {
    XcdBarrier b; b.bar = bar; b.x = xb_xcc_id(); b.st = st;
    if (threadIdx.x == 0) (void)xb_add(&bar[XB_XCNT(b.x)], 1u);
    return b;
}
DEVINL void xcd_barrier_complete(unsigned* bar, unsigned x, unsigned& nloc, unsigned& nx) {
    const unsigned G = gridDim.x * gridDim.y * gridDim.z;
    unsigned sum, cnt, mine, sp = 0u;
    for (;;) {
        sum = 0u; cnt = 0u; mine = 0u;
#pragma unroll
        for (unsigned j = 0; j < 16; ++j) { const unsigned c = xb_ld(&bar[XB_XCNT(j)]); sum += c; cnt += (c > 0u) ? 1u : 0u; mine = (j == x) ? c : mine; }
        if (sum == G) break;
        __builtin_amdgcn_s_sleep(1);
        if ((++sp & 255u) == 0u) { if (xb_ld(&bar[XB_TMO])) break; if (sp > XB_SPIN_CAP) { atomicAdd(&bar[XB_TMO], 1u); break; } }
    }
    nloc = mine > 0u ? mine : 1u; nx = cnt > 0u ? cnt : 1u;
}
DEVINL void xcd_barrier(const XcdBarrier& b) {
    asm volatile("s_waitcnt vmcnt(0)" ::: "memory");
    __syncthreads();
    if (threadIdx.x == 0) {
        unsigned* bar = b.bar;
        __builtin_amdgcn_s_waitcnt(0);
        unsigned nloc = b.st[0], nx = b.st[1];
        if (nloc == 0u) { xcd_barrier_complete(bar, b.x, nloc, nx); b.st[0] = nloc; b.st[1] = nx; }
        const unsigned old = xb_add(&bar[XB_XSUB(b.x)], 1u);
        const unsigned gen = old / nloc;
        if (old + 1u == (gen + 1u) * nloc) {
            __builtin_amdgcn_fence(__ATOMIC_RELEASE, "agent");
            asm volatile("s_waitcnt vmcnt(0)" ::: "memory");
            const unsigned og = xb_add(&bar[XB_TOP], 1u);
            const unsigned tg = og / nx;
            if (og + 1u == (tg + 1u) * nx) xb_add(&bar[XB_TOPGEN], 1u);
            else XB_SPIN(xb_ld(&bar[XB_TOPGEN]) == tg, bar);
            __builtin_amdgcn_fence(__ATOMIC_ACQUIRE, "agent");
            xb_add(&bar[XB_XGEN(b.x)], 1u);
            asm volatile("s_waitcnt vmcnt(0)" ::: "memory");
        } else {
            XB_SPIN(xb_ld(&bar[XB_XGEN(b.x)]) == gen, bar);
            __builtin_amdgcn_fence(__ATOMIC_ACQUIRE, "agent");
            asm volatile("s_waitcnt vmcnt(0)" ::: "memory");
        }
    }
    __syncthreads();
}

#ifndef ONLYQ
#define ONLYQ -1
#endif
#ifndef REP_MASK
#define REP_MASK 0
#endif
__global__ void __launch_bounds__(256, 2) mega(Params p) {
    __shared__ __attribute__((aligned(16))) char lds[65536];
    __shared__ uint4 xb_words;
    XcdBarrier bar; bar.bar = (unsigned*)(p.ws + OFF_BAR); bar.x = 0; bar.st = (volatile LAS unsigned*)&xb_words;
    if (p.coop) {
        if (threadIdx.x == 0) xb_words = make_uint4(0u, 0u, 0u, 0u);
        __syncthreads();
        bar = xcd_barrier_post((unsigned*)(p.ws + OFF_BAR), (volatile LAS unsigned*)&xb_words);
    }
#define RUNPH(PH, Q, BODY) if ((ONLYQ < 0 || ONLYQ == (Q)) && p.ph_lo <= (PH) && (PH) < p.ph_hi) { BODY; if (REP_MASK & (1 << (Q))) { BODY; } \
        if (p.coop && (PH) + 1 < p.ph_hi) { if (p.pad == 0x5a5a5a5a) cg::this_grid().sync(); else xcd_barrier(bar); } }
#define LAYER(L) \
    RUNPH(1 + (L) * 10 + 0, 0, phase_gemm_in(p, L, lds)) \
    RUNPH(1 + (L) * 10 + 1, 1, phase_prep(p, L, lds)) \
    RUNPH(1 + (L) * 10 + 2, 2, phase_scan(p, L, lds)) \
    RUNPH(1 + (L) * 10 + 3, 3, phase_mixnorm(p, L)) \
    RUNPH(1 + (L) * 10 + 4, 4, phase_gemm_n1024((const u16*)(p.ws + OFF_YCAT), 2048, (const u16*)(p.ws + OFF_WOUT) + (size_t)(L) * 1024 * 2048, nullptr, (u16*)(p.ws + OFF_T), lds)) \
    RUNPH(1 + (L) * 10 + 5, 15, phase_rowpass(p, L, 0)) \
    RUNPH(1 + (L) * 10 + 6, 6, phase_gemm_n1024((const u16*)(p.ws + OFF_HB), 1024, (const u16*)(p.ws + OFF_WQ) + (size_t)(L) * 1024 * 1024, nullptr, (u16*)(p.ws + OFF_Q), lds)) \
    RUNPH(1 + (L) * 10 + 7, 7, phase_attn(p, L, lds)) \
    RUNPH(1 + (L) * 10 + 8, 8, phase_gemm_n1024((const u16*)(p.ws + OFF_O), 1024, (const u16*)(p.ws + OFF_WO) + (size_t)(L) * 1024 * 1024, nullptr, (u16*)(p.ws + OFF_T), lds)) \
    RUNPH(1 + (L) * 10 + 9, 15, phase_rowpass(p, L, 1))
    RUNPH(0, 10, phase_prologue(p, lds))
    LAYER(0)
    LAYER(1)
}

extern "C" void kernel_launch(void* const* d_in, const int* in_sizes, int n_in, void* d_out, int out_size, void* d_ws, size_t ws_size,
                              hipStream_t stream) {
    static int grid = 0;
    if (!grid) {
        int dev = 0, cus = 0, per_cu = 0;
        hipGetDevice(&dev);
        hipDeviceGetAttribute(&cus, hipDeviceAttributeMultiprocessorCount, dev);
        hipOccupancyMaxActiveBlocksPerMultiprocessor(&per_cu, mega, 256, 0);
        if (per_cu > 2) per_cu = 2;
        if (per_cu < 1) per_cu = 1;
        grid = cus * per_cu;
        if (grid > MAX_GRID) grid = MAX_GRID;
        if (n_in != 29 || ws_size < WS_END) { fprintf(stderr, "kernel_launch: unexpected n_in %d or ws_size %zu (< %zu)\n", n_in, ws_size, (size_t)WS_END); }
    }
    Params p{};
    for (int i = 0; i < 29; ++i) p.in[i] = (const float*)d_in[i];
    p.out = (float*)d_out; p.ws = (char*)d_ws;
#if MULTI_LAUNCH
    for (int ph = 0; ph < NPHASE; ++ph) {
        p.ph_lo = ph; p.ph_hi = ph + 1; p.coop = 0;
        hipLaunchKernelGGL(mega, dim3(grid), dim3(256), 0, stream, p);
    }
#else
    p.ph_lo = 0; p.ph_hi = NPHASE; p.coop = 1;
    (void)hipMemsetAsync((char*)d_ws + OFF_BAR, 0, 16384, stream);
    void* args[] = {&p};
    hipError_t e = hipLaunchCooperativeKernel((void*)mega, dim3(grid), dim3(256), args, 0, stream);
    if (e != hipSuccess) fprintf(stderr, "cooperative launch failed: %s (grid %d)\n", hipGetErrorString(e), grid);
#endif
}
```

```cpp
#include <hip/hip_runtime.h>
#include <hip/hip_cooperative_groups.h>
#include <stdint.h>
#include <cstdio>
namespace cg = cooperative_groups;

#ifndef MULTI_LAUNCH
#define MULTI_LAUNCH 0
#endif

typedef unsigned short u16;
typedef short bf16x8 __attribute__((ext_vector_type(8)));
typedef float f32x4 __attribute__((ext_vector_type(4)));
typedef unsigned u32x4 __attribute__((ext_vector_type(4)));
#define DEVINL __device__ __forceinline__

constexpr int D = 1024, NP = 16384, NS = 128, NR = 16512, SEQ = 2048, DINP = 6784, DIN = 6672;
constexpr int NPHASE = 21;
constexpr float EPS = 1e-6f;

constexpr size_t SZ_WIN = (size_t)DINP * 1024 * 2, SZ_WOUT = (size_t)1024 * 2048 * 2, SZ_SQ = (size_t)1024 * 1024 * 2;
constexpr size_t OFF_WIN = 0;
constexpr size_t OFF_WOUT = OFF_WIN + 2 * SZ_WIN;
constexpr size_t OFF_WQ = OFF_WOUT + 2 * SZ_WOUT;
constexpr size_t OFF_WK = OFF_WQ + 2 * SZ_SQ;
constexpr size_t OFF_WV = OFF_WK + 2 * SZ_SQ;
constexpr size_t OFF_WO = OFF_WV + 2 * SZ_SQ;
constexpr size_t OFF_X = OFF_WO + 2 * SZ_SQ;
constexpr size_t OFF_HB = OFF_X + (size_t)NR * 1024 * 4;
constexpr size_t OFF_MB = OFF_HB + (size_t)NR * 1024 * 2;
constexpr size_t OFF_U = OFF_MB + (size_t)2048 * 1024 * 2;
constexpr size_t OFF_XBC = OFF_U + (size_t)NR * DINP * 2;
constexpr size_t OFF_DT = OFF_XBC + (size_t)NR * 1536 * 4;
constexpr size_t OFF_OB = OFF_DT + (size_t)NR * 16 * 4;
constexpr size_t OFF_YC = OFF_OB + (size_t)NR * 512 * 4;
constexpr size_t OFF_YCAT = OFF_YC + (size_t)NR * 1024 * 4;
constexpr size_t OFF_T = OFF_YCAT + (size_t)NR * 2048 * 2;
constexpr size_t OFF_Q = OFF_T + (size_t)NR * 1024 * 4;
constexpr size_t OFF_O = OFF_Q + (size_t)NR * 1024 * 2;
constexpr size_t OFF_MK = OFF_O + (size_t)NR * 1024 * 2;
constexpr size_t OFF_MVT = OFF_MK + (size_t)2048 * 1024 * 2;
constexpr size_t OFF_SCR = OFF_MVT + (size_t)2048 * 1024 * 2;
constexpr size_t SCR_PER_BLOCK = 128 * 256 * 4 + 128 * 256 * 2;
constexpr int MAX_GRID = 1024;
constexpr size_t OFF_XBCB = OFF_SCR + SCR_PER_BLOCK * MAX_GRID;
constexpr size_t OFF_HQG = OFF_XBCB + (size_t)NR * 1536 * 2;
constexpr size_t OFF_HQM = OFF_HQG + (size_t)2048 * 4096 * 2;
constexpr size_t OFF_HKM = OFF_HQM + (size_t)2048 * 4096 * 2;
constexpr size_t OFF_HKD = OFF_HKM + (size_t)2048 * 4096 * 2;
constexpr size_t OFF_HDS = OFF_HKD + (size_t)2048 * 4096 * 2;
constexpr size_t OFF_BAR = OFF_HDS + (size_t)2048 * 128 * 4;
constexpr size_t WS_END = OFF_BAR + 16384;

constexpr size_t O_YP = 0;
constexpr size_t O_YS = O_YP + (size_t)NP * 1024;
constexpr size_t O_CAP = O_YS + (size_t)NS * 1024;
constexpr size_t O_HGP = O_CAP + (size_t)2 * 8 * 2 * 512;
constexpr size_t O_SCP = O_HGP + (size_t)2 * 8 * 4 * 128 * 128;
constexpr size_t O_SSP = O_SCP + (size_t)2 * 8 * 3 * 1536;
constexpr size_t O_MKP = O_SSP + (size_t)2 * 8 * 16 * 64 * 128;
constexpr size_t O_MVP = O_MKP + (size_t)2 * 8 * 256 * 1024;
constexpr size_t O_CAS = O_MVP + (size_t)2 * 8 * 256 * 1024;
constexpr size_t O_HGS = O_CAS + (size_t)2 * 128 * 2 * 512;
constexpr size_t O_SCS = O_HGS + (size_t)2 * 128 * 4 * 128 * 128;
constexpr size_t O_SSS = O_SCS + (size_t)2 * 128 * 3 * 1536;

enum { I_XP = 0, I_XS, I_MEM, I_SCA, I_SHG, I_SSC, I_SSS, I_CK, I_CV, I_WIN, I_CAW, I_HLB, I_HGN, I_SCW, I_SCB, I_DTB, I_ALOG, I_DSK,
       I_SNORM, I_WOUT, I_GPM, I_GQM, I_GPX, I_GQX, I_GMEM, I_WQ, I_WK, I_WV, I_WO };

struct Params {
    const float* in[29];
    float* out;
    char* ws;
    int ph_lo, ph_hi, coop, pad;
};

DEVINL float bf2f(uint32_t h) { return __uint_as_float(h << 16); }
DEVINL uint32_t f2bf(float f) { uint32_t u = __float_as_uint(f); return (u + 0x7fffu + ((u >> 16) & 1u)) >> 16; }
DEVINL uint32_t pack2(float a, float b) { return f2bf(a) | (f2bf(b) << 16); }
DEVINL float lo16(uint32_t v) { return __uint_as_float(v << 16); }
DEVINL float hi16(uint32_t v) { return __uint_as_float(v & 0xffff0000u); }
DEVINL float sigmoidf_(float x) { return __builtin_amdgcn_rcpf(1.0f + __expf(-x)); }
DEVINL float siluf_(float x) { return x * __builtin_amdgcn_rcpf(1.0f + __expf(-x)); }
DEVINL float wave_sum(float v) {
#pragma unroll
    for (int o = 32; o; o >>= 1) v += __shfl_xor(v, o);
    return v;
}
DEVINL float wave_max(float v) {
#pragma unroll
    for (int o = 32; o; o >>= 1) v = fmaxf(v, __shfl_xor(v, o));
    return v;
}
DEVINL void lds_barrier() { asm volatile("s_waitcnt lgkmcnt(0)\n\ts_barrier" ::: "memory"); }
DEVINL float4 ldnt4(const float* p) { const f32x4 v = __builtin_nontemporal_load((const f32x4*)p); return make_float4(v[0], v[1], v[2], v[3]); }
DEVINL uint4 ldnt16(const void* p) { const u32x4 v = __builtin_nontemporal_load((const u32x4*)p); return make_uint4(v[0], v[1], v[2], v[3]); }
DEVINL void stnt4(float* p, float4 v) { const f32x4 t = (f32x4){v.x, v.y, v.z, v.w}; __builtin_nontemporal_store(t, (f32x4*)p); }
#define UNPACK8(v, f) do { f[0] = lo16(v.x); f[1] = hi16(v.x); f[2] = lo16(v.y); f[3] = hi16(v.y); f[4] = lo16(v.z); f[5] = hi16(v.z); f[6] = lo16(v.w); f[7] = hi16(v.w); } while (0)

template <class Epi>
DEVINL void gemm_tile(const u16* __restrict__ A, int lda, const u16* __restrict__ Bt, int ldb, int K, char* lds, Epi epi) {
    const int tid = threadIdx.x, lane = tid & 63, wave = tid >> 6, wr = wave >> 1, wc = wave & 1, fr = lane & 15, fq = lane >> 4;
    f32x4 acc[4][4];
#pragma unroll
    for (int m = 0; m < 4; ++m)
#pragma unroll
        for (int n = 0; n < 4; ++n) acc[m][n] = (f32x4){0.f, 0.f, 0.f, 0.f};
    const int srow = tid >> 2, sch = tid & 3;
    const u16* Ag = A + (size_t)srow * lda + sch * 8;
    const u16* Bg = Bt + (size_t)srow * ldb + sch * 8;
    const int soff = srow * 64 + ((sch ^ (((srow >> 3) & 1) << 1)) << 4);
    const int swz = ((fq ^ (((fr >> 3) & 1) << 1)) << 4);
    const int fa = (wr * 64 + fr) * 64 + swz;
    const int fb = 16384 + (wc * 64 + fr) * 64 + swz;
    uint4 pa0, pa1, pa2, pa3, pb0, pb1, pb2, pb3, qa0, qa1, qa2, qa3, qb0, qb1, qb2, qb3;
    const int nt = K >> 6;
    const size_t sA1 = (size_t)64 * lda, sB1 = (size_t)64 * ldb;
#define G_LOAD(P, T) do { const int k0_ = (T) << 6; \
        P##a0 = *(const uint4*)(Ag + k0_); P##a1 = *(const uint4*)(Ag + k0_ + 32); P##a2 = *(const uint4*)(Ag + sA1 + k0_); P##a3 = *(const uint4*)(Ag + sA1 + k0_ + 32); \
        P##b0 = *(const uint4*)(Bg + k0_); P##b1 = *(const uint4*)(Bg + k0_ + 32); P##b2 = *(const uint4*)(Bg + sB1 + k0_); P##b3 = *(const uint4*)(Bg + sB1 + k0_ + 32); } while (0)
#define G_STORE(P, ST) do { char* nb_ = lds + (ST) * 32768 + soff; \
        *(uint4*)(nb_) = P##a0; *(uint4*)(nb_ + 8192) = P##a1; *(uint4*)(nb_ + 4096) = P##a2; *(uint4*)(nb_ + 4096 + 8192) = P##a3; \
        *(uint4*)(nb_ + 16384) = P##b0; *(uint4*)(nb_ + 16384 + 8192) = P##b1; *(uint4*)(nb_ + 16384 + 4096) = P##b2; *(uint4*)(nb_ + 16384 + 4096 + 8192) = P##b3; } while (0)
    auto g_compute = [&](int ST) __attribute__((always_inline)) {
        const char* base = lds + ST * 32768;
#pragma unroll
        for (int s = 0; s < 2; ++s) {
            bf16x8 a[4], b[4];
#pragma unroll
            for (int m = 0; m < 4; ++m) a[m] = *(const bf16x8*)(base + fa + m * 1024 + s * 8192);
#pragma unroll
            for (int n = 0; n < 4; ++n) b[n] = *(const bf16x8*)(base + fb + n * 1024 + s * 8192);
            __builtin_amdgcn_s_setprio(1);
#pragma unroll
            for (int m = 0; m < 4; ++m)
#pragma unroll
                for (int n = 0; n < 4; ++n) acc[m][n] = __builtin_amdgcn_mfma_f32_16x16x32_bf16(b[n], a[m], acc[m][n], 0, 0, 0);
            __builtin_amdgcn_s_setprio(0);
        }
    };
#define G_COMPUTE(ST) g_compute(ST)
    G_LOAD(p, 0);
    if (nt > 1) G_LOAD(q, 1);
    G_STORE(p, 0);
    if (nt > 2) G_LOAD(p, 2);
    lds_barrier();
#pragma unroll 1
    for (int t = 0; t < nt; t += 2) {
        if (t + 1 < nt) G_STORE(q, 1);
        if (t + 3 < nt) G_LOAD(q, t + 3);
        G_COMPUTE(0);
        lds_barrier();
        if (t + 1 < nt) {
            if (t + 2 < nt) G_STORE(p, 0);
            if (t + 4 < nt) G_LOAD(p, t + 4);
            G_COMPUTE(1);
            lds_barrier();
        }
    }
#undef G_LOAD
#undef G_STORE
#undef G_COMPUTE
#pragma unroll
    for (int m = 0; m < 4; ++m)
#pragma unroll
        for (int n = 0; n < 4; ++n) epi(wr * 64 + m * 16 + fr, wc * 64 + n * 16 + fq * 4, acc[m][n]);
}

DEVINL void gemm_tile_b(const u16* __restrict__ A, int lda, const u16* __restrict__ Bt, int ldb, int K, char* lds, u16* __restrict__ dst, int ldd) {
    const int tid = threadIdx.x, lane = tid & 63, wave = tid >> 6, wr = wave >> 1, wc = wave & 1, fr = lane & 15, fq = lane >> 4;
    f32x4 acc[4][4];
#pragma unroll
    for (int m = 0; m < 4; ++m)
#pragma unroll
        for (int n = 0; n < 4; ++n) acc[m][n] = (f32x4){0.f, 0.f, 0.f, 0.f};
    const int srow = tid >> 2, sch = tid & 3;
    const u16* Ag = A + (size_t)srow * lda + sch * 8;
    const u16* Bg = Bt + (size_t)srow * ldb + sch * 8;
    const int soff = srow * 64 + ((sch ^ (((srow >> 3) & 1) << 1)) << 4);
    const int swz = ((fq ^ (((fr >> 3) & 1) << 1)) << 4);
    const int fa = (wr * 64 + fr) * 64 + swz;
    const int fb = 16384 + (wc * 64 + fr) * 64 + swz;
    uint4 pa0, pa1, pa2, pa3, pb0, pb1, pb2, pb3, qa0, qa1, qa2, qa3, qb0, qb1, qb2, qb3;
    const int nt = K >> 6;
    const size_t sA1 = (size_t)64 * lda, sB1 = (size_t)64 * ldb;
#define G_LOAD(P, T) do { const int k0_ = (T) << 6; \
        P##a0 = *(const uint4*)(Ag + k0_); P##a1 = *(const uint4*)(Ag + k0_ + 32); P##a2 = *(const uint4*)(Ag + sA1 + k0_); P##a3 = *(const uint4*)(Ag + sA1 + k0_ + 32); \
        P##b0 = *(const uint4*)(Bg + k0_); P##b1 = *(const uint4*)(Bg + k0_ + 32); P##b2 = *(const uint4*)(Bg + sB1 + k0_); P##b3 = *(const uint4*)(Bg + sB1 + k0_ + 32); } while (0)
#define G_STORE(P, ST) do { char* nb_ = lds + (ST) * 32768 + soff; \
        *(uint4*)(nb_) = P##a0; *(uint4*)(nb_ + 8192) = P##a1; *(uint4*)(nb_ + 4096) = P##a2; *(uint4*)(nb_ + 4096 + 8192) = P##a3; \
        *(uint4*)(nb_ + 16384) = P##b0; *(uint4*)(nb_ + 16384 + 8192) = P##b1; *(uint4*)(nb_ + 16384 + 4096) = P##b2; *(uint4*)(nb_ + 16384 + 4096 + 8192) = P##b3; } while (0)
    auto g_compute = [&](int ST) __attribute__((always_inline)) {
        const char* base = lds + ST * 32768;
#pragma unroll
        for (int s = 0; s < 2; ++s) {
            bf16x8 a[4], b[4];
#pragma unroll
            for (int m = 0; m < 4; ++m) a[m] = *(const bf16x8*)(base + fa + m * 1024 + s * 8192);
#pragma unroll
            for (int n = 0; n < 4; ++n) b[n] = *(const bf16x8*)(base + fb + n * 1024 + s * 8192);
            __builtin_amdgcn_s_setprio(1);
#pragma unroll
            for (int m = 0; m < 4; ++m)
#pragma unroll
                for (int n = 0; n < 4; ++n) acc[m][n] = __builtin_amdgcn_mfma_f32_16x16x32_bf16(b[n], a[m], acc[m][n], 0, 0, 0);
            __builtin_amdgcn_s_setprio(0);
        }
    };
#define G_COMPUTE(ST) g_compute(ST)
    G_LOAD(p, 0);
    if (nt > 1) G_LOAD(q, 1);
    G_STORE(p, 0);
    if (nt > 2) G_LOAD(p, 2);
    lds_barrier();
#pragma unroll 1
    for (int t = 0; t < nt; t += 2) {
        if (t + 1 < nt) G_STORE(q, 1);
        if (t + 3 < nt) G_LOAD(q, t + 3);
        G_COMPUTE(0);
        lds_barrier();
        if (t + 1 < nt) {
            if (t + 2 < nt) G_STORE(p, 0);
            if (t + 4 < nt) G_LOAD(p, t + 4);
            G_COMPUTE(1);
            lds_barrier();
        }
    }
#undef G_LOAD
#undef G_STORE
#undef G_COMPUTE
    {
        char* img = lds + wave * 9216;
#pragma unroll
        for (int m = 0; m < 4; ++m)
#pragma unroll
            for (int n = 0; n < 4; ++n)
                *(uint2*)(img + (m * 16 + fr) * 144 + (n * 16 + fq * 4) * 2) = make_uint2(pack2(acc[m][n][0], acc[m][n][1]), pack2(acc[m][n][2], acc[m][n][3]));
        u16* d0 = dst + (size_t)(wr * 64) * ldd + wc * 64 + (lane & 7) * 8;
#pragma unroll
        for (int it = 0; it < 8; ++it) {
            const int row = it * 8 + (lane >> 3);
            const uint4 v = *(const uint4*)(img + row * 144 + (lane & 7) * 16);
            *(uint4*)(d0 + (size_t)row * ldd) = v;
        }
    }
    lds_barrier();
}

template <class Epi>
DEVINL void gemm_tile1(const u16* __restrict__ A, int lda, const u16* __restrict__ Bt, int ldb, int K, char* lds, Epi epi) {
    const int tid = threadIdx.x, lane = tid & 63, wave = tid >> 6, wr = wave >> 1, wc = wave & 1, fr = lane & 15, fq = lane >> 4;
    f32x4 acc[4][4];
#pragma unroll
    for (int m = 0; m < 4; ++m)
#pragma unroll
        for (int n = 0; n < 4; ++n) acc[m][n] = (f32x4){0.f, 0.f, 0.f, 0.f};
    const int srow = tid >> 3, sch = tid & 7;
    const u16* Ag = A + (size_t)srow * lda + sch * 8;
    const u16* Bg = Bt + (size_t)srow * ldb + sch * 8;
    const int soff = (sch >> 2) * 8192 + srow * 64 + ((((sch & 3) ^ (((srow >> 3) & 1) << 1))) << 4);
    const int swz = ((fq ^ (((fr >> 3) & 1) << 1)) << 4);
    const int fa = (wr * 64 + fr) * 64 + swz;
    const int fb = 16384 + (wc * 64 + fr) * 64 + swz;
    uint4 ra[4], rb[4];
    const int nt = K >> 6;
#pragma unroll
    for (int i = 0; i < 4; ++i) {
        ra[i] = *(const uint4*)(Ag + (size_t)i * 32 * lda);
        rb[i] = *(const uint4*)(Bg + (size_t)i * 32 * ldb);
    }
#pragma unroll
    for (int i = 0; i < 4; ++i) {
        *(uint4*)(lds + soff + i * 2048) = ra[i];
        *(uint4*)(lds + 16384 + soff + i * 2048) = rb[i];
    }
    __syncthreads();
    for (int t = 0; t < nt; ++t) {
        const bool more = (t + 1 < nt);
        if (more) {
            const int k0 = (t + 1) << 6;
#pragma unroll
            for (int i = 0; i < 4; ++i) {
                ra[i] = *(const uint4*)(Ag + (size_t)i * 32 * lda + k0);
                rb[i] = *(const uint4*)(Bg + (size_t)i * 32 * ldb + k0);
            }
        }
        const char* base = lds + (t & 1) * 32768;
#pragma unroll
        for (int s = 0; s < 2; ++s) {
            bf16x8 a[4], b[4];
#pragma unroll
            for (int m = 0; m < 4; ++m) a[m] = *(const bf16x8*)(base + fa + m * 1024 + s * 8192);
#pragma unroll
            for (int n = 0; n < 4; ++n) b[n] = *(const bf16x8*)(base + fb + n * 1024 + s * 8192);
#pragma unroll
            for (int m = 0; m < 4; ++m)
#pragma unroll
                for (int n = 0; n < 4; ++n) acc[m][n] = __builtin_amdgcn_mfma_f32_16x16x32_bf16(b[n], a[m], acc[m][n], 0, 0, 0);
        }
        if (more) {
            char* nb = lds + ((t + 1) & 1) * 32768;
#pragma unroll
            for (int i = 0; i < 4; ++i) {
                *(uint4*)(nb + soff + i * 2048) = ra[i];
                *(uint4*)(nb + 16384 + soff + i * 2048) = rb[i];
            }
        }
        __syncthreads();
    }
#pragma unroll
    for (int m = 0; m < 4; ++m)
#pragma unroll
        for (int n = 0; n < 4; ++n) epi(wr * 64 + m * 16 + fr, wc * 64 + n * 16 + fq * 4, acc[m][n]);
}

DEVINL void tile_mn(int id, int nM, int nN, int& m, int& n) {
    const int grp = id / (8 * nN), fm = grp * 8;
    const int gsz = (nM - fm) < 8 ? (nM - fm) : 8;
    const int rem = id - grp * 8 * nN;
    m = fm + rem % gsz; n = rem / gsz;
}

template <class F>
DEVINL void for_tiles_xcd(int T, F f) {
    const int G = gridDim.x;
    if ((G & 7) == 0) {
        const int x = blockIdx.x & 7, s = blockIdx.x >> 3, GS = G >> 3, per = ((((T + 7) >> 3) + 63) >> 6) << 6;
        for (int i = s; i < per; i += GS) { const int id = x * per + i; if (id < T) f(id); }
    } else {
        for (int id = blockIdx.x; id < T; id += G) f(id);
    }
}

DEVINL void transpose_tile(const float* __restrict__ W, int K, int N, u16* __restrict__ Wt, int k0, int n0, float* tile) {
    const int tid = threadIdx.x, tx = tid & 15, ty = tid >> 4;
#pragma unroll
    for (int i = 0; i < 4; ++i) {
        const int k = ty + 16 * i, n = n0 + tx * 4;
        float4 v = make_float4(0.f, 0.f, 0.f, 0.f);
        if (n < N) v = ldnt4(W + (size_t)(k0 + k) * N + n);
        float* t = tile + k * 65 + tx * 4;
        t[0] = v.x; t[1] = v.y; t[2] = v.z; t[3] = v.w;
    }
    __syncthreads();
    const int n = tid >> 2, kc = (tid & 3) * 16;
    uint32_t w[8];
#pragma unroll
    for (int j = 0; j < 8; ++j) w[j] = pack2(tile[(kc + 2 * j) * 65 + n], tile[(kc + 2 * j + 1) * 65 + n]);
    uint4* dst = (uint4*)(Wt + (size_t)(n0 + n) * K + k0 + kc);
    dst[0] = make_uint4(w[0], w[1], w[2], w[3]);
    dst[1] = make_uint4(w[4], w[5], w[6], w[7]);
    __syncthreads();
}

DEVINL void rowpass_row(const float* __restrict__ base, const u16* __restrict__ trow, const float* __restrict__ gpost,
                        float* __restrict__ xdst, const float* __restrict__ gnext, u16* __restrict__ hb, int lane, bool ntx = false) {
    float x[16];
    {
        const float4 a = ldnt4(base + lane * 8), b = ldnt4(base + lane * 8 + 4);
        const float4 c = ldnt4(base + 512 + lane * 8), d = ldnt4(base + 512 + lane * 8 + 4);
        x[0] = a.x; x[1] = a.y; x[2] = a.z; x[3] = a.w; x[4] = b.x; x[5] = b.y; x[6] = b.z; x[7] = b.w;
        x[8] = c.x; x[9] = c.y; x[10] = c.z; x[11] = c.w; x[12] = d.x; x[13] = d.y; x[14] = d.z; x[15] = d.w;
    }
    if (trow) {
        float t[16], g[16];
        {
            const uint4 t0 = ldnt16(trow + lane * 8), t1 = ldnt16(trow + 512 + lane * 8);
            t[0] = lo16(t0.x); t[1] = hi16(t0.x); t[2] = lo16(t0.y); t[3] = hi16(t0.y); t[4] = lo16(t0.z); t[5] = hi16(t0.z); t[6] = lo16(t0.w); t[7] = hi16(t0.w);
            t[8] = lo16(t1.x); t[9] = hi16(t1.x); t[10] = lo16(t1.y); t[11] = hi16(t1.y); t[12] = lo16(t1.z); t[13] = hi16(t1.z); t[14] = lo16(t1.w); t[15] = hi16(t1.w);
        }
#pragma unroll
        for (int h = 0; h < 2; ++h)
#pragma unroll
            for (int q = 0; q < 2; ++q) {
                const float4 gg = *(const float4*)(gpost + h * 512 + lane * 8 + q * 4);
                g[h * 8 + q * 4 + 0] = gg.x; g[h * 8 + q * 4 + 1] = gg.y; g[h * 8 + q * 4 + 2] = gg.z; g[h * 8 + q * 4 + 3] = gg.w;
            }
        float ss = 0.f;
#pragma unroll
        for (int i = 0; i < 16; ++i) ss += t[i] * t[i];
        ss = wave_sum(ss);
        const float rstd = rsqrtf(ss * (1.0f / 1024.0f) + EPS);
#pragma unroll
        for (int i = 0; i < 16; ++i) x[i] += t[i] * rstd * g[i];
    }
    if (xdst) {
#pragma unroll
        for (int h = 0; h < 2; ++h)
#pragma unroll
            for (int q = 0; q < 2; ++q)
            {
                const float4 xv = make_float4(x[h * 8 + q * 4], x[h * 8 + q * 4 + 1], x[h * 8 + q * 4 + 2], x[h * 8 + q * 4 + 3]);
                (void)ntx; stnt4(xdst + h * 512 + lane * 8 + q * 4, xv);
            }
    }
    if (gnext) {
        float ss = 0.f;
#pragma unroll
        for (int i = 0; i < 16; ++i) ss += x[i] * x[i];
        ss = wave_sum(ss);
        const float rstd = rsqrtf(ss * (1.0f / 1024.0f) + EPS);
#pragma unroll
        for (int h = 0; h < 2; ++h) {
            const float4 g0 = *(const float4*)(gnext + h * 512 + lane * 8), g1 = *(const float4*)(gnext + h * 512 + lane * 8 + 4);
            uint4 o;
            o.x = pack2(x[h * 8 + 0] * rstd * g0.x, x[h * 8 + 1] * rstd * g0.y);
            o.y = pack2(x[h * 8 + 2] * rstd * g0.z, x[h * 8 + 3] * rstd * g0.w);
            o.z = pack2(x[h * 8 + 4] * rstd * g1.x, x[h * 8 + 5] * rstd * g1.y);
            o.w = pack2(x[h * 8 + 6] * rstd * g1.z, x[h * 8 + 7] * rstd * g1.w);
            *(uint4*)(hb + h * 512 + lane * 8) = o;
        }
    }
}

DEVINL void phase_prologue(const Params& p, char* lds) {
    const int G = gridDim.x;
    u16* WinT = (u16*)(p.ws + OFF_WIN);
    u16* WoutT = (u16*)(p.ws + OFF_WOUT);
    for (int it = blockIdx.x; it < 6464; it += G) {
        const int l = it / 3232; int r = it % 3232;
        const float* W; u16* Wt; int K, N, kt, nt;
        if (r < 1696) { W = p.in[I_WIN] + (size_t)l * 1024 * DIN; K = 1024; N = DIN; Wt = WinT + (size_t)l * DINP * 1024; kt = r & 15; nt = r >> 4; }
        else if (r < 2208) { r -= 1696; W = p.in[I_WOUT] + (size_t)l * 2048 * 1024; K = 2048; N = 1024; Wt = WoutT + (size_t)l * 1024 * 2048; kt = r & 31; nt = r >> 5; }
        else {
            r -= 2208; const int j = r >> 8; r &= 255;
            W = p.in[j == 0 ? I_WQ : j == 1 ? I_WK : j == 2 ? I_WV : I_WO] + (size_t)l * 1024 * 1024;
            Wt = (u16*)(p.ws + (j == 0 ? OFF_WQ : j == 1 ? OFF_WK : j == 2 ? OFF_WV : OFF_WO)) + (size_t)l * 1024 * 1024;
            K = 1024; N = 1024; kt = r & 15; nt = r >> 4;
        }
        transpose_tile(W, K, N, Wt, kt * 64, nt * 64, (float*)lds);
    }
    const int wave = threadIdx.x >> 6, lane = threadIdx.x & 63;
    float* X = (float*)(p.ws + OFF_X);
    u16* Hb = (u16*)(p.ws + OFF_HB);
    u16* Mb = (u16*)(p.ws + OFF_MB);
    for (int it = blockIdx.x; it < (NR + 2048) / 4; it += G) {
        const int r = it * 4 + wave;
        if (r < NR) {
            const float* src = r < NP ? p.in[I_XP] + (size_t)r * 1024 : p.in[I_XS] + (size_t)(r - NP) * 1024;
            rowpass_row(src, nullptr, nullptr, nullptr, p.in[I_GPM], Hb + (size_t)r * 1024, lane);
        } else {
            const int m = r - NR;
            rowpass_row(p.in[I_MEM] + (size_t)m * 1024, nullptr, nullptr, nullptr, p.in[I_GMEM], Mb + (size_t)m * 1024, lane);
        }
    }
}

DEVINL void phase_gemm_in(const Params& p, int l, char* lds) {
    const u16* Hb = (const u16*)(p.ws + OFF_HB);
    const u16* Mb = (const u16*)(p.ws + OFF_MB);
    const u16* WinT = (const u16*)(p.ws + OFF_WIN) + (size_t)l * DINP * 1024;
    const u16* WkT = (const u16*)(p.ws + OFF_WK) + (size_t)l * 1024 * 1024;
    const u16* WvT = (const u16*)(p.ws + OFF_WV) + (size_t)l * 1024 * 1024;
    u16* U = (u16*)(p.ws + OFF_U);
    u16* MKb = (u16*)(p.ws + OFF_MK);
    u16* MVT = (u16*)(p.ws + OFF_MVT);
    float* omk = p.out + O_MKP + (size_t)l * 2048 * 1024;
    float* omv = p.out + O_MVP + (size_t)l * 2048 * 1024;
    constexpr int TU = 129 * 53;
    for_tiles_xcd(TU + 256, [&](int id) {
        if (id < TU) {
            int m, n; tile_mn(id, 129, 53, m, n);
            u16* dst = U + (size_t)m * 128 * DINP + n * 128;
            gemm_tile_b(Hb + (size_t)m * 128 * 1024, 1024, WinT + (size_t)n * 128 * 1024, 1024, 1024, lds, dst, DINP);
        } else {
            int id2 = id - TU; const int isv = id2 >> 7; id2 &= 127;
            const int m = id2 & 15, n = id2 >> 4;
            if (!isv) {
                float* df = omk + (size_t)m * 128 * 1024 + n * 128;
                u16* db = MKb + (size_t)m * 128 * 1024 + n * 128;
                gemm_tile(Mb + (size_t)m * 128 * 1024, 1024, WkT + (size_t)n * 128 * 1024, 1024, 1024, lds,
                          [&](int r, int c, f32x4 v) {
                              stnt4(df + (size_t)r * 1024 + c, make_float4(v[0], v[1], v[2], v[3]));
                              *(uint2*)(db + (size_t)r * 1024 + c) = make_uint2(pack2(v[0], v[1]), pack2(v[2], v[3]));
                          });
            } else {
                float* df = omv + (size_t)m * 128 * 1024 + n * 128;
                gemm_tile(Mb + (size_t)m * 128 * 1024, 1024, WvT + (size_t)n * 128 * 1024, 1024, 1024, lds,
                          [&](int r, int c, f32x4 v) {
                              stnt4(df + (size_t)r * 1024 + c, make_float4(v[0], v[1], v[2], v[3]));
                              const int row = m * 128 + r, col = n * 128 + c;
                              const int b = row >> 8, mm = row & 255, h = col >> 8, d = col & 255;
                              u16* t = MVT + ((size_t)((b * 4 + h) * 256 + d)) * 256 + mm;
                              t[0] = (u16)f2bf(v[0]); t[256] = (u16)f2bf(v[1]); t[512] = (u16)f2bf(v[2]); t[768] = (u16)f2bf(v[3]);
                          });
            }
        }
    });
}

DEVINL void phase_gemm_n1024(const u16* A, int K, const u16* Wt, float* Cf, u16* Cb, char* lds) {
    for_tiles_xcd(128 * 8, [&](int id) {
        int m, n; tile_mn(id, 128, 8, m, n);
        const size_t o = (size_t)m * 128 * 1024 + n * 128;
        if (Cf) {
            float* df = Cf + o;
            gemm_tile(A + (size_t)m * 128 * K, K, Wt + (size_t)n * 128 * K, K, K, lds,
                      [&](int r, int c, f32x4 v) { *(float4*)(df + (size_t)r * 1024 + c) = make_float4(v[0], v[1], v[2], v[3]); });
        } else {
            u16* db = Cb + o;
            gemm_tile_b(A + (size_t)m * 128 * K, K, Wt + (size_t)n * 128 * K, K, K, lds, db, 1024);
        }
    });
    const int tid = threadIdx.x, lane = tid & 63, w = tid >> 6, fr = lane & 15, fq = lane >> 4;
    float* red = (float*)lds;
    for (int pc = blockIdx.x; pc < 512; pc += gridDim.x) {
        const int row0 = NP + (pc >> 6) * 16, col0 = (pc & 63) * 16;
        const int kq = K >> 2;
        const u16* pa = A + (size_t)(row0 + fr) * K + w * kq + fq * 8;
        const u16* pb = Wt + (size_t)(col0 + fr) * K + w * kq + fq * 8;
        f32x4 acc = (f32x4){0.f, 0.f, 0.f, 0.f};
#pragma unroll 4
        for (int k = 0; k < kq; k += 32)
            acc = __builtin_amdgcn_mfma_f32_16x16x32_bf16(*(const bf16x8*)(pb + k), *(const bf16x8*)(pa + k), acc, 0, 0, 0);
        *(float4*)(red + (w * 64 + lane) * 4) = make_float4(acc[0], acc[1], acc[2], acc[3]);
        __syncthreads();
        if (w == 0) {
            const float4 a0 = *(const float4*)(red + lane * 4), a1 = *(const float4*)(red + (64 + lane) * 4), a2 = *(const float4*)(red + (128 + lane) * 4), a3 = *(const float4*)(red + (192 + lane) * 4);
            const float v0 = a0.x + a1.x + a2.x + a3.x, v1 = a0.y + a1.y + a2.y + a3.y, v2 = a0.z + a1.z + a2.z + a3.z, v3 = a0.w + a1.w + a2.w + a3.w;
            const size_t o = (size_t)(row0 + fr) * 1024 + col0 + fq * 4;
            if (Cf) *(float4*)(Cf + o) = make_float4(v0, v1, v2, v3);
            else *(uint2*)(Cb + o) = make_uint2(pack2(v0, v1), pack2(v2, v3));
        }
        __syncthreads();
    }
}

DEVINL float hgrn_lb(const Params& p, int l, int c) {
    if (l == 0) return 0.f;
    const float b0 = p.in[I_HLB][c], b1 = p.in[I_HLB][512 + c];
    return 1.0f / (1.0f + __expf(b0 - b1));
}

DEVINL void hgrn_prep_unit(const Params& p, int l, int u, char* lds) {
    const int c = u & 63, h = (u >> 6) & 3, b = u >> 8;
    const int tid = threadIdx.x;
    float* tot = (float*)lds;
    const u16* U = (const u16*)(p.ws + OFF_U);
    u16* QG = (u16*)(p.ws + OFF_HQG) + (size_t)u * 4096;
    u16* QM = (u16*)(p.ws + OFF_HQM) + (size_t)u * 4096;
    u16* KM = (u16*)(p.ws + OFF_HKM) + (size_t)u * 4096;
    u16* KD = (u16*)(p.ws + OFF_HKD) + (size_t)u * 4096;
    float* DS = (float*)(p.ws + OFF_HDS) + (size_t)u * 128;
    const int kp = (tid & 63) * 2, tq = tid >> 6;
    const float lb0 = hgrn_lb(p, l, h * 128 + kp), lb1 = hgrn_lb(p, l, h * 128 + kp + 1);
    const u16* pQ = U + ((size_t)b * SEQ + c * 32 + tq * 8) * DINP + 2048 + h * 128 + kp;
    uint32_t rq[8], rf[8];
#pragma unroll
    for (int i = 0; i < 8; ++i) { rq[i] = *(const uint32_t*)(pQ + (size_t)i * DINP); rf[i] = *(const uint32_t*)(pQ + (size_t)i * DINP + 512); }
    float f0[8], f1[8], L0[8], L1[8];
    {
        float a0 = 0.f, a1 = 0.f;
#pragma unroll
        for (int i = 0; i < 8; ++i) {
            f0[i] = lb0 + (1.f - lb0) * sigmoidf_(lo16(rf[i]));
            f1[i] = lb1 + (1.f - lb1) * sigmoidf_(hi16(rf[i]));
            a0 += __logf(f0[i]); a1 += __logf(f1[i]);
            L0[i] = a0; L1[i] = a1;
        }
        *(float2*)(tot + tq * 128 + kp) = make_float2(a0, a1);
    }
    __syncthreads();
    {
        const float2 t0 = *(const float2*)(tot + kp), t1 = *(const float2*)(tot + 128 + kp), t2 = *(const float2*)(tot + 256 + kp), t3 = *(const float2*)(tot + 384 + kp);
        const float off0 = (tq > 0 ? t0.x : 0.f) + (tq > 1 ? t1.x : 0.f) + (tq > 2 ? t2.x : 0.f);
        const float off1 = (tq > 0 ? t0.y : 0.f) + (tq > 1 ? t1.y : 0.f) + (tq > 2 ? t2.y : 0.f);
        const float ref0 = t0.x + t1.x, ref1 = t0.y + t1.y;
        const float last0 = ref0 + t2.x + t3.x, last1 = ref1 + t2.y + t3.y;
        uint32_t kd[8];
#pragma unroll
        for (int i = 0; i < 8; ++i) {
            const int t = tq * 8 + i;
            const float G0 = L0[i] + off0, G1 = L1[i] + off1;
            const float q0 = lo16(rq[i]), q1 = hi16(rq[i]);
            const float k0 = 1.f - f0[i], k1 = 1.f - f1[i];
            *(uint32_t*)(QG + t * 128 + kp) = pack2(q0 * __expf(G0), q1 * __expf(G1));
            *(uint32_t*)(QM + t * 128 + kp) = pack2(q0 * __expf(fminf(G0 - ref0, 60.f)), q1 * __expf(fminf(G1 - ref1, 60.f)));
            *(uint32_t*)(KM + t * 128 + kp) = pack2(k0 * __expf(fminf(ref0 - G0, 60.f)), k1 * __expf(fminf(ref1 - G1, 60.f)));
            kd[i] = pack2(k0 * __expf(last0 - G0), k1 * __expf(last1 - G1));
        }
        *(uint4*)(KD + kp * 32 + tq * 8) = make_uint4((kd[0] & 0xffffu) | (kd[1] << 16), (kd[2] & 0xffffu) | (kd[3] << 16), (kd[4] & 0xffffu) | (kd[5] << 16), (kd[6] & 0xffffu) | (kd[7] << 16));
        *(uint4*)(KD + (kp + 1) * 32 + tq * 8) = make_uint4((kd[0] >> 16) | (kd[1] & 0xffff0000u), (kd[2] >> 16) | (kd[3] & 0xffff0000u), (kd[4] >> 16) | (kd[5] & 0xffff0000u), (kd[6] >> 16) | (kd[7] & 0xffff0000u));
        if (tq == 0) *(float2*)(DS + kp) = make_float2(__expf(last0), __expf(last1));
    }
    __syncthreads();
}

DEVINL void phase_prep(const Params& p, int l, char* lds) {
    for (int u = blockIdx.x; u < 2048; u += gridDim.x) hgrn_prep_unit(p, l, u, lds);
    const u16* U = (const u16*)(p.ws + OFF_U);
    u16* Ycat = (u16*)(p.ws + OFF_YCAT);
    float* XBC = (float*)(p.ws + OFF_XBC);
    float* DT = (float*)(p.ws + OFF_DT);
    const int tid = threadIdx.x;
#pragma unroll 1
    for (int it = blockIdx.x; it < 1024; it += gridDim.x) {
        const int b = it >> 7, t0 = (it & 127) * 16;
        const size_t r0 = (size_t)b * SEQ + t0;
        if (tid < 64) {
            const int c0 = tid * 8;
            const float* cw = p.in[I_CAW] + (size_t)l * 3 * 512 + c0;
            float w0[8], w1[8], w2[8], pm2[8], pm1[8];
            {
                const float4 a0 = *(const float4*)cw, a1 = *(const float4*)(cw + 4), b0 = *(const float4*)(cw + 512), b1 = *(const float4*)(cw + 516), d0 = *(const float4*)(cw + 1024), d1 = *(const float4*)(cw + 1028);
                w0[0] = a0.x; w0[1] = a0.y; w0[2] = a0.z; w0[3] = a0.w; w0[4] = a1.x; w0[5] = a1.y; w0[6] = a1.z; w0[7] = a1.w;
                w1[0] = b0.x; w1[1] = b0.y; w1[2] = b0.z; w1[3] = b0.w; w1[4] = b1.x; w1[5] = b1.y; w1[6] = b1.z; w1[7] = b1.w;
                w2[0] = d0.x; w2[1] = d0.y; w2[2] = d0.z; w2[3] = d0.w; w2[4] = d1.x; w2[5] = d1.y; w2[6] = d1.z; w2[7] = d1.w;
            }
            if (t0 > 0) {
                const u16* Uq = U + (r0 - 2) * DINP;
                const uint4 h2 = *(const uint4*)(Uq + c0), c2 = *(const uint4*)(Uq + 1024 + c0), h1 = *(const uint4*)(Uq + DINP + c0), c1 = *(const uint4*)(Uq + DINP + 1024 + c0);
                float fh[8], fc[8];
                UNPACK8(h2, fh); UNPACK8(c2, fc);
#pragma unroll
                for (int i = 0; i < 8; ++i) pm2[i] = fc[i] * fh[i];
                UNPACK8(h1, fh); UNPACK8(c1, fc);
#pragma unroll
                for (int i = 0; i < 8; ++i) pm1[i] = fc[i] * fh[i];
            } else {
#pragma unroll
                for (int i = 0; i < 8; ++i) { pm2[i] = 0.f; pm1[i] = 0.f; }
            }
            const float dtb = (tid < 16) ? p.in[I_DTB][l * 16 + tid] : 0.f;
#pragma unroll 4
            for (int j = 0; j < 16; ++j) {
                const u16* Ur = U + (r0 + j) * DINP;
                const uint4 vh = *(const uint4*)(Ur + c0), vc = *(const uint4*)(Ur + 1024 + c0), vb = *(const uint4*)(Ur + 512 + c0), vz = *(const uint4*)(Ur + 1536 + c0);
                float fh[8], fc[8], fb[8], fz[8], pc[8], y[8];
                UNPACK8(vh, fh); UNPACK8(vc, fc); UNPACK8(vb, fb); UNPACK8(vz, fz);
#pragma unroll
                for (int i = 0; i < 8; ++i) {
                    pc[i] = fc[i] * fh[i];
                    const float cv = w0[i] * pm2[i] + w1[i] * pm1[i] + w2[i] * pc[i];
                    y[i] = fb[i] * cv * siluf_(fz[i]);
                    pm2[i] = pm1[i]; pm1[i] = pc[i];
                }
                *(uint4*)(Ycat + (r0 + j) * 2048 + c0) = make_uint4(pack2(y[0], y[1]), pack2(y[2], y[3]), pack2(y[4], y[5]), pack2(y[6], y[7]));
                if (t0 + j >= SEQ - 2) {
                    float* o = p.out + O_CAP + (((size_t)l * 8 + b) * 2 + (t0 + j - (SEQ - 2))) * 512 + c0;
                    *(float4*)o = make_float4(pc[0], pc[1], pc[2], pc[3]);
                    *(float4*)(o + 4) = make_float4(pc[4], pc[5], pc[6], pc[7]);
                }
                if (tid < 16) {
                    const float xx = bf2f(Ur[6656 + tid]) + dtb;
                    DT[(r0 + j) * 16 + tid] = xx > 20.f ? xx : log1pf(__expf(xx));
                }
            }
        } else {
            const int c0 = (tid - 64) * 8;
            const float* cw = p.in[I_SCW] + (size_t)l * 4 * 1536 + c0;
            const float* cb = p.in[I_SCB] + (size_t)l * 1536 + c0;
            float w0[8], w1[8], w2[8], w3[8], bs[8], x3[8], x2[8], x1[8];
#pragma unroll
            for (int i = 0; i < 8; ++i) { w0[i] = cw[i]; w1[i] = cw[1536 + i]; w2[i] = cw[3072 + i]; w3[i] = cw[4608 + i]; bs[i] = cb[i]; }
            if (t0 > 0) {
                const u16* Uq = U + (r0 - 3) * DINP + 5120 + c0;
                const uint4 v3 = *(const uint4*)Uq, v2 = *(const uint4*)(Uq + DINP), v1 = *(const uint4*)(Uq + 2 * (size_t)DINP);
                UNPACK8(v3, x3); UNPACK8(v2, x2); UNPACK8(v1, x1);
            } else {
#pragma unroll
                for (int i = 0; i < 8; ++i) { x3[i] = 0.f; x2[i] = 0.f; x1[i] = 0.f; }
            }
#pragma unroll 4
            for (int j = 0; j < 16; ++j) {
                const uint4 v = *(const uint4*)(U + (r0 + j) * DINP + 5120 + c0);
                float x0[8], y[8];
                UNPACK8(v, x0);
#pragma unroll
                for (int i = 0; i < 8; ++i) {
                    y[i] = siluf_(w0[i] * x3[i] + w1[i] * x2[i] + w2[i] * x1[i] + w3[i] * x0[i] + bs[i]);
                    x3[i] = x2[i]; x2[i] = x1[i]; x1[i] = x0[i];
                }
                *(uint4*)((u16*)(p.ws + OFF_XBCB) + (r0 + j) * 1536 + c0) = make_uint4(pack2(y[0], y[1]), pack2(y[2], y[3]), pack2(y[4], y[5]), pack2(y[6], y[7]));
                if (t0 + j >= SEQ - 3) {
                    float* o = p.out + O_SCP + (((size_t)l * 8 + b) * 3 + (t0 + j - (SEQ - 3))) * 1536 + c0;
                    *(float4*)o = make_float4(x0[0], x0[1], x0[2], x0[3]);
                    *(float4*)(o + 4) = make_float4(x0[4], x0[5], x0[6], x0[7]);
                }
            }
        }
    }
    for (int r = NP + blockIdx.x; r < NR; r += gridDim.x) {
        const bool prompt = false;
        const int t = r & (SEQ - 1), b = r >> 11, s = r - NP;
        const u16* Ur = U + (size_t)r * DINP;
        if (tid < 64) {
            const int c0 = tid * 8;
            float pv[3][8];
#pragma unroll
            for (int j = 0; j < 3; ++j) {
                const int back = 2 - j;
                if (prompt ? (t - back >= 0) : (back == 0)) {
                    const u16* Uq = Ur - (size_t)back * DINP;
                    const uint4 vh = *(const uint4*)(Uq + c0), vc = *(const uint4*)(Uq + 1024 + c0);
                    float fh[8], fc[8]; UNPACK8(vh, fh); UNPACK8(vc, fc);
#pragma unroll
                    for (int i = 0; i < 8; ++i) pv[j][i] = fc[i] * fh[i];
                } else if (prompt) {
#pragma unroll
                    for (int i = 0; i < 8; ++i) pv[j][i] = 0.f;
                } else {
                    const float* st = p.in[I_SCA] + (((size_t)l * NS + s) * 2 + j) * 512 + c0;
                    const float4 a = *(const float4*)st, bb = *(const float4*)(st + 4);
                    pv[j][0] = a.x; pv[j][1] = a.y; pv[j][2] = a.z; pv[j][3] = a.w; pv[j][4] = bb.x; pv[j][5] = bb.y; pv[j][6] = bb.z; pv[j][7] = bb.w;
                }
            }
            const float* cw = p.in[I_CAW] + (size_t)l * 3 * 512 + c0;
            const uint4 vb = *(const uint4*)(Ur + 512 + c0), vz = *(const uint4*)(Ur + 1536 + c0);
            float fb[8], fz[8]; UNPACK8(vb, fb); UNPACK8(vz, fz);
            float y[8];
#pragma unroll
            for (int i = 0; i < 8; ++i) {
                const float cv = cw[i] * pv[0][i] + cw[512 + i] * pv[1][i] + cw[1024 + i] * pv[2][i];
                y[i] = fb[i] * cv * siluf_(fz[i]);
            }
            *(uint4*)(Ycat + (size_t)r * 2048 + c0) = make_uint4(pack2(y[0], y[1]), pack2(y[2], y[3]), pack2(y[4], y[5]), pack2(y[6], y[7]));
            if (prompt) {
                if (t >= SEQ - 2) {
                    float* o = p.out + O_CAP + (((size_t)l * 8 + b) * 2 + (t - (SEQ - 2))) * 512 + c0;
                    *(float4*)o = make_float4(pv[2][0], pv[2][1], pv[2][2], pv[2][3]);
                    *(float4*)(o + 4) = make_float4(pv[2][4], pv[2][5], pv[2][6], pv[2][7]);
                }
            } else {
                float* o = p.out + O_CAS + (((size_t)l * NS + s) * 2) * 512 + c0;
                *(float4*)o = make_float4(pv[1][0], pv[1][1], pv[1][2], pv[1][3]);
                *(float4*)(o + 4) = make_float4(pv[1][4], pv[1][5], pv[1][6], pv[1][7]);
                *(float4*)(o + 512) = make_float4(pv[2][0], pv[2][1], pv[2][2], pv[2][3]);
                *(float4*)(o + 516) = make_float4(pv[2][4], pv[2][5], pv[2][6], pv[2][7]);
            }
        } else {
            const int c0 = (tid - 64) * 8;
            float xv[4][8];
#pragma unroll
            for (int j = 0; j < 4; ++j) {
                const int back = 3 - j;
                if (prompt ? (t - back >= 0) : (back == 0)) {
                    const uint4 v = *(const uint4*)(Ur - (size_t)back * DINP + 5120 + c0);
                    UNPACK8(v, xv[j]);
                } else if (prompt) {
#pragma unroll
                    for (int i = 0; i < 8; ++i) xv[j][i] = 0.f;
                } else {
                    const float* st = p.in[I_SSC] + (((size_t)l * NS + s) * 3 + j) * 1536 + c0;
                    const float4 a = *(const float4*)st, bb = *(const float4*)(st + 4);
                    xv[j][0] = a.x; xv[j][1] = a.y; xv[j][2] = a.z; xv[j][3] = a.w; xv[j][4] = bb.x; xv[j][5] = bb.y; xv[j][6] = bb.z; xv[j][7] = bb.w;
                }
            }
            const float* cw = p.in[I_SCW] + (size_t)l * 4 * 1536 + c0;
            const float* cb = p.in[I_SCB] + (size_t)l * 1536 + c0;
            float y[8];
#pragma unroll
            for (int i = 0; i < 8; ++i) {
                const float cv = cw[i] * xv[0][i] + cw[1536 + i] * xv[1][i] + cw[3072 + i] * xv[2][i] + cw[4608 + i] * xv[3][i] + cb[i];
                y[i] = siluf_(cv);
            }
            if (!prompt) {
                float* xo = XBC + (size_t)r * 1536 + c0;
                *(float4*)xo = make_float4(y[0], y[1], y[2], y[3]);
                *(float4*)(xo + 4) = make_float4(y[4], y[5], y[6], y[7]);
            }
            *(uint4*)((u16*)(p.ws + OFF_XBCB) + (size_t)r * 1536 + c0) = make_uint4(pack2(y[0], y[1]), pack2(y[2], y[3]), pack2(y[4], y[5]), pack2(y[6], y[7]));
            if (prompt) {
                if (t >= SEQ - 3) {
                    float* o = p.out + O_SCP + (((size_t)l * 8 + b) * 3 + (t - (SEQ - 3))) * 1536 + c0;
                    *(float4*)o = make_float4(xv[3][0], xv[3][1], xv[3][2], xv[3][3]);
                    *(float4*)(o + 4) = make_float4(xv[3][4], xv[3][5], xv[3][6], xv[3][7]);
                }
            } else {
                float* o = p.out + O_SCS + (((size_t)l * NS + s) * 3) * 1536 + c0;
#pragma unroll
                for (int j = 0; j < 3; ++j) {
                    *(float4*)(o + j * 1536) = make_float4(xv[j + 1][0], xv[j + 1][1], xv[j + 1][2], xv[j + 1][3]);
                    *(float4*)(o + j * 1536 + 4) = make_float4(xv[j + 1][4], xv[j + 1][5], xv[j + 1][6], xv[j + 1][7]);
                }
            }
        }
        if (tid < 16) {
            const float xx = bf2f(Ur[6656 + tid]) + p.in[I_DTB][l * 16 + tid];
            DT[(size_t)r * 16 + tid] = xx > 20.f ? xx : log1pf(__expf(xx));
        }
    }
}


DEVINL void hgrn_prompt_item(const Params& p, int l, int item, char* lds) {
    const int b = item >> 5, h = (item >> 3) & 3, vs = item & 7;
    const int tid = threadIdx.x, lane = tid & 63, wave = tid >> 6;
    const int vl = wave * 4 + (lane >> 4), kg = lane & 15;
    float* fS = (float*)lds;
    float* qS = fS + 2048;
    float* vS = qS + 2048;
    float* part = vS + 256;
    const u16* U = (const u16*)(p.ws + OFF_U);
    float* OB = (float*)(p.ws + OFF_OB);
    const int tl = tid >> 4, kc = (tid & 15) * 8, vi = tid & 15;
    float lbv[8];
#pragma unroll
    for (int j = 0; j < 8; ++j) lbv[j] = hgrn_lb(p, l, h * 128 + kc + j);
    const size_t rowb = (size_t)b * SEQ;
    const u16* Uq = U + (rowb + tl) * DINP + 2048 + h * 128 + kc;
    const u16* Uv = U + (rowb + tl) * DINP + 3072 + h * 128 + vs * 16 + vi;
    float S[8];
#pragma unroll
    for (int i = 0; i < 8; ++i) S[i] = 0.f;
    uint4 rq = *(const uint4*)Uq, rf = *(const uint4*)(Uq + 512);
    u16 rv = *Uv;
    for (int c = 0; c < SEQ / 16; ++c) {
        {
            float q[8], g[8]; UNPACK8(rq, q); UNPACK8(rf, g);
#pragma unroll
            for (int j = 0; j < 8; ++j) g[j] = lbv[j] + (1.0f - lbv[j]) * sigmoidf_(g[j]);
            *(float4*)(qS + tl * 128 + kc) = make_float4(q[0], q[1], q[2], q[3]);
            *(float4*)(qS + tl * 128 + kc + 4) = make_float4(q[4], q[5], q[6], q[7]);
            *(float4*)(fS + tl * 128 + kc) = make_float4(g[0], g[1], g[2], g[3]);
            *(float4*)(fS + tl * 128 + kc + 4) = make_float4(g[4], g[5], g[6], g[7]);
            vS[tl * 16 + vi] = bf2f(rv);
        }
        if (c + 1 < SEQ / 16) {
            const size_t adv = (size_t)(c + 1) * 16 * DINP;
            rq = *(const uint4*)(Uq + adv); rf = *(const uint4*)(Uq + adv + 512); rv = *(Uv + adv);
        }
        __syncthreads();
#pragma unroll 1
        for (int tg = 0; tg < 16; tg += 4) {
        float pa[4];
#pragma unroll
        for (int tt = 0; tt < 4; ++tt) {
            const int t = tg + tt;
            const float4 f0 = *(const float4*)(fS + t * 128 + kg * 4), f1 = *(const float4*)(fS + t * 128 + 64 + kg * 4);
            const float4 q0 = *(const float4*)(qS + t * 128 + kg * 4), q1 = *(const float4*)(qS + t * 128 + 64 + kg * 4);
            const float vv = vS[t * 16 + vl];
            S[0] = f0.x * S[0] + (1.f - f0.x) * vv; S[1] = f0.y * S[1] + (1.f - f0.y) * vv;
            S[2] = f0.z * S[2] + (1.f - f0.z) * vv; S[3] = f0.w * S[3] + (1.f - f0.w) * vv;
            S[4] = f1.x * S[4] + (1.f - f1.x) * vv; S[5] = f1.y * S[5] + (1.f - f1.y) * vv;
            S[6] = f1.z * S[6] + (1.f - f1.z) * vv; S[7] = f1.w * S[7] + (1.f - f1.w) * vv;
            float a = q0.x * S[0] + q0.y * S[1] + q0.z * S[2] + q0.w * S[3];
            a += q1.x * S[4] + q1.y * S[5] + q1.z * S[6] + q1.w * S[7];
            pa[tt] = a;
        }
#pragma unroll
        for (int tt = 0; tt < 4; ++tt) part[(tg + tt) * 256 + vl * 16 + kg] = pa[tt];
        }
        __syncthreads();
        {
            const float* pp = part + tl * 256 + vi * 16;
            const float4 a = *(const float4*)pp, bq = *(const float4*)(pp + 4), cq = *(const float4*)(pp + 8), dq = *(const float4*)(pp + 12);
            const float o = (a.x + a.y + a.z + a.w) + (bq.x + bq.y + bq.z + bq.w) + (cq.x + cq.y + cq.z + cq.w) + (dq.x + dq.y + dq.z + dq.w);
            OB[(rowb + c * 16 + tl) * 512 + h * 128 + vs * 16 + vi] = o;
        }
    }
    float* so = p.out + O_HGP + (((size_t)l * 8 + b) * 4 + h) * 128 * 128;
#pragma unroll
    for (int i = 0; i < 4; ++i) {
        so[(size_t)(kg * 4 + i) * 128 + vs * 16 + vl] = S[i];
        so[(size_t)(64 + kg * 4 + i) * 128 + vs * 16 + vl] = S[4 + i];
    }
    __syncthreads();
}

DEVINL void ssd_prompt_item(const Params& p, int l, int item, char* lds) {
    const int b = item >> 5, head = (item >> 1) & 15, ph = item & 1, g = head >> 3;
    const int tid = threadIdx.x;
    const int pl = tid >> 3, ng = tid & 7;
    float* Bs = (float*)lds;
    float* Cs = Bs + 2048;
    float* xs = Cs + 2048;
    float* xd = xs + 512;
    float* dcs = xd + 512;
    float* part = dcs + 64;
    const float* XBC = (const float*)(p.ws + OFF_XBC);
    const float* DT = (const float*)(p.ws + OFF_DT);
    const u16* U = (const u16*)(p.ws + OFF_U);
    float* YC = (float*)(p.ws + OFF_YC);
    const float Aneg = -__expf(p.in[I_ALOG][l * 16 + head]);
    const float Dsk = p.in[I_DSK][l * 16 + head];
    const int tl = tid >> 4, nc = (tid & 15) * 8, xc = (tid & 15) * 2;
    const size_t rowb = (size_t)b * SEQ;
    const float* pB = XBC + (rowb + tl) * 1536 + 1024 + g * 128 + nc;
    const float* pX = XBC + (rowb + tl) * 1536 + head * 64 + ph * 32 + xc;
    const float* pD = DT + (rowb + tl) * 16 + head;
    float S[16];
#pragma unroll
    for (int i = 0; i < 16; ++i) S[i] = 0.f;
    float4 rb0 = *(const float4*)pB, rb1 = *(const float4*)(pB + 4), rc0 = *(const float4*)(pB + 256), rc1 = *(const float4*)(pB + 260);
    float2 rx = *(const float2*)pX;
    float rd = *pD;
    for (int c = 0; c < SEQ / 16; ++c) {
        *(float4*)(Bs + tl * 128 + nc) = rb0; *(float4*)(Bs + tl * 128 + nc + 4) = rb1;
        *(float4*)(Cs + tl * 128 + nc) = rc0; *(float4*)(Cs + tl * 128 + nc + 4) = rc1;
        xs[tl * 32 + xc] = rx.x; xs[tl * 32 + xc + 1] = rx.y;
        xd[tl * 32 + xc] = rx.x * rd; xd[tl * 32 + xc + 1] = rx.y * rd;
        if ((tid & 15) == 0) dcs[tl] = __expf(rd * Aneg);
        if (c + 1 < SEQ / 16) {
            const size_t adv = (size_t)(c + 1) * 16;
            const float* qB = pB + adv * 1536;
            rb0 = *(const float4*)qB; rb1 = *(const float4*)(qB + 4); rc0 = *(const float4*)(qB + 256); rc1 = *(const float4*)(qB + 260);
            rx = *(const float2*)(pX + adv * 1536);
            rd = *(pD + adv * 16);
        }
        __syncthreads();
#pragma unroll 1
        for (int tg = 0; tg < 16; tg += 4) {
        float pa[4];
#pragma unroll
        for (int tt = 0; tt < 4; ++tt) {
            const int t = tg + tt;
            const float dec = dcs[t], xdt = xd[t * 32 + pl];
            float a = 0.f;
#pragma unroll
            for (int j = 0; j < 4; ++j) {
                const float4 Bv = *(const float4*)(Bs + t * 128 + j * 32 + ng * 4);
                const float4 Cv = *(const float4*)(Cs + t * 128 + j * 32 + ng * 4);
                S[j * 4 + 0] = dec * S[j * 4 + 0] + xdt * Bv.x; S[j * 4 + 1] = dec * S[j * 4 + 1] + xdt * Bv.y;
                S[j * 4 + 2] = dec * S[j * 4 + 2] + xdt * Bv.z; S[j * 4 + 3] = dec * S[j * 4 + 3] + xdt * Bv.w;
                a += Cv.x * S[j * 4 + 0] + Cv.y * S[j * 4 + 1] + Cv.z * S[j * 4 + 2] + Cv.w * S[j * 4 + 3];
            }
            pa[tt] = a;
        }
#pragma unroll
        for (int tt = 0; tt < 4; ++tt) part[(tg + tt) * 256 + tid] = pa[tt];
        }
        __syncthreads();
#pragma unroll
        for (int i = 0; i < 2; ++i) {
            const int idx = tid + 256 * i, t2 = idx >> 5, p2 = idx & 31;
            const float4 a = *(const float4*)(part + t2 * 256 + p2 * 8), bq = *(const float4*)(part + t2 * 256 + p2 * 8 + 4);
            const float y = (a.x + a.y + a.z + a.w) + (bq.x + bq.y + bq.z + bq.w) + Dsk * xs[t2 * 32 + p2];
            const size_t row = rowb + c * 16 + t2;
            const float z = bf2f(U[row * DINP + 4096 + head * 64 + ph * 32 + p2]);
            YC[row * 1024 + head * 64 + ph * 32 + p2] = y * siluf_(z);
        }
        __syncthreads();
    }
    float* so = p.out + O_SSP + ((((size_t)l * 8 + b) * 16 + head) * 64 + ph * 32 + pl) * 128;
#pragma unroll
    for (int j = 0; j < 4; ++j) *(float4*)(so + j * 32 + ng * 4) = make_float4(S[j * 4], S[j * 4 + 1], S[j * 4 + 2], S[j * 4 + 3]);
}

DEVINL void hgrn_sample_item(const Params& p, int l, int item, char* lds) {
    const int s = item >> 2, h = item & 3;
    const int tid = threadIdx.x;
    float* qs = (float*)lds; float* fs = qs + 128; float* vs = fs + 128; float* red = vs + 128;
    const u16* Ur = (const u16*)(p.ws + OFF_U) + (size_t)(NP + s) * DINP;
    if (tid < 128) {
        qs[tid] = bf2f(Ur[2048 + h * 128 + tid]);
        const float lb = hgrn_lb(p, l, h * 128 + tid);
        fs[tid] = lb + (1.f - lb) * sigmoidf_(bf2f(Ur[2560 + h * 128 + tid]));
        vs[tid] = bf2f(Ur[3072 + h * 128 + tid]);
    }
    __syncthreads();
    const int v4 = (tid & 31) * 4, kr = tid >> 5;
    const size_t sb = (((size_t)l * NS + s) * 4 + h) * 128 * 128;
    const float* Sin = p.in[I_SHG] + sb;
    float* Sout = p.out + O_HGS + sb;
    const float4 vv = *(const float4*)(vs + v4);
    float4 acc = make_float4(0.f, 0.f, 0.f, 0.f);
#pragma unroll 1
    for (int hb = 0; hb < 2; ++hb) {
        float4 so[8];
#pragma unroll
        for (int i = 0; i < 8; ++i) so[i] = ldnt4(Sin + (size_t)(kr + 8 * (hb * 8 + i)) * 128 + v4);
#pragma unroll
        for (int i = 0; i < 8; ++i) {
            const int k = kr + 8 * (hb * 8 + i);
            const float f = fs[k], kk = 1.f - f, q = qs[k];
            float4 sn;
            sn.x = f * so[i].x + kk * vv.x; sn.y = f * so[i].y + kk * vv.y; sn.z = f * so[i].z + kk * vv.z; sn.w = f * so[i].w + kk * vv.w;
            stnt4(Sout + (size_t)k * 128 + v4, sn);
            acc.x += q * sn.x; acc.y += q * sn.y; acc.z += q * sn.z; acc.w += q * sn.w;
        }
    }
    *(float4*)(red + kr * 128 + v4) = acc;
    __syncthreads();
    if (tid < 128) {
        float o = 0.f;
#pragma unroll
        for (int i = 0; i < 8; ++i) o += red[i * 128 + tid];
        ((u16*)(p.ws + OFF_OB))[(size_t)(NP + s) * 512 + h * 128 + tid] = (u16)f2bf(o);
    }
    __syncthreads();
}

DEVINL void ssd_sample_item(const Params& p, int l, int item) {
    const int s = item >> 4, head = item & 15, g = head >> 3;
    const int tid = threadIdx.x;
    const size_t row = NP + s;
    const float* xr = (const float*)(p.ws + OFF_XBC) + row * 1536;
    const float dt = ((const float*)(p.ws + OFF_DT))[row * 16 + head];
    const float dec = __expf(-__expf(p.in[I_ALOG][l * 16 + head]) * dt);
    const float Dsk = p.in[I_DSK][l * 16 + head];
    const int n4 = (tid & 31) * 4, pr = tid >> 5;
    const float4 Bv = *(const float4*)(xr + 1024 + g * 128 + n4), Cv = *(const float4*)(xr + 1280 + g * 128 + n4);
    const size_t sb = (((size_t)l * NS + s) * 16 + head) * 64 * 128;
    const float* Sin = p.in[I_SSS] + sb;
    float* Sout = p.out + O_SSS + sb;
    const u16* Ur = (const u16*)(p.ws + OFF_U) + row * DINP;
    u16* YC = (u16*)(p.ws + OFF_YC);
    float4 so[8];
#pragma unroll
    for (int i = 0; i < 8; ++i) so[i] = ldnt4(Sin + (size_t)(pr + 8 * i) * 128 + n4);
#pragma unroll
    for (int i = 0; i < 8; ++i) {
        const int pp = pr + 8 * i;
        const float x = xr[head * 64 + pp], xdt = x * dt;
        float4 sn;
        sn.x = dec * so[i].x + xdt * Bv.x; sn.y = dec * so[i].y + xdt * Bv.y; sn.z = dec * so[i].z + xdt * Bv.z; sn.w = dec * so[i].w + xdt * Bv.w;
        stnt4(Sout + (size_t)pp * 128 + n4, sn);
        float a = Cv.x * sn.x + Cv.y * sn.y + Cv.z * sn.z + Cv.w * sn.w;
#pragma unroll
        for (int o = 16; o; o >>= 1) a += __shfl_xor(a, o);
        if ((tid & 31) == 0) {
            const float y = a + Dsk * x;
            const float z = bf2f(Ur[4096 + head * 64 + pp]);
            YC[row * 1024 + head * 64 + pp] = (u16)f2bf(y * siluf_(z));
        }
    }
}


DEVINL bf16x8 ldfrag(const u16* base, int ld, int row, int k) { return *(const bf16x8*)(base + row * ld + k); }
DEVINL void st4bf(u16* dst, float a, float b, float c, float d) { *(uint2*)dst = make_uint2(pack2(a, b), pack2(c, d)); }

DEVINL void ssd_prompt_mfma(const Params& p, int l, int item, char* lds) {
    const int b = item >> 5, head = (item >> 1) & 15, ph = item & 1, g = head >> 3;
    const int tid = threadIdx.x, lane = tid & 63, w = tid >> 6, fr = lane & 15, fq = lane >> 4;
    u16* Cs = (u16*)lds;
    u16* Bs = Cs + 32 * 136;
    u16* Sb = Bs + 32 * 136;
    u16* BT = Sb + 32 * 136;
    u16* XT = BT + 128 * 40;
    u16* XW = XT + 32 * 40;
    u16* Ms = XW + 32 * 40;
    float* csS = (float*)(Ms + 32 * 40);
    float* dtS = csS + 32;
    const u16* XB = (const u16*)(p.ws + OFF_XBCB);
    const float* DT = (const float*)(p.ws + OFF_DT);
    const u16* U = (const u16*)(p.ws + OFF_U);
    u16* YC = (u16*)(p.ws + OFF_YC);
    const float Aneg = -__expf(p.in[I_ALOG][l * 16 + head]);
    const float Dsk = p.in[I_DSK][l * 16 + head];
    const size_t rowb = (size_t)b * SEQ;
    const int srow = tid >> 3, sc = tid & 7;
    const int ti = w >> 1, pi = w & 1;
    for (int i = tid; i < 32 * 136 / 2; i += 256) ((uint32_t*)Sb)[i] = 0u;
    f32x4 Sacc[2][2];
#pragma unroll
    for (int a = 0; a < 2; ++a)
#pragma unroll
        for (int c = 0; c < 2; ++c) Sacc[a][c] = (f32x4){0.f, 0.f, 0.f, 0.f};
    const u16* pC = XB + (rowb + srow) * 1536 + 1280 + g * 128 + sc * 16;
    const u16* pB = XB + (rowb + srow) * 1536 + 1024 + g * 128 + sc * 16;
    const u16* pX = XB + (rowb + srow) * 1536 + head * 64 + ph * 32 + sc * 4;
    const float* pD = DT + (rowb + (lane & 31)) * 16 + head;
    const u16* pZ = U + (rowb + ti * 16 + fr) * DINP + 4096 + head * 64 + ph * 32 + pi * 16 + fq * 4;
    const u16* pXs = XB + (rowb + ti * 16 + fr) * 1536 + head * 64 + ph * 32 + pi * 16 + fq * 4;
#define SSD_LD(S, CC) do { const size_t adv = (size_t)(CC) * 32; \
        S##C0 = *(const uint4*)(pC + adv * 1536); S##C1 = *(const uint4*)(pC + adv * 1536 + 8); \
        S##B0 = *(const uint4*)(pB + adv * 1536); S##B1 = *(const uint4*)(pB + adv * 1536 + 8); \
        S##x = *(const uint2*)(pX + adv * 1536); S##z = *(const uint2*)(pZ + adv * DINP); S##xs = *(const uint2*)(pXs + adv * 1536); \
        S##dt = *(pD + adv * 16); } while (0)
    uint4 aC0, aC1, aB0, aB1, bC0, bC1, bB0, bB1; uint2 ax, az, axs, bx, bz, bxs; float adt, bdt;
    SSD_LD(a, 0); SSD_LD(b, 1);
    auto stage = [&](uint4 rC0, uint4 rC1, uint4 rB0, uint4 rB1, float rdt) __attribute__((always_inline)) {
        *(uint4*)(Cs + srow * 136 + sc * 16) = rC0; *(uint4*)(Cs + srow * 136 + sc * 16 + 8) = rC1;
        *(uint4*)(Bs + srow * 136 + sc * 16) = rB0; *(uint4*)(Bs + srow * 136 + sc * 16 + 8) = rB1;
        {
            const uint32_t bw[8] = {rB0.x, rB0.y, rB0.z, rB0.w, rB1.x, rB1.y, rB1.z, rB1.w};
#pragma unroll
            for (int j = 0; j < 8; ++j) {
                BT[(sc * 16 + 2 * j) * 40 + srow] = (u16)(bw[j] & 0xffffu);
                BT[(sc * 16 + 2 * j + 1) * 40 + srow] = (u16)(bw[j] >> 16);
            }
        }
        if (w == 0) {
            float a = rdt * Aneg;
#pragma unroll
            for (int o = 1; o < 32; o <<= 1) { const float v = __shfl_up(a, o); if ((lane & 31) >= o) a += v; }
            if (lane < 32) { csS[lane] = a; dtS[lane] = rdt; }
        }
    };
    auto rest = [&](int c, uint2 cx, uint2 cz, uint2 cxs) __attribute__((always_inline)) {
        lds_barrier();
        const float cs31 = csS[31];
        {
            const float wgt = dtS[srow] * __expf(cs31 - csS[srow]);
            const float x0 = lo16(cx.x), x1 = hi16(cx.x), x2 = lo16(cx.y), x3 = hi16(cx.y);
            XT[(sc * 4 + 0) * 40 + srow] = (u16)(cx.x & 0xffffu); XT[(sc * 4 + 1) * 40 + srow] = (u16)(cx.x >> 16);
            XT[(sc * 4 + 2) * 40 + srow] = (u16)(cx.y & 0xffffu); XT[(sc * 4 + 3) * 40 + srow] = (u16)(cx.y >> 16);
            XW[(sc * 4 + 0) * 40 + srow] = (u16)f2bf(x0 * wgt); XW[(sc * 4 + 1) * 40 + srow] = (u16)f2bf(x1 * wgt);
            XW[(sc * 4 + 2) * 40 + srow] = (u16)f2bf(x2 * wgt); XW[(sc * 4 + 3) * 40 + srow] = (u16)f2bf(x3 * wgt);
        }
        {
            const int t = ti * 16 + fr, s0 = pi * 16 + fq * 4;
            if (pi <= ti) {
                f32x4 acc = (f32x4){0.f, 0.f, 0.f, 0.f};
#pragma unroll
                for (int ks = 0; ks < 4; ++ks)
                    acc = __builtin_amdgcn_mfma_f32_16x16x32_bf16(ldfrag(Bs, 136, pi * 16 + fr, ks * 32 + fq * 8), ldfrag(Cs, 136, ti * 16 + fr, ks * 32 + fq * 8), acc, 0, 0, 0);
                const float cst = csS[t];
                float m[4];
#pragma unroll
                for (int r = 0; r < 4; ++r) { const int s = s0 + r; m[r] = (s <= t) ? acc[r] * __expf(cst - csS[s]) * dtS[s] : 0.f; }
                st4bf(Ms + t * 40 + s0, m[0], m[1], m[2], m[3]);
            } else {
                *(uint2*)(Ms + t * 40 + s0) = make_uint2(0u, 0u);
            }
        }
        lds_barrier();
        {
            f32x4 ad = __builtin_amdgcn_mfma_f32_16x16x32_bf16(ldfrag(XT, 40, pi * 16 + fr, fq * 8), ldfrag(Ms, 40, ti * 16 + fr, fq * 8), (f32x4){0.f, 0.f, 0.f, 0.f}, 0, 0, 0);
            f32x4 ao = (f32x4){0.f, 0.f, 0.f, 0.f};
#pragma unroll
            for (int ks = 0; ks < 4; ++ks)
                ao = __builtin_amdgcn_mfma_f32_16x16x32_bf16(ldfrag(Sb, 136, pi * 16 + fr, ks * 32 + fq * 8), ldfrag(Cs, 136, ti * 16 + fr, ks * 32 + fq * 8), ao, 0, 0, 0);
            const int t = ti * 16 + fr;
            const float e = __expf(csS[t]);
            const float xs0 = lo16(cxs.x), xs1 = hi16(cxs.x), xs2 = lo16(cxs.y), xs3 = hi16(cxs.y);
            const float z0 = lo16(cz.x), z1 = hi16(cz.x), z2 = lo16(cz.y), z3 = hi16(cz.y);
            float4 y;
            y.x = (ad[0] + e * ao[0] + Dsk * xs0) * siluf_(z0);
            y.y = (ad[1] + e * ao[1] + Dsk * xs1) * siluf_(z1);
            y.z = (ad[2] + e * ao[2] + Dsk * xs2) * siluf_(z2);
            y.w = (ad[3] + e * ao[3] + Dsk * xs3) * siluf_(z3);
            *(uint2*)(YC + (rowb + (size_t)c * 32 + t) * 1024 + head * 64 + ph * 32 + pi * 16 + fq * 4) = make_uint2(pack2(y.x, y.y), pack2(y.z, y.w));
        }
        {
            const float e31 = __expf(cs31);
#pragma unroll
            for (int a = 0; a < 2; ++a) {
                const bf16x8 bt = ldfrag(BT, 40, (2 * w + a) * 16 + fr, fq * 8);
#pragma unroll
                for (int pt = 0; pt < 2; ++pt) {
                    f32x4 s = Sacc[a][pt];
                    s[0] *= e31; s[1] *= e31; s[2] *= e31; s[3] *= e31;
                    Sacc[a][pt] = __builtin_amdgcn_mfma_f32_16x16x32_bf16(bt, ldfrag(XW, 40, pt * 16 + fr, fq * 8), s, 0, 0, 0);
                }
            }
        }
        lds_barrier();
#pragma unroll
        for (int a = 0; a < 2; ++a)
#pragma unroll
            for (int pt = 0; pt < 2; ++pt)
                st4bf(Sb + (pt * 16 + fr) * 136 + (2 * w + a) * 16 + fq * 4, Sacc[a][pt][0], Sacc[a][pt][1], Sacc[a][pt][2], Sacc[a][pt][3]);
    };
#pragma unroll 1
    for (int c = 0; c < SEQ / 32; c += 2) {
        { stage(aC0, aC1, aB0, aB1, adt); const uint2 cx = ax, cz = az, cxs = axs; if (c + 2 < SEQ / 32) SSD_LD(a, c + 2); rest(c, cx, cz, cxs); }
        { stage(bC0, bC1, bB0, bB1, bdt); const uint2 cx = bx, cz = bz, cxs = bxs; if (c + 3 < SEQ / 32) SSD_LD(b, c + 3); rest(c + 1, cx, cz, cxs); }
    }
#undef SSD_LD
    float* so = p.out + O_SSP + ((((size_t)l * 8 + b) * 16 + head) * 64 + ph * 32) * 128;
#pragma unroll
    for (int a = 0; a < 2; ++a)
#pragma unroll
        for (int pt = 0; pt < 2; ++pt)
            *(float4*)(so + (size_t)(pt * 16 + fr) * 128 + (2 * w + a) * 16 + fq * 4) = make_float4(Sacc[a][pt][0], Sacc[a][pt][1], Sacc[a][pt][2], Sacc[a][pt][3]);
    __syncthreads();
}

DEVINL void hgrn_prompt_mfma(const Params& p, int l, int item, char* lds) {
    const int b = item >> 4, h = (item >> 2) & 3, vq = item & 3;
    const int tid = threadIdx.x, lane = tid & 63, w = tid >> 6, fr = lane & 15, fq = lane >> 4;
    u16* Qg = (u16*)lds;
    u16* Qm = Qg + 32 * 136;
    u16* Km = Qm + 32 * 136;
    u16* ST = Km + 32 * 136;
    u16* KdT = ST + 32 * 136;
    u16* VT = KdT + 128 * 40;
    u16* As = VT + 32 * 40;
    float* dS = (float*)(As + 32 * 40);
    const u16* U = (const u16*)(p.ws + OFF_U);
    u16* OB = (u16*)(p.ws + OFF_OB);
    const size_t rowb = (size_t)b * SEQ;
    const size_t u0 = (size_t)(b * 4 + h) * 64;
    const u16* gQG = (const u16*)(p.ws + OFF_HQG) + u0 * 4096;
    const u16* gQM = (const u16*)(p.ws + OFF_HQM) + u0 * 4096;
    const u16* gKM = (const u16*)(p.ws + OFF_HKM) + u0 * 4096;
    const u16* gKD = (const u16*)(p.ws + OFF_HKD) + u0 * 4096;
    const float* gDS = (const float*)(p.ws + OFF_HDS) + u0 * 128;
    const int vrow = tid >> 3, v4 = (tid & 7) * 4;
    const int ti = w >> 1, ji = w & 1;
    const int r0 = tid >> 4, c0 = (tid & 15) * 8;
    const int k0 = tid >> 2, p0 = (tid & 3) * 8;
    for (int i = tid; i < 32 * 136 / 2; i += 256) ((uint32_t*)ST)[i] = 0u;
    f32x4 Sacc[2][2];
#pragma unroll
    for (int a = 0; a < 2; ++a)
#pragma unroll
        for (int c = 0; c < 2; ++c) Sacc[a][c] = (f32x4){0.f, 0.f, 0.f, 0.f};
    const u16* pV = U + (rowb + vrow) * DINP + 3072 + h * 128 + vq * 32 + v4;
    const int gi0 = r0 * 128 + c0, gi1 = (r0 + 16) * 128 + c0, gk0 = k0 * 32 + p0, gk1 = (k0 + 64) * 32 + p0;
    const int li0 = r0 * 136 + c0, li1 = (r0 + 16) * 136 + c0, lk0 = k0 * 40 + p0, lk1 = (k0 + 64) * 40 + p0;
#define HG_LD(S, CC) do { const size_t au = (size_t)(CC) * 4096; \
        S##g0 = *(const uint4*)(gQG + au + gi0); S##g1 = *(const uint4*)(gQG + au + gi1); S##m0 = *(const uint4*)(gQM + au + gi0); S##m1 = *(const uint4*)(gQM + au + gi1); \
        S##k0 = *(const uint4*)(gKM + au + gi0); S##k1 = *(const uint4*)(gKM + au + gi1); S##d0 = *(const uint4*)(gKD + au + gk0); S##d1 = *(const uint4*)(gKD + au + gk1); \
        S##ds = *(const float4*)(gDS + (size_t)(CC) * 128 + (tid & 31) * 4); S##v = *(const uint2*)(pV + (size_t)(CC) * 32 * DINP); } while (0)
    uint4 ag0, ag1, am0, am1, ak0, ak1, ad0, ad1, bg0, bg1, bm0, bm1, bk0, bk1, bd0, bd1; float4 ads, bds; uint2 av, bv;
    HG_LD(a, 0); HG_LD(b, 1);
    auto stage = [&](uint4 g0, uint4 g1, uint4 m0, uint4 m1, uint4 kk0, uint4 kk1, uint4 d0, uint4 d1, float4 ds, uint2 rv) __attribute__((always_inline)) {
        *(uint4*)(Qg + li0) = g0; *(uint4*)(Qg + li1) = g1; *(uint4*)(Qm + li0) = m0; *(uint4*)(Qm + li1) = m1;
        *(uint4*)(Km + li0) = kk0; *(uint4*)(Km + li1) = kk1; *(uint4*)(KdT + lk0) = d0; *(uint4*)(KdT + lk1) = d1;
        if (tid < 32) *(float4*)(dS + tid * 4) = ds;
        VT[(v4 + 0) * 40 + vrow] = (u16)(rv.x & 0xffffu); VT[(v4 + 1) * 40 + vrow] = (u16)(rv.x >> 16);
        VT[(v4 + 2) * 40 + vrow] = (u16)(rv.y & 0xffffu); VT[(v4 + 3) * 40 + vrow] = (u16)(rv.y >> 16);
    };
    auto rest = [&](int c) __attribute__((always_inline)) {
        lds_barrier();
        {
            const int t = ti * 16 + fr, j0 = ji * 16 + fq * 4;
            if (ji <= ti) {
                f32x4 acc = (f32x4){0.f, 0.f, 0.f, 0.f};
#pragma unroll
                for (int ks = 0; ks < 4; ++ks)
                    acc = __builtin_amdgcn_mfma_f32_16x16x32_bf16(ldfrag(Km, 136, ji * 16 + fr, ks * 32 + fq * 8), ldfrag(Qm, 136, ti * 16 + fr, ks * 32 + fq * 8), acc, 0, 0, 0);
                st4bf(As + t * 40 + j0, (j0 + 0 <= t) ? acc[0] : 0.f, (j0 + 1 <= t) ? acc[1] : 0.f, (j0 + 2 <= t) ? acc[2] : 0.f, (j0 + 3 <= t) ? acc[3] : 0.f);
            } else {
                *(uint2*)(As + t * 40 + j0) = make_uint2(0u, 0u);
            }
        }
        lds_barrier();
        {
            const int vi = ji;
            f32x4 acc = __builtin_amdgcn_mfma_f32_16x16x32_bf16(ldfrag(VT, 40, vi * 16 + fr, fq * 8), ldfrag(As, 40, ti * 16 + fr, fq * 8), (f32x4){0.f, 0.f, 0.f, 0.f}, 0, 0, 0);
#pragma unroll
            for (int ks = 0; ks < 4; ++ks)
                acc = __builtin_amdgcn_mfma_f32_16x16x32_bf16(ldfrag(ST, 136, vi * 16 + fr, ks * 32 + fq * 8), ldfrag(Qg, 136, ti * 16 + fr, ks * 32 + fq * 8), acc, 0, 0, 0);
            *(uint2*)(OB + (rowb + (size_t)c * 32 + ti * 16 + fr) * 512 + h * 128 + vq * 32 + vi * 16 + fq * 4) = make_uint2(pack2(acc[0], acc[1]), pack2(acc[2], acc[3]));
        }
#pragma unroll
        for (int a = 0; a < 2; ++a) {
            const int kt = 2 * w + a;
            const bf16x8 kf = ldfrag(KdT, 40, kt * 16 + fr, fq * 8);
            const float4 dd = *(const float4*)(dS + kt * 16 + fq * 4);
#pragma unroll
            for (int vt = 0; vt < 2; ++vt) {
                f32x4 s = Sacc[a][vt];
                s[0] *= dd.x; s[1] *= dd.y; s[2] *= dd.z; s[3] *= dd.w;
                Sacc[a][vt] = __builtin_amdgcn_mfma_f32_16x16x32_bf16(kf, ldfrag(VT, 40, vt * 16 + fr, fq * 8), s, 0, 0, 0);
            }
        }
        lds_barrier();
#pragma unroll
        for (int a = 0; a < 2; ++a)
#pragma unroll
            for (int vt = 0; vt < 2; ++vt)
                st4bf(ST + (vt * 16 + fr) * 136 + (2 * w + a) * 16 + fq * 4, Sacc[a][vt][0], Sacc[a][vt][1], Sacc[a][vt][2], Sacc[a][vt][3]);
    };
#pragma unroll 1
    for (int c = 0; c < SEQ / 32; c += 2) {
        stage(ag0, ag1, am0, am1, ak0, ak1, ad0, ad1, ads, av); if (c + 2 < SEQ / 32) HG_LD(a, c + 2); rest(c);
        stage(bg0, bg1, bm0, bm1, bk0, bk1, bd0, bd1, bds, bv); if (c + 3 < SEQ / 32) HG_LD(b, c + 3); rest(c + 1);
    }
#undef HG_LD
    float* so = p.out + O_HGP + (((size_t)l * 8 + b) * 4 + h) * 128 * 128;
#pragma unroll
    for (int a = 0; a < 2; ++a)
#pragma unroll
        for (int vt = 0; vt < 2; ++vt)
#pragma unroll
            for (int r = 0; r < 4; ++r)
                so[(size_t)((2 * w + a) * 16 + fq * 4 + r) * 128 + vq * 32 + vt * 16 + fr] = Sacc[a][vt][r];
    __syncthreads();
}

DEVINL int scan_next_item(unsigned* ctr, int* slot) {
    __syncthreads();
    if (threadIdx.x == 0) *slot = (int)gridDim.x + (int)__hip_atomic_fetch_add(ctr, 1u, __ATOMIC_RELAXED, __HIP_MEMORY_SCOPE_AGENT);
    __syncthreads();
    return *slot;
}
DEVINL void phase_scan(const Params& p, int l, char* lds) {
    unsigned* ctr = (unsigned*)(p.ws + OFF_BAR) + 3520 + l * 64;
    __shared__ int nxt_item;
    int it = blockIdx.x;
#pragma unroll 1
    while (it < 256) { ssd_prompt_mfma(p, l, it, lds); it = scan_next_item(ctr, &nxt_item); }
#pragma unroll 1
    while (it < 384) { hgrn_prompt_mfma(p, l, it - 256, lds); it = scan_next_item(ctr, &nxt_item); }
#pragma unroll 1
    while (it < 896) { hgrn_sample_item(p, l, it - 384, lds); it = scan_next_item(ctr, &nxt_item); }
#pragma unroll 1
    while (it < 2944) { ssd_sample_item(p, l, it - 896); it = scan_next_item(ctr, &nxt_item); }
}

DEVINL void phase_mixnorm(const Params& p, int l) {
    const int wave = threadIdx.x >> 6, lane = threadIdx.x & 63;
    const u16* OB = (const u16*)(p.ws + OFF_OB);
    const u16* YC = (const u16*)(p.ws + OFF_YC);
    const u16* U = (const u16*)(p.ws + OFF_U);
    u16* Ycat = (u16*)(p.ws + OFF_YCAT);
    const float* gn = p.in[I_HGN] + (size_t)l * 512;
    const float* sn = p.in[I_SNORM] + (size_t)l * 1024;
    for (int it = blockIdx.x; it < NR / 4; it += gridDim.x) {
        const size_t r = (size_t)it * 4 + wave;
        {
            const uint4 ov = *(const uint4*)(OB + r * 512 + lane * 8);
            float x[8]; UNPACK8(ov, x);
            float ss = 0.f;
#pragma unroll
            for (int i = 0; i < 8; ++i) ss += x[i] * x[i];
            ss += __shfl_xor(ss, 1); ss += __shfl_xor(ss, 2); ss += __shfl_xor(ss, 4); ss += __shfl_xor(ss, 8);
            const float rstd = rsqrtf(ss * (1.0f / 128.0f) + EPS);
            const uint4 zz = *(const uint4*)(U + r * DINP + 3584 + lane * 8);
            float z[8]; UNPACK8(zz, z);
            const float4 g0 = *(const float4*)(gn + lane * 8), g1 = *(const float4*)(gn + lane * 8 + 4);
            const float gg[8] = {g0.x, g0.y, g0.z, g0.w, g1.x, g1.y, g1.z, g1.w};
            float y[8];
#pragma unroll
            for (int i = 0; i < 8; ++i) y[i] = x[i] * rstd * gg[i] * siluf_(z[i]);
            *(uint4*)(Ycat + r * 2048 + 512 + lane * 8) = make_uint4(pack2(y[0], y[1]), pack2(y[2], y[3]), pack2(y[4], y[5]), pack2(y[6], y[7]));
        }
        {
            float x[16];
#pragma unroll
            for (int h = 0; h < 2; ++h) {
                const uint4 yv = *(const uint4*)(YC + r * 1024 + h * 512 + lane * 8);
                x[h * 8 + 0] = lo16(yv.x); x[h * 8 + 1] = hi16(yv.x); x[h * 8 + 2] = lo16(yv.y); x[h * 8 + 3] = hi16(yv.y); x[h * 8 + 4] = lo16(yv.z); x[h * 8 + 5] = hi16(yv.z); x[h * 8 + 6] = lo16(yv.w); x[h * 8 + 7] = hi16(yv.w);
            }
            float ss = 0.f;
#pragma unroll
            for (int i = 0; i < 16; ++i) ss += x[i] * x[i];
            ss = wave_sum(ss);
            const float rstd = rsqrtf(ss * (1.0f / 1024.0f) + EPS);
#pragma unroll
            for (int h = 0; h < 2; ++h) {
                const float4 g0 = *(const float4*)(sn + h * 512 + lane * 8), g1 = *(const float4*)(sn + h * 512 + lane * 8 + 4);
                uint4 o;
                o.x = pack2(x[h * 8 + 0] * rstd * g0.x, x[h * 8 + 1] * rstd * g0.y);
                o.y = pack2(x[h * 8 + 2] * rstd * g0.z, x[h * 8 + 3] * rstd * g0.w);
                o.z = pack2(x[h * 8 + 4] * rstd * g1.x, x[h * 8 + 5] * rstd * g1.y);
                o.w = pack2(x[h * 8 + 6] * rstd * g1.z, x[h * 8 + 7] * rstd * g1.w);
                *(uint4*)(Ycat + r * 2048 + 1024 + h * 512 + lane * 8) = o;
            }
        }
    }
}

DEVINL void phase_rowpass(const Params& p, int l, int which) {
    const int wave = threadIdx.x >> 6, lane = threadIdx.x & 63;
    float* X = (float*)(p.ws + OFF_X);
    const u16* T = (const u16*)(p.ws + OFF_T);
    u16* Hb = (u16*)(p.ws + OFF_HB);
    u16* Mb = (u16*)(p.ws + OFF_MB);
    const bool last = (which == 1 && l == 1);
    const float* gpost = p.in[which == 0 ? I_GQM : I_GQX] + (size_t)l * 1024;
    const float* gnext = which == 0 ? p.in[I_GPX] + (size_t)l * 1024 : (last ? nullptr : p.in[I_GPM] + (size_t)(l + 1) * 1024);
    const int nrows = (which == 1 && !last) ? NR + 2048 : NR;
    for (int it = blockIdx.x; it < nrows / 4; it += gridDim.x) {
        const int r = it * 4 + wave;
        if (r < NR) {
            float* xd = X + (size_t)r * 1024;
            if (last) xd = r < NP ? p.out + O_YP + (size_t)r * 1024 : p.out + O_YS + (size_t)(r - NP) * 1024;
            const float* xb = X + (size_t)r * 1024;
            if (which == 0 && l == 0) xb = r < NP ? p.in[I_XP] + (size_t)r * 1024 : p.in[I_XS] + (size_t)(r - NP) * 1024;
            rowpass_row(xb, T + (size_t)r * 1024, gpost, xd, gnext, Hb + (size_t)r * 1024, lane, last);
        } else {
            const int m = r - NR;
            rowpass_row(p.in[I_MEM] + (size_t)m * 1024, nullptr, nullptr, nullptr, p.in[I_GMEM] + (size_t)(l + 1) * 1024, Mb + (size_t)m * 1024, lane);
        }
    }
}

DEVINL void attn_prompt_item(const Params& p, int item, char* lds) {
    const int b = item >> 6, h = (item >> 4) & 3, qt = item & 15;
    const int tid = threadIdx.x, lane = tid & 63, wave = tid >> 6;
    const u16* Qt = (const u16*)(p.ws + OFF_Q) + ((size_t)b * SEQ + qt * 128) * 1024 + h * 256;
    const u16* Kb = (const u16*)(p.ws + OFF_MK) + (size_t)b * 256 * 1024 + h * 256;
    const u16* Vt = (const u16*)(p.ws + OFF_MVT) + (size_t)(b * 4 + h) * 256 * 256;
    float* Ss = (float*)(p.ws + OFF_SCR + (size_t)blockIdx.x * SCR_PER_BLOCK);
    u16* Ps = (u16*)((char*)Ss + 128 * 256 * 4);
    u16* Ob = (u16*)(p.ws + OFF_O) + ((size_t)b * SEQ + qt * 128) * 1024 + h * 256;
#pragma unroll 1
    for (int nt = 0; nt < 2; ++nt)
        gemm_tile1(Qt, 1024, Kb + (size_t)nt * 128 * 1024, 1024, 256, lds,
                  [&](int r, int c, f32x4 v) { *(float4*)(Ss + r * 256 + nt * 128 + c) = make_float4(v[0] * 0.0625f, v[1] * 0.0625f, v[2] * 0.0625f, v[3] * 0.0625f); });
    __syncthreads();
    for (int i = 0; i < 32; ++i) {
        const int r = wave * 32 + i;
        const float4 x = *(const float4*)(Ss + r * 256 + lane * 4);
        const float m = wave_max(fmaxf(fmaxf(x.x, x.y), fmaxf(x.z, x.w)));
        const float e0 = __expf(x.x - m), e1 = __expf(x.y - m), e2 = __expf(x.z - m), e3 = __expf(x.w - m);
        const float inv = 1.0f / wave_sum(e0 + e1 + e2 + e3);
        *(uint2*)(Ps + r * 256 + lane * 4) = make_uint2(pack2(e0 * inv, e1 * inv), pack2(e2 * inv, e3 * inv));
    }
    __syncthreads();
#pragma unroll 1
    for (int nt = 0; nt < 2; ++nt)
        gemm_tile1(Ps, 256, Vt + (size_t)nt * 128 * 256, 256, 256, lds,
                  [&](int r, int c, f32x4 v) { *(uint2*)(Ob + (size_t)r * 1024 + nt * 128 + c) = make_uint2(pack2(v[0], v[1]), pack2(v[2], v[3])); });
    __syncthreads();
}


DEVINL void attn_prompt_item2(const Params& p, int item, char* lds) {
    const int b = item >> 7, h = (item >> 5) & 3, qt = item & 31;
    const int tid = threadIdx.x, lane = tid & 63, w = tid >> 6, fr = lane & 15, fq = lane >> 4;
    char* Kbuf = lds;
    char* Vbuf = lds + 33792;
    const size_t qrow = (size_t)b * SEQ + qt * 64 + w * 16 + fr;
    const u16* Qp = (const u16*)(p.ws + OFF_Q) + qrow * 1024 + h * 256 + fq * 8;
    const int krow = tid >> 5, kch = tid & 31;
    const u16* Kg = (const u16*)(p.ws + OFF_MK) + ((size_t)b * 256 + krow) * 1024 + h * 256 + kch * 8;
    const int klds = krow * 528 + kch * 16;
    const int vrow = tid >> 2, vch = tid & 3;
    const u16* Vg = (const u16*)(p.ws + OFF_MVT) + ((size_t)(b * 4 + h) * 256 + vrow) * 256 + vch * 8;
    const int vlds = vrow * 80 + vch * 16;
    bf16x8 qf[8];
#pragma unroll
    for (int ks = 0; ks < 8; ++ks) qf[ks] = *(const bf16x8*)(Qp + ks * 32);
    uint4 r0, r1, r2, r3, r4, r5, r6, r7;
#define KLOAD(KB) do { const u16* g_ = Kg + (size_t)(KB) * 64 * 1024; \
        r0 = *(const uint4*)(g_); r1 = *(const uint4*)(g_ + 8 * 1024); r2 = *(const uint4*)(g_ + 16 * 1024); r3 = *(const uint4*)(g_ + 24 * 1024); \
        r4 = *(const uint4*)(g_ + 32 * 1024); r5 = *(const uint4*)(g_ + 40 * 1024); r6 = *(const uint4*)(g_ + 48 * 1024); r7 = *(const uint4*)(g_ + 56 * 1024); } while (0)
#define KSTORE() do { char* d_ = Kbuf + klds; \
        *(uint4*)(d_) = r0; *(uint4*)(d_ + 8 * 528) = r1; *(uint4*)(d_ + 16 * 528) = r2; *(uint4*)(d_ + 24 * 528) = r3; \
        *(uint4*)(d_ + 32 * 528) = r4; *(uint4*)(d_ + 40 * 528) = r5; *(uint4*)(d_ + 48 * 528) = r6; *(uint4*)(d_ + 56 * 528) = r7; } while (0)
#define VLOAD(VB) do { const u16* g_ = Vg + (VB) * 32; \
        r0 = *(const uint4*)(g_); r1 = *(const uint4*)(g_ + 64 * 256); r2 = *(const uint4*)(g_ + 128 * 256); r3 = *(const uint4*)(g_ + 192 * 256); } while (0)
#define VSTORE() do { char* d_ = Vbuf + vlds; \
        *(uint4*)(d_) = r0; *(uint4*)(d_ + 64 * 80) = r1; *(uint4*)(d_ + 128 * 80) = r2; *(uint4*)(d_ + 192 * 80) = r3; } while (0)
    f32x4 sacc[16];
    KLOAD(0);
#pragma unroll
    for (int kb = 0; kb < 4; ++kb) {
        KSTORE();
        if (kb < 3) KLOAD(kb + 1); else VLOAD(0);
        lds_barrier();
#pragma unroll
        for (int kl = 0; kl < 4; ++kl) {
            f32x4 acc = (f32x4){0.f, 0.f, 0.f, 0.f};
#pragma unroll
            for (int ks = 0; ks < 8; ++ks)
                acc = __builtin_amdgcn_mfma_f32_16x16x32_bf16(*(const bf16x8*)(Kbuf + (kl * 16 + fr) * 528 + (ks * 32 + fq * 8) * 2), qf[ks], acc, 0, 0, 0);
            sacc[kb * 4 + kl] = acc;
        }
        lds_barrier();
    }
    float m = -3.0e38f;
#pragma unroll
    for (int kt = 0; kt < 16; ++kt) m = fmaxf(m, fmaxf(fmaxf(sacc[kt][0], sacc[kt][1]), fmaxf(sacc[kt][2], sacc[kt][3])));
    m = fmaxf(m, __shfl_xor(m, 16)); m = fmaxf(m, __shfl_xor(m, 32));
    float sum = 0.f;
#pragma unroll
    for (int kt = 0; kt < 16; ++kt)
#pragma unroll
        for (int r = 0; r < 4; ++r) { const float e = __expf((sacc[kt][r] - m) * 0.0625f); sacc[kt][r] = e; sum += e; }
    sum += __shfl_xor(sum, 16); sum += __shfl_xor(sum, 32);
    const float inv = __builtin_amdgcn_rcpf(sum);
    bf16x8 pf[8];
#pragma unroll
    for (int ks = 0; ks < 8; ++ks) {
        uint4 u;
        u.x = pack2(sacc[2 * ks][0] * inv, sacc[2 * ks][1] * inv); u.y = pack2(sacc[2 * ks][2] * inv, sacc[2 * ks][3] * inv);
        u.z = pack2(sacc[2 * ks + 1][0] * inv, sacc[2 * ks + 1][1] * inv); u.w = pack2(sacc[2 * ks + 1][2] * inv, sacc[2 * ks + 1][3] * inv);
        pf[ks] = __builtin_bit_cast(bf16x8, u);
    }
    f32x4 oacc[16];
#pragma unroll
    for (int dt = 0; dt < 16; ++dt) oacc[dt] = (f32x4){0.f, 0.f, 0.f, 0.f};
#pragma unroll
    for (int vb = 0; vb < 8; ++vb) {
        VSTORE();
        if (vb < 7) VLOAD(vb + 1);
        lds_barrier();
#pragma unroll
        for (int dt = 0; dt < 16; ++dt) {
            const uint2 lo = *(const uint2*)(Vbuf + (dt * 16 + fr) * 80 + fq * 8), hi = *(const uint2*)(Vbuf + (dt * 16 + fr) * 80 + fq * 8 + 32);
            const uint4 u = make_uint4(lo.x, lo.y, hi.x, hi.y);
            oacc[dt] = __builtin_amdgcn_mfma_f32_16x16x32_bf16(__builtin_bit_cast(bf16x8, u), pf[vb], oacc[dt], 0, 0, 0);
        }
        lds_barrier();
    }
#undef KLOAD
#undef KSTORE
#undef VLOAD
#undef VSTORE
    {
        char* img = lds + w * 8448 + fr * 528 + fq * 8;
#pragma unroll
        for (int dt = 0; dt < 16; ++dt)
            *(uint2*)(img + dt * 32) = make_uint2(pack2(oacc[dt][0], oacc[dt][1]), pack2(oacc[dt][2], oacc[dt][3]));
        const char* rd = lds + w * 8448 + (lane >> 5) * 528 + (lane & 31) * 16;
        u16* o0 = (u16*)(p.ws + OFF_O) + ((size_t)b * SEQ + qt * 64 + w * 16 + (lane >> 5)) * 1024 + h * 256 + (lane & 31) * 8;
#pragma unroll
        for (int it = 0; it < 8; ++it) *(uint4*)(o0 + (size_t)it * 2048) = *(const uint4*)(rd + it * 1056);
    }
    lds_barrier();
}

DEVINL void attn_sample_item(const Params& p, int l, int item, char* lds) {
    const int s = item >> 2, h = item & 3;
    const int tid = threadIdx.x, lane = tid & 63, wave = tid >> 6;
    float* sc = (float*)lds;
    float* red = sc + 256;
    float* wred = red + 1024;
    const int rsub = lane >> 4, part = lane & 15;
    const u16* qp = (const u16*)(p.ws + OFF_Q) + (size_t)(NP + s) * 1024 + h * 256 + part * 4;
    float qv[16];
#pragma unroll
    for (int j = 0; j < 4; ++j) {
        const uint2 qq = *(const uint2*)(qp + j * 64);
        qv[j * 4 + 0] = lo16(qq.x); qv[j * 4 + 1] = hi16(qq.x); qv[j * 4 + 2] = lo16(qq.y); qv[j * 4 + 3] = hi16(qq.y);
    }
    const size_t cb0 = (((size_t)l * NS + s) * 256) * 1024 + h * 256;
    const float* Kc = p.in[I_CK] + cb0 + part * 4;
    const float* Vc = p.in[I_CV] + cb0 + lane * 4;
#pragma unroll 1
    for (int i = 0; i < 4; ++i) {
        float4 kv[4][4];
#pragma unroll
        for (int pp = 0; pp < 4; ++pp)
#pragma unroll
            for (int j = 0; j < 4; ++j) kv[pp][j] = ldnt4(Kc + (size_t)(wave * 64 + (i * 4 + pp) * 4 + rsub) * 1024 + j * 64);
#pragma unroll
        for (int pp = 0; pp < 4; ++pp) {
            float d = 0.f;
#pragma unroll
            for (int j = 0; j < 4; ++j) d += kv[pp][j].x * qv[j * 4] + kv[pp][j].y * qv[j * 4 + 1] + kv[pp][j].z * qv[j * 4 + 2] + kv[pp][j].w * qv[j * 4 + 3];
            d += __shfl_xor(d, 1); d += __shfl_xor(d, 2); d += __shfl_xor(d, 4); d += __shfl_xor(d, 8);
            if (part == 0) sc[wave * 64 + (i * 4 + pp) * 4 + rsub] = d * 0.0625f;
        }
    }
    __syncthreads();
    const float x = sc[tid];
    const float wm = wave_max(x);
    if (lane == 0) wred[wave] = wm;
    __syncthreads();
    const float m = fmaxf(fmaxf(wred[0], wred[1]), fmaxf(wred[2], wred[3]));
    const float e = __expf(x - m);
    const float ws_ = wave_sum(e);
    if (lane == 0) wred[4 + wave] = ws_;
    __syncthreads();
    const float inv = 1.0f / (wred[4] + wred[5] + wred[6] + wred[7]);
    sc[tid] = e * inv;
    __syncthreads();
    float4 acc = make_float4(0.f, 0.f, 0.f, 0.f);
#pragma unroll 1
    for (int i = 0; i < 4; ++i) {
        float4 vv[16];
#pragma unroll
        for (int j = 0; j < 16; ++j) vv[j] = ldnt4(Vc + (size_t)(wave * 64 + i * 16 + j) * 1024);
#pragma unroll
        for (int j = 0; j < 16; ++j) {
            const float pw = sc[wave * 64 + i * 16 + j];
            acc.x += pw * vv[j].x; acc.y += pw * vv[j].y; acc.z += pw * vv[j].z; acc.w += pw * vv[j].w;
        }
    }
    *(float4*)(red + wave * 256 + lane * 4) = acc;
    __syncthreads();
    {
        const float o = red[tid] + red[256 + tid] + red[512 + tid] + red[768 + tid];
        ((u16*)(p.ws + OFF_O))[(size_t)(NP + s) * 1024 + h * 256 + tid] = (u16)f2bf(o);
    }
    __syncthreads();
}

DEVINL void phase_attn(const Params& p, int l, char* lds) {
    const int G = gridDim.x;
    const bool sample_first = (int)blockIdx.x >= (G >> 1);
#pragma unroll 1
    for (int pass = 0; pass < 2; ++pass) {
        const bool do_sample = (pass == 0) == sample_first;
        if (do_sample) {
#pragma unroll 1
            for (int it = blockIdx.x; it < 512; it += G) attn_sample_item(p, l, it, lds);
        } else {
#pragma unroll 1
            for (int it = blockIdx.x; it < 1024; it += G) attn_prompt_item2(p, it, lds);
        }
    }
}

#define XB_TMO      128
#define XB_XCNT(j)  (256  + 64 * (j))
#define XB_XSUB(j)  (1280 + 64 * (j))
#define XB_XGEN(j)  (2304 + 64 * (j))
#define XB_TOP      3328
#define XB_TOPGEN   3392
#define XCD_BAR_WORDS 3456
#define XB_SPIN_CAP (1u << 22)
#define LAS __attribute__((address_space(3)))
DEVINL unsigned xb_ld(unsigned* p) { return __hip_atomic_load(p, __ATOMIC_RELAXED, __HIP_MEMORY_SCOPE_AGENT); }
DEVINL unsigned xb_add(unsigned* p, unsigned v) { return __hip_atomic_fetch_add(p, v, __ATOMIC_RELAXED, __HIP_MEMORY_SCOPE_AGENT); }
DEVINL unsigned xb_xcc_id() { return (unsigned)__builtin_amdgcn_s_getreg((3 << 11) | 20) & 0xFu; }
#define XB_SPIN(cond, bar) do { unsigned _sp = 0; while (cond) { __builtin_amdgcn_s_sleep(1); \
    if ((++_sp & 255u) == 0u) { if (xb_ld(&(bar)[XB_TMO])) break; if (_sp > XB_SPIN_CAP) { atomicAdd(&(bar)[XB_TMO], 1u); break; } } } } while (0)
struct XcdBarrier { unsigned* bar; unsigned x; volatile LAS unsigned* st; };
DEVINL XcdBarrier xcd_barrier_post(unsigned* bar, volatile LAS unsigned* st) {
    XcdBarrier b; b.bar = bar; b.x = xb_xcc_id(); b.st = st;
    if (threadIdx.x == 0) (void)xb_add(&bar[XB_XCNT(b.x)], 1u);
    return b;
}
DEVINL void xcd_barrier_complete(unsigned* bar, unsigned x, unsigned& nloc, unsigned& nx) {
    const unsigned G = gridDim.x * gridDim.y * gridDim.z;
    unsigned sum, cnt, mine, sp = 0u;
    for (;;) {
        sum = 0u; cnt = 0u; mine = 0u;
#pragma unroll
        for (unsigned j = 0; j < 16; ++j) { const unsigned c = xb_ld(&bar[XB_XCNT(j)]); sum += c; cnt += (c > 0u) ? 1u : 0u; mine = (j == x) ? c : mine; }
        if (sum == G) break;
        __builtin_amdgcn_s_sleep(1);
        if ((++sp & 255u) == 0u) { if (xb_ld(&bar[XB_TMO])) break; if (sp > XB_SPIN_CAP) { atomicAdd(&bar[XB_TMO], 1u); break; } }
    }
    nloc = mine > 0u ? mine : 1u; nx = cnt > 0u ? cnt : 1u;
}
DEVINL void xcd_barrier(const XcdBarrier& b) {
    asm volatile("s_waitcnt vmcnt(0)" ::: "memory");
    __syncthreads();
    if (threadIdx.x == 0) {
        unsigned* bar = b.bar;
        __builtin_amdgcn_s_waitcnt(0);
        unsigned nloc = b.st[0], nx = b.st[1];
        if (nloc == 0u) { xcd_barrier_complete(bar, b.x, nloc, nx); b.st[0] = nloc; b.st[1] = nx; }
        const unsigned old = xb_add(&bar[XB_XSUB(b.x)], 1u);
        const unsigned gen = old / nloc;
        if (old + 1u == (gen + 1u) * nloc) {
            __builtin_amdgcn_fence(__ATOMIC_RELEASE, "agent");
            asm volatile("s_waitcnt vmcnt(0)" ::: "memory");
            const unsigned og = xb_add(&bar[XB_TOP], 1u);
            const unsigned tg = og / nx;
            if (og + 1u == (tg + 1u) * nx) xb_add(&bar[XB_TOPGEN], 1u);
            else XB_SPIN(xb_ld(&bar[XB_TOPGEN]) == tg, bar);
            __builtin_amdgcn_fence(__ATOMIC_ACQUIRE, "agent");
            xb_add(&bar[XB_XGEN(b.x)], 1u);
            asm volatile("s_waitcnt vmcnt(0)" ::: "memory");
        } else {
            XB_SPIN(xb_ld(&bar[XB_XGEN(b.x)]) == gen, bar);
            __builtin_amdgcn_fence(__ATOMIC_ACQUIRE, "agent");
            asm volatile("s_waitcnt vmcnt(0)" ::: "memory");
        }
    }
    __syncthreads();
}

#ifndef ONLYQ
#define ONLYQ -1
#endif
#ifndef REP_MASK
#define REP_MASK 0
#endif
__global__ void __launch_bounds__(256, 2) mega(Params p) {
    __shared__ __attribute__((aligned(16))) char lds[65536];
    __shared__ uint4 xb_words;
    XcdBarrier bar; bar.bar = (unsigned*)(p.ws + OFF_BAR); bar.x = 0; bar.st = (volatile LAS unsigned*)&xb_words;
    if (p.coop) {
        if (threadIdx.x == 0) xb_words = make_uint4(0u, 0u, 0u, 0u);
        __syncthreads();
        bar = xcd_barrier_post((unsigned*)(p.ws + OFF_BAR), (volatile LAS unsigned*)&xb_words);
    }
#define RUNPH(PH, Q, BODY) if ((ONLYQ < 0 || ONLYQ == (Q)) && p.ph_lo <= (PH) && (PH) < p.ph_hi) { BODY; if (REP_MASK & (1 << (Q))) { BODY; } \
        if (p.coop && (PH) + 1 < p.ph_hi) { if (p.pad == 0x5a5a5a5a) cg::this_grid().sync(); else xcd_barrier(bar); } }
#define LAYER(L) \
    RUNPH(1 + (L) * 10 + 0, 0, phase_gemm_in(p, L, lds)) \
    RUNPH(1 + (L) * 10 + 1, 1, phase_prep(p, L, lds)) \
    RUNPH(1 + (L) * 10 + 2, 2, phase_scan(p, L, lds)) \
    RUNPH(1 + (L) * 10 + 3, 3, phase_mixnorm(p, L)) \
    RUNPH(1 + (L) * 10 + 4, 4, phase_gemm_n1024((const u16*)(p.ws + OFF_YCAT), 2048, (const u16*)(p.ws + OFF_WOUT) + (size_t)(L) * 1024 * 2048, nullptr, (u16*)(p.ws + OFF_T), lds)) \
    RUNPH(1 + (L) * 10 + 5, 15, phase_rowpass(p, L, 0)) \
    RUNPH(1 + (L) * 10 + 6, 6, phase_gemm_n1024((const u16*)(p.ws + OFF_HB), 1024, (const u16*)(p.ws + OFF_WQ) + (size_t)(L) * 1024 * 1024, nullptr, (u16*)(p.ws + OFF_Q), lds)) \
    RUNPH(1 + (L) * 10 + 7, 7, phase_attn(p, L, lds)) \
    RUNPH(1 + (L) * 10 + 8, 8, phase_gemm_n1024((const u16*)(p.ws + OFF_O), 1024, (const u16*)(p.ws + OFF_WO) + (size_t)(L) * 1024 * 1024, nullptr, (u16*)(p.ws + OFF_T), lds)) \
    RUNPH(1 + (L) * 10 + 9, 15, phase_rowpass(p, L, 1))
    RUNPH(0, 10, phase_prologue(p, lds))
    LAYER(0)
    LAYER(1)
}

extern "C" void kernel_launch(void* const* d_in, const int* in_sizes, int n_in, void* d_out, int out_size, void* d_ws, size_t ws_size,
                              hipStream_t stream) {
    static int grid = 0;
    if (!grid) {
        int dev = 0, cus = 0, per_cu = 0;
        hipGetDevice(&dev);
        hipDeviceGetAttribute(&cus, hipDeviceAttributeMultiprocessorCount, dev);
        hipOccupancyMaxActiveBlocksPerMultiprocessor(&per_cu, mega, 256, 0);
        if (per_cu > 2) per_cu = 2;
        if (per_cu < 1) per_cu = 1;
        grid = cus * per_cu;
        if (grid > MAX_GRID) grid = MAX_GRID;
        if (n_in != 29 || ws_size < WS_END) { fprintf(stderr, "kernel_launch: unexpected n_in %d or ws_size %zu (< %zu)\n", n_in, ws_size, (size_t)WS_END); }
    }
    Params p{};
    for (int i = 0; i < 29; ++i) p.in[i] = (const float*)d_in[i];
    p.out = (float*)d_out; p.ws = (char*)d_ws;
#if MULTI_LAUNCH
    for (int ph = 0; ph < NPHASE; ++ph) {
        p.ph_lo = ph; p.ph_hi = ph + 1; p.coop = 0;
        hipLaunchKernelGGL(mega, dim3(grid), dim3(256), 0, stream, p);
    }
#else
    p.ph_lo = 0; p.ph_hi = NPHASE; p.coop = 1;
    (void)hipMemsetAsync((char*)d_ws + OFF_BAR, 0, 16384, stream);
    void* args[] = {&p};
    hipError_t e = hipLaunchCooperativeKernel((void*)mega, dim3(grid), dim3(256), args, 0, stream);
    if (e != hipSuccess) fprintf(stderr, "cooperative launch failed: %s (grid %d)\n", hipGetErrorString(e), grid);
#endif
}
```

```cpp
#include <hip/hip_runtime.h>
#include <hip/hip_cooperative_groups.h>
#include <stdint.h>
#include <cstdio>
namespace cg = cooperative_groups;

#ifndef MULTI_LAUNCH
#define MULTI_LAUNCH 0
#endif

typedef unsigned short u16;
typedef short bf16x8 __attribute__((ext_vector_type(8)));
typedef float f32x4 __attribute__((ext_vector_type(4)));
typedef unsigned u32x4 __attribute__((ext_vector_type(4)));
#define DEVINL __device__ __forceinline__

constexpr int D = 1024, NP = 16384, NS = 128, NR = 16512, SEQ = 2048, DINP = 6784, DIN = 6672;
constexpr int NPHASE = 21;
constexpr float EPS = 1e-6f;

constexpr size_t SZ_WIN = (size_t)DINP * 1024 * 2, SZ_WOUT = (size_t)1024 * 2048 * 2, SZ_SQ = (size_t)1024 * 1024 * 2;
constexpr size_t OFF_WIN = 0;
constexpr size_t OFF_WOUT = OFF_WIN + 2 * SZ_WIN;
constexpr size_t OFF_WQ = OFF_WOUT + 2 * SZ_WOUT;
constexpr size_t OFF_WK = OFF_WQ + 2 * SZ_SQ;
constexpr size_t OFF_WV = OFF_WK + 2 * SZ_SQ;
constexpr size_t OFF_WO = OFF_WV + 2 * SZ_SQ;
constexpr size_t OFF_X = OFF_WO + 2 * SZ_SQ;
constexpr size_t OFF_HB = OFF_X + (size_t)NR * 1024 * 4;
constexpr size_t OFF_MB = OFF_HB + (size_t)NR * 1024 * 2;
constexpr size_t OFF_U = OFF_MB + (size_t)2048 * 1024 * 2;
constexpr size_t OFF_XBC = OFF_U + (size_t)NR * DINP * 2;
constexpr size_t OFF_DT = OFF_XBC + (size_t)NR * 1536 * 4;
constexpr size_t OFF_OB = OFF_DT + (size_t)NR * 16 * 4;
constexpr size_t OFF_YC = OFF_OB + (size_t)NR * 512 * 4;
constexpr size_t OFF_YCAT = OFF_YC + (size_t)NR * 1024 * 4;
constexpr size_t OFF_T = OFF_YCAT + (size_t)NR * 2048 * 2;
constexpr size_t OFF_Q = OFF_T + (size_t)NR * 1024 * 4;
constexpr size_t OFF_O = OFF_Q + (size_t)NR * 1024 * 2;
constexpr size_t OFF_MK = OFF_O + (size_t)NR * 1024 * 2;
constexpr size_t OFF_MVT = OFF_MK + (size_t)2048 * 1024 * 2;
constexpr size_t OFF_SCR = OFF_MVT + (size_t)2048 * 1024 * 2;
constexpr size_t SCR_PER_BLOCK = 128 * 256 * 4 + 128 * 256 * 2;
constexpr int MAX_GRID = 1024;
constexpr size_t OFF_XBCB = OFF_SCR + SCR_PER_BLOCK * MAX_GRID;
constexpr size_t OFF_HQG = OFF_XBCB + (size_t)NR * 1536 * 2;
constexpr size_t OFF_HQM = OFF_HQG + (size_t)2048 * 4096 * 2;
constexpr size_t OFF_HKM = OFF_HQM + (size_t)2048 * 4096 * 2;
constexpr size_t OFF_HKD = OFF_HKM + (size_t)2048 * 4096 * 2;
constexpr size_t OFF_HDS = OFF_HKD + (size_t)2048 * 4096 * 2;
constexpr size_t OFF_BAR = OFF_HDS + (size_t)2048 * 128 * 4;
constexpr size_t WS_END = OFF_BAR + 16384;

constexpr size_t O_YP = 0;
constexpr size_t O_YS = O_YP + (size_t)NP * 1024;
constexpr size_t O_CAP = O_YS + (size_t)NS * 1024;
constexpr size_t O_HGP = O_CAP + (size_t)2 * 8 * 2 * 512;
constexpr size_t O_SCP = O_HGP + (size_t)2 * 8 * 4 * 128 * 128;
constexpr size_t O_SSP = O_SCP + (size_t)2 * 8 * 3 * 1536;
constexpr size_t O_MKP = O_SSP + (size_t)2 * 8 * 16 * 64 * 128;
constexpr size_t O_MVP = O_MKP + (size_t)2 * 8 * 256 * 1024;
constexpr size_t O_CAS = O_MVP + (size_t)2 * 8 * 256 * 1024;
constexpr size_t O_HGS = O_CAS + (size_t)2 * 128 * 2 * 512;
constexpr size_t O_SCS = O_HGS + (size_t)2 * 128 * 4 * 128 * 128;
constexpr size_t O_SSS = O_SCS + (size_t)2 * 128 * 3 * 1536;

enum { I_XP = 0, I_XS, I_MEM, I_SCA, I_SHG, I_SSC, I_SSS, I_CK, I_CV, I_WIN, I_CAW, I_HLB, I_HGN, I_SCW, I_SCB, I_DTB, I_ALOG, I_DSK,
       I_SNORM, I_WOUT, I_GPM, I_GQM, I_GPX, I_GQX, I_GMEM, I_WQ, I_WK, I_WV, I_WO };

struct Params {
    const float* in[29];
    float* out;
    char* ws;
    int ph_lo, ph_hi, coop, pad;
};

DEVINL float bf2f(uint32_t h) { return __uint_as_float(h << 16); }
DEVINL uint32_t f2bf(float f) { uint32_t u = __float_as_uint(f); return (u + 0x7fffu + ((u >> 16) & 1u)) >> 16; }
DEVINL uint32_t pack2(float a, float b) { return f2bf(a) | (f2bf(b) << 16); }
DEVINL float lo16(uint32_t v) { return __uint_as_float(v << 16); }
DEVINL float hi16(uint32_t v) { return __uint_as_float(v & 0xffff0000u); }
DEVINL float sigmoidf_(float x) { return __builtin_amdgcn_rcpf(1.0f + __expf(-x)); }
DEVINL float siluf_(float x) { return x * __builtin_amdgcn_rcpf(1.0f + __expf(-x)); }
DEVINL float wave_sum(float v) {
#pragma unroll
    for (int o = 32; o; o >>= 1) v += __shfl_xor(v, o);
    return v;
}
DEVINL float wave_max(float v) {
#pragma unroll
    for (int o = 32; o; o >>= 1) v = fmaxf(v, __shfl_xor(v, o));
    return v;
}
DEVINL void lds_barrier() { asm volatile("s_waitcnt lgkmcnt(0)\n\ts_barrier" ::: "memory"); }
DEVINL float4 ldnt4(const float* p) { const f32x4 v = __builtin_nontemporal_load((const f32x4*)p); return make_float4(v[0], v[1], v[2], v[3]); }
DEVINL uint4 ldnt16(const void* p) { const u32x4 v = __builtin_nontemporal_load((const u32x4*)p); return make_uint4(v[0], v[1], v[2], v[3]); }
DEVINL void stnt4(float* p, float4 v) { const f32x4 t = (f32x4){v.x, v.y, v.z, v.w}; __builtin_nontemporal_store(t, (f32x4*)p); }
#define UNPACK8(v, f) do { f[0] = lo16(v.x); f[1] = hi16(v.x); f[2] = lo16(v.y); f[3] = hi16(v.y); f[4] = lo16(v.z); f[5] = hi16(v.z); f[6] = lo16(v.w); f[7] = hi16(v.w); } while (0)

template <class Epi>
DEVINL void gemm_tile(const u16* __restrict__ A, int lda, const u16* __restrict__ Bt, int ldb, int K, char* lds, Epi epi) {
    const int tid = threadIdx.x, lane = tid & 63, wave = tid >> 6, wr = wave >> 1, wc = wave & 1, fr = lane & 15, fq = lane >> 4;
    f32x4 acc[4][4];
#pragma unroll
    for (int m = 0; m < 4; ++m)
#pragma unroll
        for (int n = 0; n < 4; ++n) acc[m][n] = (f32x4){0.f, 0.f, 0.f, 0.f};
    const int srow = tid >> 2, sch = tid & 3;
    const u16* Ag = A + (size_t)srow * lda + sch * 8;
    const u16* Bg = Bt + (size_t)srow * ldb + sch * 8;
    const int soff = srow * 64 + ((sch ^ (((srow >> 3) & 1) << 1)) << 4);
    const int swz = ((fq ^ (((fr >> 3) & 1) << 1)) << 4);
    const int fa = (wr * 64 + fr) * 64 + swz;
    const int fb = 16384 + (wc * 64 + fr) * 64 + swz;
    uint4 pa0, pa1, pa2, pa3, pb0, pb1, pb2, pb3, qa0, qa1, qa2, qa3, qb0, qb1, qb2, qb3;
    const int nt = K >> 6;
    const size_t sA1 = (size_t)64 * lda, sB1 = (size_t)64 * ldb;
#define G_LOAD(P, T) do { const int k0_ = (T) << 6; \
        P##a0 = *(const uint4*)(Ag + k0_); P##a1 = *(const uint4*)(Ag + k0_ + 32); P##a2 = *(const uint4*)(Ag + sA1 + k0_); P##a3 = *(const uint4*)(Ag + sA1 + k0_ + 32); \
        P##b0 = *(const uint4*)(Bg + k0_); P##b1 = *(const uint4*)(Bg + k0_ + 32); P##b2 = *(const uint4*)(Bg + sB1 + k0_); P##b3 = *(const uint4*)(Bg + sB1 + k0_ + 32); } while (0)
#define G_STORE(P, ST) do { char* nb_ = lds + (ST) * 32768 + soff; \
        *(uint4*)(nb_) = P##a0; *(uint4*)(nb_ + 8192) = P##a1; *(uint4*)(nb_ + 4096) = P##a2; *(uint4*)(nb_ + 4096 + 8192) = P##a3; \
        *(uint4*)(nb_ + 16384) = P##b0; *(uint4*)(nb_ + 16384 + 8192) = P##b1; *(uint4*)(nb_ + 16384 + 4096) = P##b2; *(uint4*)(nb_ + 16384 + 4096 + 8192) = P##b3; } while (0)
    auto g_compute = [&](int ST) __attribute__((always_inline)) {
        const char* base = lds + ST * 32768;
#pragma unroll
        for (int s = 0; s < 2; ++s) {
            bf16x8 a[4], b[4];
#pragma unroll
            for (int m = 0; m < 4; ++m) a[m] = *(const bf16x8*)(base + fa + m * 1024 + s * 8192);
#pragma unroll
            for (int n = 0; n < 4; ++n) b[n] = *(const bf16x8*)(base + fb + n * 1024 + s * 8192);
            __builtin_amdgcn_s_setprio(1);
#pragma unroll
            for (int m = 0; m < 4; ++m)
#pragma unroll
                for (int n = 0; n < 4; ++n) acc[m][n] = __builtin_amdgcn_mfma_f32_16x16x32_bf16(b[n], a[m], acc[m][n], 0, 0, 0);
            __builtin_amdgcn_s_setprio(0);
        }
    };
#define G_COMPUTE(ST) g_compute(ST)
    G_LOAD(p, 0);
    if (nt > 1) G_LOAD(q, 1);
    G_STORE(p, 0);
    if (nt > 2) G_LOAD(p, 2);
    lds_barrier();
#pragma unroll 1
    for (int t = 0; t < nt; t += 2) {
        if (t + 1 < nt) G_STORE(q, 1);
        if (t + 3 < nt) G_LOAD(q, t + 3);
        G_COMPUTE(0);
        lds_barrier();
        if (t + 1 < nt) {
            if (t + 2 < nt) G_STORE(p, 0);
            if (t + 4 < nt) G_LOAD(p, t + 4);
            G_COMPUTE(1);
            lds_barrier();
        }
    }
#undef G_LOAD
#undef G_STORE
#undef G_COMPUTE
#pragma unroll
    for (int m = 0; m < 4; ++m)
#pragma unroll
        for (int n = 0; n < 4; ++n) epi(wr * 64 + m * 16 + fr, wc * 64 + n * 16 + fq * 4, acc[m][n]);
}

DEVINL void gemm_tile_b(const u16* __restrict__ A, int lda, const u16* __restrict__ Bt, int ldb, int K, char* lds, u16* __restrict__ dst, int ldd) {
    const int tid = threadIdx.x, lane = tid & 63, wave = tid >> 6, wr = wave >> 1, wc = wave & 1, fr = lane & 15, fq = lane >> 4;
    f32x4 acc[4][4];
#pragma unroll
    for (int m = 0; m < 4; ++m)
#pragma unroll
        for (int n = 0; n < 4; ++n) acc[m][n] = (f32x4){0.f, 0.f, 0.f, 0.f};
    const int srow = tid >> 2, sch = tid & 3;
    const u16* Ag = A + (size_t)srow * lda + sch * 8;
    const u16* Bg = Bt + (size_t)srow * ldb + sch * 8;
    const int soff = srow * 64 + ((sch ^ (((srow >> 3) & 1) << 1)) << 4);
    const int swz = ((fq ^ (((fr >> 3) & 1) << 1)) << 4);
    const int fa = (wr * 64 + fr) * 64 + swz;
    const int fb = 16384 + (wc * 64 + fr) * 64 + swz;
    uint4 pa0, pa1, pa2, pa3, pb0, pb1, pb2, pb3, qa0, qa1, qa2, qa3, qb0, qb1, qb2, qb3;
    const int nt = K >> 6;
    const size_t sA1 = (size_t)64 * lda, sB1 = (size_t)64 * ldb;
#define G_LOAD(P, T) do { const int k0_ = (T) << 6; \
        P##a0 = *(const uint4*)(Ag + k0_); P##a1 = *(const uint4*)(Ag + k0_ + 32); P##a2 = *(const uint4*)(Ag + sA1 + k0_); P##a3 = *(const uint4*)(Ag + sA1 + k0_ + 32); \
        P##b0 = *(const uint4*)(Bg + k0_); P##b1 = *(const uint4*)(Bg + k0_ + 32); P##b2 = *(const uint4*)(Bg + sB1 + k0_); P##b3 = *(const uint4*)(Bg + sB1 + k0_ + 32); } while (0)
#define G_STORE(P, ST) do { char* nb_ = lds + (ST) * 32768 + soff; \
        *(uint4*)(nb_) = P##a0; *(uint4*)(nb_ + 8192) = P##a1; *(uint4*)(nb_ + 4096) = P##a2; *(uint4*)(nb_ + 4096 + 8192) = P##a3; \
        *(uint4*)(nb_ + 16384) = P##b0; *(uint4*)(nb_ + 16384 + 8192) = P##b1; *(uint4*)(nb_ + 16384 + 4096) = P##b2; *(uint4*)(nb_ + 16384 + 4096 + 8192) = P##b3; } while (0)
    auto g_compute = [&](int ST) __attribute__((always_inline)) {
        const char* base = lds + ST * 32768;
#pragma unroll
        for (int s = 0; s < 2; ++s) {
            bf16x8 a[4], b[4];
#pragma unroll
            for (int m = 0; m < 4; ++m) a[m] = *(const bf16x8*)(base + fa + m * 1024 + s * 8192);
#pragma unroll
            for (int n = 0; n < 4; ++n) b[n] = *(const bf16x8*)(base + fb + n * 1024 + s * 8192);
            __builtin_amdgcn_s_setprio(1);
#pragma unroll
            for (int m = 0; m < 4; ++m)
#pragma unroll
                for (int n = 0; n < 4; ++n) acc[m][n] = __builtin_amdgcn_mfma_f32_16x16x32_bf16(b[n], a[m], acc[m][n], 0, 0, 0);
            __builtin_amdgcn_s_setprio(0);
        }
    };
#define G_COMPUTE(ST) g_compute(ST)
    G_LOAD(p, 0);
    if (nt > 1) G_LOAD(q, 1);
    G_STORE(p, 0);
    if (nt > 2) G_LOAD(p, 2);
    lds_barrier();
#pragma unroll 1
    for (int t = 0; t < nt; t += 2) {
        if (t + 1 < nt) G_STORE(q, 1);
        if (t + 3 < nt) G_LOAD(q, t + 3);
        G_COMPUTE(0);
        lds_barrier();
        if (t + 1 < nt) {
            if (t + 2 < nt) G_STORE(p, 0);
            if (t + 4 < nt) G_LOAD(p, t + 4);
            G_COMPUTE(1);
            lds_barrier();
        }
    }
#undef G_LOAD
#undef G_STORE
#undef G_COMPUTE
    {
        char* img = lds + wave * 9216;
#pragma unroll
        for (int m = 0; m < 4; ++m)
#pragma unroll
            for (int n = 0; n < 4; ++n)
                *(uint2*)(img + (m * 16 + fr) * 144 + (n * 16 + fq * 4) * 2) = make_uint2(pack2(acc[m][n][0], acc[m][n][1]), pack2(acc[m][n][2], acc[m][n][3]));
        u16* d0 = dst + (size_t)(wr * 64) * ldd + wc * 64 + (lane & 7) * 8;
#pragma unroll
        for (int it = 0; it < 8; ++it) {
            const int row = it * 8 + (lane >> 3);
            const uint4 v = *(const uint4*)(img + row * 144 + (lane & 7) * 16);
            *(uint4*)(d0 + (size_t)row * ldd) = v;
        }
    }
    lds_barrier();
}

template <class Epi>
DEVINL void gemm_tile1(const u16* __restrict__ A, int lda, const u16* __restrict__ Bt, int ldb, int K, char* lds, Epi epi) {
    const int tid = threadIdx.x, lane = tid & 63, wave = tid >> 6, wr = wave >> 1, wc = wave & 1, fr = lane & 15, fq = lane >> 4;
    f32x4 acc[4][4];
#pragma unroll
    for (int m = 0; m < 4; ++m)
#pragma unroll
        for (int n = 0; n < 4; ++n) acc[m][n] = (f32x4){0.f, 0.f, 0.f, 0.f};
    const int srow = tid >> 3, sch = tid & 7;
    const u16* Ag = A + (size_t)srow * lda + sch * 8;
    const u16* Bg = Bt + (size_t)srow * ldb + sch * 8;
    const int soff = (sch >> 2) * 8192 + srow * 64 + ((((sch & 3) ^ (((srow >> 3) & 1) << 1))) << 4);
    const int swz = ((fq ^ (((fr >> 3) & 1) << 1)) << 4);
    const int fa = (wr * 64 + fr) * 64 + swz;
    const int fb = 16384 + (wc * 64 + fr) * 64 + swz;
    uint4 ra[4], rb[4];
    const int nt = K >> 6;
#pragma unroll
    for (int i = 0; i < 4; ++i) {
        ra[i] = *(const uint4*)(Ag + (size_t)i * 32 * lda);
        rb[i] = *(const uint4*)(Bg + (size_t)i * 32 * ldb);
    }
#pragma unroll
    for (int i = 0; i < 4; ++i) {
        *(uint4*)(lds + soff + i * 2048) = ra[i];
        *(uint4*)(lds + 16384 + soff + i * 2048) = rb[i];
    }
    __syncthreads();
    for (int t = 0; t < nt; ++t) {
        const bool more = (t + 1 < nt);
        if (more) {
            const int k0 = (t + 1) << 6;
#pragma unroll
            for (int i = 0; i < 4; ++i) {
                ra[i] = *(const uint4*)(Ag + (size_t)i * 32 * lda + k0);
                rb[i] = *(const uint4*)(Bg + (size_t)i * 32 * ldb + k0);
            }
        }
        const char* base = lds + (t & 1) * 32768;
#pragma unroll
        for (int s = 0; s < 2; ++s) {
            bf16x8 a[4], b[4];
#pragma unroll
            for (int m = 0; m < 4; ++m) a[m] = *(const bf16x8*)(base + fa + m * 1024 + s * 8192);
#pragma unroll
            for (int n = 0; n < 4; ++n) b[n] = *(const bf16x8*)(base + fb + n * 1024 + s * 8192);
#pragma unroll
            for (int m = 0; m < 4; ++m)
#pragma unroll
                for (int n = 0; n < 4; ++n) acc[m][n] = __builtin_amdgcn_mfma_f32_16x16x32_bf16(b[n], a[m], acc[m][n], 0, 0, 0);
        }
        if (more) {
            char* nb = lds + ((t + 1) & 1) * 32768;
#pragma unroll
            for (int i = 0; i < 4; ++i) {
                *(uint4*)(nb + soff + i * 2048) = ra[i];
                *(uint4*)(nb + 16384 + soff + i * 2048) = rb[i];
            }
        }
        __syncthreads();
    }
#pragma unroll
    for (int m = 0; m < 4; ++m)
#pragma unroll
        for (int n = 0; n < 4; ++n) epi(wr * 64 + m * 16 + fr, wc * 64 + n * 16 + fq * 4, acc[m][n]);
}

DEVINL void tile_mn(int id, int nM, int nN, int& m, int& n) {
    const int grp = id / (8 * nN), fm = grp * 8;
    const int gsz = (nM - fm) < 8 ? (nM - fm) : 8;
    const int rem = id - grp * 8 * nN;
    m = fm + rem % gsz; n = rem / gsz;
}

template <class F>
DEVINL void for_tiles_xcd(int T, F f) {
    const int G = gridDim.x;
    if ((G & 7) == 0) {
        const int x = blockIdx.x & 7, s = blockIdx.x >> 3, GS = G >> 3, per = ((((T + 7) >> 3) + 63) >> 6) << 6;
        for (int i = s; i < per; i += GS) { const int id = x * per + i; if (id < T) f(id); }
    } else {
        for (int id = blockIdx.x; id < T; id += G) f(id);
    }
}

DEVINL void transpose_tile(const float* __restrict__ W, int K, int N, u16* __restrict__ Wt, int k0, int n0, float* tile) {
    const int tid = threadIdx.x, tx = tid & 15, ty = tid >> 4;
#pragma unroll
    for (int i = 0; i < 4; ++i) {
        const int k = ty + 16 * i, n = n0 + tx * 4;
        float4 v = make_float4(0.f, 0.f, 0.f, 0.f);
        if (n < N) v = ldnt4(W + (size_t)(k0 + k) * N + n);
        float* t = tile + k * 65 + tx * 4;
        t[0] = v.x; t[1] = v.y; t[2] = v.z; t[3] = v.w;
    }
    __syncthreads();
    const int n = tid >> 2, kc = (tid & 3) * 16;
    uint32_t w[8];
#pragma unroll
    for (int j = 0; j < 8; ++j) w[j] = pack2(tile[(kc + 2 * j) * 65 + n], tile[(kc + 2 * j + 1) * 65 + n]);
    uint4* dst = (uint4*)(Wt + (size_t)(n0 + n) * K + k0 + kc);
    dst[0] = make_uint4(w[0], w[1], w[2], w[3]);
    dst[1] = make_uint4(w[4], w[5], w[6], w[7]);
    __syncthreads();
}

DEVINL void rowpass_row(const float* __restrict__ base, const u16* __restrict__ trow, const float* __restrict__ gpost,
                        float* __restrict__ xdst, const float* __restrict__ gnext, u16* __restrict__ hb, int lane, bool ntx = false) {
    float x[16];
    {
        const float4 a = ldnt4(base + lane * 8), b = ldnt4(base + lane * 8 + 4);
        const float4 c = ldnt4(base + 512 + lane * 8), d = ldnt4(base + 512 + lane * 8 + 4);
        x[0] = a.x; x[1] = a.y; x[2] = a.z; x[3] = a.w; x[4] = b.x; x[5] = b.y; x[6] = b.z; x[7] = b.w;
        x[8] = c.x; x[9] = c.y; x[10] = c.z; x[11] = c.w; x[12] = d.x; x[13] = d.y; x[14] = d.z; x[15] = d.w;
    }
    if (trow) {
        float t[16], g[16];
        {
            const uint4 t0 = ldnt16(trow + lane * 8), t1 = ldnt16(trow + 512 + lane * 8);
            t[0] = lo16(t0.x); t[1] = hi16(t0.x); t[2] = lo16(t0.y); t[3] = hi16(t0.y); t[4] = lo16(t0.z); t[5] = hi16(t0.z); t[6] = lo16(t0.w); t[7] = hi16(t0.w);
            t[8] = lo16(t1.x); t[9] = hi16(t1.x); t[10] = lo16(t1.y); t[11] = hi16(t1.y); t[12] = lo16(t1.z); t[13] = hi16(t1.z); t[14] = lo16(t1.w); t[15] = hi16(t1.w);
        }
#pragma unroll
        for (int h = 0; h < 2; ++h)
#pragma unroll
            for (int q = 0; q < 2; ++q) {
                const float4 gg = *(const float4*)(gpost + h * 512 + lane * 8 + q * 4);
                g[h * 8 + q * 4 + 0] = gg.x; g[h * 8 + q * 4 + 1] = gg.y; g[h * 8 + q * 4 + 2] = gg.z; g[h * 8 + q * 4 + 3] = gg.w;
            }
        float ss = 0.f;
#pragma unroll
        for (int i = 0; i < 16; ++i) ss += t[i] * t[i];
        ss = wave_sum(ss);
        const float rstd = rsqrtf(ss * (1.0f / 1024.0f) + EPS);
#pragma unroll
        for (int i = 0; i < 16; ++i) x[i] += t[i] * rstd * g[i];
    }
    if (xdst) {
#pragma unroll
        for (int h = 0; h < 2; ++h)
#pragma unroll
            for (int q = 0; q < 2; ++q)
            {
                const float4 xv = make_float4(x[h * 8 + q * 4], x[h * 8 + q * 4 + 1], x[h * 8 + q * 4 + 2], x[h * 8 + q * 4 + 3]);
                (void)ntx; stnt4(xdst + h * 512 + lane * 8 + q * 4, xv);
            }
    }
    if (gnext) {
        float ss = 0.f;
#pragma unroll
        for (int i = 0; i < 16; ++i) ss += x[i] * x[i];
        ss = wave_sum(ss);
        const float rstd = rsqrtf(ss * (1.0f / 1024.0f) + EPS);
#pragma unroll
        for (int h = 0; h < 2; ++h) {
            const float4 g0 = *(const float4*)(gnext + h * 512 + lane * 8), g1 = *(const float4*)(gnext + h * 512 + lane * 8 + 4);
            uint4 o;
            o.x = pack2(x[h * 8 + 0] * rstd * g0.x, x[h * 8 + 1] * rstd * g0.y);
            o.y = pack2(x[h * 8 + 2] * rstd * g0.z, x[h * 8 + 3] * rstd * g0.w);
            o.z = pack2(x[h * 8 + 4] * rstd * g1.x, x[h * 8 + 5] * rstd * g1.y);
            o.w = pack2(x[h * 8 + 6] * rstd * g1.z, x[h * 8 + 7] * rstd * g1.w);
            *(uint4*)(hb + h * 512 + lane * 8) = o;
        }
    }
}

DEVINL void phase_prologue(const Params& p, char* lds) {
    const int G = gridDim.x;
    u16* WinT = (u16*)(p.ws + OFF_WIN);
    u16* WoutT = (u16*)(p.ws + OFF_WOUT);
    for (int it = blockIdx.x; it < 6464; it += G) {
        const int l = it / 3232; int r = it % 3232;
        const float* W; u16* Wt; int K, N, kt, nt;
        if (r < 1696) { W = p.in[I_WIN] + (size_t)l * 1024 * DIN; K = 1024; N = DIN; Wt = WinT + (size_t)l * DINP * 1024; kt = r & 15; nt = r >> 4; }
        else if (r < 2208) { r -= 1696; W = p.in[I_WOUT] + (size_t)l * 2048 * 1024; K = 2048; N = 1024; Wt = WoutT + (size_t)l * 1024 * 2048; kt = r & 31; nt = r >> 5; }
        else {
            r -= 2208; const int j = r >> 8; r &= 255;
            W = p.in[j == 0 ? I_WQ : j == 1 ? I_WK : j == 2 ? I_WV : I_WO] + (size_t)l * 1024 * 1024;
            Wt = (u16*)(p.ws + (j == 0 ? OFF_WQ : j == 1 ? OFF_WK : j == 2 ? OFF_WV : OFF_WO)) + (size_t)l * 1024 * 1024;
            K = 1024; N = 1024; kt = r & 15; nt = r >> 4;
        }
        transpose_tile(W, K, N, Wt, kt * 64, nt * 64, (float*)lds);
    }
    const int wave = threadIdx.x >> 6, lane = threadIdx.x & 63;
    float* X = (float*)(p.ws + OFF_X);
    u16* Hb = (u16*)(p.ws + OFF_HB);
    u16* Mb = (u16*)(p.ws + OFF_MB);
    for (int it = blockIdx.x; it < (NR + 2048) / 4; it += G) {
        const int r = it * 4 + wave;
        if (r < NR) {
            const float* src = r < NP ? p.in[I_XP] + (size_t)r * 1024 : p.in[I_XS] + (size_t)(r - NP) * 1024;
            rowpass_row(src, nullptr, nullptr, nullptr, p.in[I_GPM], Hb + (size_t)r * 1024, lane);
        } else {
            const int m = r - NR;
            rowpass_row(p.in[I_MEM] + (size_t)m * 1024, nullptr, nullptr, nullptr, p.in[I_GMEM], Mb + (size_t)m * 1024, lane);
        }
    }
}

DEVINL void phase_gemm_in(const Params& p, int l, char* lds) {
    const u16* Hb = (const u16*)(p.ws + OFF_HB);
    const u16* Mb = (const u16*)(p.ws + OFF_MB);
    const u16* WinT = (const u16*)(p.ws + OFF_WIN) + (size_t)l * DINP * 1024;
    const u16* WkT = (const u16*)(p.ws + OFF_WK) + (size_t)l * 1024 * 1024;
    const u16* WvT = (const u16*)(p.ws + OFF_WV) + (size_t)l * 1024 * 1024;
    u16* U = (u16*)(p.ws + OFF_U);
    u16* MKb = (u16*)(p.ws + OFF_MK);
    u16* MVT = (u16*)(p.ws + OFF_MVT);
    float* omk = p.out + O_MKP + (size_t)l * 2048 * 1024;
    float* omv = p.out + O_MVP + (size_t)l * 2048 * 1024;
    constexpr int TU = 129 * 53;
    for_tiles_xcd(TU + 256, [&](int id) {
        if (id < TU) {
            int m, n; tile_mn(id, 129, 53, m, n);
            u16* dst = U + (size_t)m * 128 * DINP + n * 128;
            gemm_tile_b(Hb + (size_t)m * 128 * 1024, 1024, WinT + (size_t)n * 128 * 1024, 1024, 1024, lds, dst, DINP);
        } else {
            int id2 = id - TU; const int isv = id2 >> 7; id2 &= 127;
            const int m = id2 & 15, n = id2 >> 4;
            if (!isv) {
                float* df = omk + (size_t)m * 128 * 1024 + n * 128;
                u16* db = MKb + (size_t)m * 128 * 1024 + n * 128;
                gemm_tile(Mb + (size_t)m * 128 * 1024, 1024, WkT + (size_t)n * 128 * 1024, 1024, 1024, lds,
                          [&](int r, int c, f32x4 v) {
                              stnt4(df + (size_t)r * 1024 + c, make_float4(v[0], v[1], v[2], v[3]));
                              *(uint2*)(db + (size_t)r * 1024 + c) = make_uint2(pack2(v[0], v[1]), pack2(v[2], v[3]));
                          });
            } else {
                float* df = omv + (size_t)m * 128 * 1024 + n * 128;
                gemm_tile(Mb + (size_t)m * 128 * 1024, 1024, WvT + (size_t)n * 128 * 1024, 1024, 1024, lds,
                          [&](int r, int c, f32x4 v) {
                              stnt4(df + (size_t)r * 1024 + c, make_float4(v[0], v[1], v[2], v[3]));
                              const int row = m * 128 + r, col = n * 128 + c;
                              const int b = row >> 8, mm = row & 255, h = col >> 8, d = col & 255;
                              u16* t = MVT + ((size_t)((b * 4 + h) * 256 + d)) * 256 + mm;
                              t[0] = (u16)f2bf(v[0]); t[256] = (u16)f2bf(v[1]); t[512] = (u16)f2bf(v[2]); t[768] = (u16)f2bf(v[3]);
                          });
            }
        }
    });
}

DEVINL void phase_gemm_n1024(const u16* A, int K, const u16* Wt, float* Cf, u16* Cb, char* lds) {
    for_tiles_xcd(128 * 8, [&](int id) {
        int m, n; tile_mn(id, 128, 8, m, n);
        const size_t o = (size_t)m * 128 * 1024 + n * 128;
        if (Cf) {
            float* df = Cf + o;
            gemm_tile(A + (size_t)m * 128 * K, K, Wt + (size_t)n * 128 * K, K, K, lds,
                      [&](int r, int c, f32x4 v) { *(float4*)(df + (size_t)r * 1024 + c) = make_float4(v[0], v[1], v[2], v[3]); });
        } else {
            u16* db = Cb + o;
            gemm_tile_b(A + (size_t)m * 128 * K, K, Wt + (size_t)n * 128 * K, K, K, lds, db, 1024);
        }
    });
    const int tid = threadIdx.x, lane = tid & 63, w = tid >> 6, fr = lane & 15, fq = lane >> 4;
    float* red = (float*)lds;
    for (int pc = blockIdx.x; pc < 512; pc += gridDim.x) {
        const int row0 = NP + (pc >> 6) * 16, col0 = (pc & 63) * 16;
        const int kq = K >> 2;
        const u16* pa = A + (size_t)(row0 + fr) * K + w * kq + fq * 8;
        const u16* pb = Wt + (size_t)(col0 + fr) * K + w * kq + fq * 8;
        f32x4 acc = (f32x4){0.f, 0.f, 0.f, 0.f};
#pragma unroll 4
        for (int k = 0; k < kq; k += 32)
            acc = __builtin_amdgcn_mfma_f32_16x16x32_bf16(*(const bf16x8*)(pb + k), *(const bf16x8*)(pa + k), acc, 0, 0, 0);
        *(float4*)(red + (w * 64 + lane) * 4) = make_float4(acc[0], acc[1], acc[2], acc[3]);
        __syncthreads();
        if (w == 0) {
            const float4 a0 = *(const float4*)(red + lane * 4), a1 = *(const float4*)(red + (64 + lane) * 4), a2 = *(const float4*)(red + (128 + lane) * 4), a3 = *(const float4*)(red + (192 + lane) * 4);
            const float v0 = a0.x + a1.x + a2.x + a3.x, v1 = a0.y + a1.y + a2.y + a3.y, v2 = a0.z + a1.z + a2.z + a3.z, v3 = a0.w + a1.w + a2.w + a3.w;
            const size_t o = (size_t)(row0 + fr) * 1024 + col0 + fq * 4;
            if (Cf) *(float4*)(Cf + o) = make_float4(v0, v1, v2, v3);
            else *(uint2*)(Cb + o) = make_uint2(pack2(v0, v1), pack2(v2, v3));
        }
        __syncthreads();
    }
}

DEVINL float hgrn_lb(const Params& p, int l, int c) {
    if (l == 0) return 0.f;
    const float b0 = p.in[I_HLB][c], b1 = p.in[I_HLB][512 + c];
    return 1.0f / (1.0f + __expf(b0 - b1));
}

DEVINL void hgrn_prep_unit(const Params& p, int l, int u, char* lds) {
    const int c = u & 63, h = (u >> 6) & 3, b = u >> 8;
    const int tid = threadIdx.x;
    float* tot = (float*)lds;
    const u16* U = (const u16*)(p.ws + OFF_U);
    u16* QG = (u16*)(p.ws + OFF_HQG) + (size_t)u * 4096;
    u16* QM = (u16*)(p.ws + OFF_HQM) + (size_t)u * 4096;
    u16* KM = (u16*)(p.ws + OFF_HKM) + (size_t)u * 4096;
    u16* KD = (u16*)(p.ws + OFF_HKD) + (size_t)u * 4096;
    float* DS = (float*)(p.ws + OFF_HDS) + (size_t)u * 128;
    const int kp = (tid & 63) * 2, tq = tid >> 6;
    const float lb0 = hgrn_lb(p, l, h * 128 + kp), lb1 = hgrn_lb(p, l, h * 128 + kp + 1);
    const u16* pQ = U + ((size_t)b * SEQ + c * 32 + tq * 8) * DINP + 2048 + h * 128 + kp;
    uint32_t rq[8], rf[8];
#pragma unroll
    for (int i = 0; i < 8; ++i) { rq[i] = *(const uint32_t*)(pQ + (size_t)i * DINP); rf[i] = *(const uint32_t*)(pQ + (size_t)i * DINP + 512); }
    float f0[8], f1[8], L0[8], L1[8];
    {
        float a0 = 0.f, a1 = 0.f;
#pragma unroll
        for (int i = 0; i < 8; ++i) {
            f0[i] = lb0 + (1.f - lb0) * sigmoidf_(lo16(rf[i]));
            f1[i] = lb1 + (1.f - lb1) * sigmoidf_(hi16(rf[i]));
            a0 += __logf(f0[i]); a1 += __logf(f1[i]);
            L0[i] = a0; L1[i] = a1;
        }
        *(float2*)(tot + tq * 128 + kp) = make_float2(a0, a1);
    }
    __syncthreads();
    {
        const float2 t0 = *(const float2*)(tot + kp), t1 = *(const float2*)(tot + 128 + kp), t2 = *(const float2*)(tot + 256 + kp), t3 = *(const float2*)(tot + 384 + kp);
        const float off0 = (tq > 0 ? t0.x : 0.f) + (tq > 1 ? t1.x : 0.f) + (tq > 2 ? t2.x : 0.f);
        const float off1 = (tq > 0 ? t0.y : 0.f) + (tq > 1 ? t1.y : 0.f) + (tq > 2 ? t2.y : 0.f);
        const float ref0 = t0.x + t1.x, ref1 = t0.y + t1.y;
        const float last0 = ref0 + t2.x + t3.x, last1 = ref1 + t2.y + t3.y;
        uint32_t kd[8];
#pragma unroll
        for (int i = 0; i < 8; ++i) {
            const int t = tq * 8 + i;
            const float G0 = L0[i] + off0, G1 = L1[i] + off1;
            const float q0 = lo16(rq[i]), q1 = hi16(rq[i]);
            const float k0 = 1.f - f0[i], k1 = 1.f - f1[i];
            *(uint32_t*)(QG + t * 128 + kp) = pack2(q0 * __expf(G0), q1 * __expf(G1));
            *(uint32_t*)(QM + t * 128 + kp) = pack2(q0 * __expf(fminf(G0 - ref0, 60.f)), q1 * __expf(fminf(G1 - ref1, 60.f)));
            *(uint32_t*)(KM + t * 128 + kp) = pack2(k0 * __expf(fminf(ref0 - G0, 60.f)), k1 * __expf(fminf(ref1 - G1, 60.f)));
            kd[i] = pack2(k0 * __expf(last0 - G0), k1 * __expf(last1 - G1));
        }
        *(uint4*)(KD + kp * 32 + tq * 8) = make_uint4((kd[0] & 0xffffu) | (kd[1] << 16), (kd[2] & 0xffffu) | (kd[3] << 16), (kd[4] & 0xffffu) | (kd[5] << 16), (kd[6] & 0xffffu) | (kd[7] << 16));
        *(uint4*)(KD + (kp + 1) * 32 + tq * 8) = make_uint4((kd[0] >> 16) | (kd[1] & 0xffff0000u), (kd[2] >> 16) | (kd[3] & 0xffff0000u), (kd[4] >> 16) | (kd[5] & 0xffff0000u), (kd[6] >> 16) | (kd[7] & 0xffff0000u));
        if (tq == 0) *(float2*)(DS + kp) = make_float2(__expf(last0), __expf(last1));
    }
    __syncthreads();
}

DEVINL void phase_prep(const Params& p, int l, char* lds) {
    for (int u = blockIdx.x; u < 2048; u += gridDim.x) hgrn_prep_unit(p, l, u, lds);
    const u16* U = (const u16*)(p.ws + OFF_U);
    u16* Ycat = (u16*)(p.ws + OFF_YCAT);
    float* XBC = (float*)(p.ws + OFF_XBC);
    float* DT = (float*)(p.ws + OFF_DT);
    const int tid = threadIdx.x;
#pragma unroll 1
    for (int it = blockIdx.x; it < 1024; it += gridDim.x) {
        const int b = it >> 7, t0 = (it & 127) * 16;
        const size_t r0 = (size_t)b * SEQ + t0;
        if (tid < 64) {
            const int c0 = tid * 8;
            const float* cw = p.in[I_CAW] + (size_t)l * 3 * 512 + c0;
            float w0[8], w1[8], w2[8], pm2[8], pm1[8];
            {
                const float4 a0 = *(const float4*)cw, a1 = *(const float4*)(cw + 4), b0 = *(const float4*)(cw + 512), b1 = *(const float4*)(cw + 516), d0 = *(const float4*)(cw + 1024), d1 = *(const float4*)(cw + 1028);
                w0[0] = a0.x; w0[1] = a0.y; w0[2] = a0.z; w0[3] = a0.w; w0[4] = a1.x; w0[5] = a1.y; w0[6] = a1.z; w0[7] = a1.w;
                w1[0] = b0.x; w1[1] = b0.y; w1[2] = b0.z; w1[3] = b0.w; w1[4] = b1.x; w1[5] = b1.y; w1[6] = b1.z; w1[7] = b1.w;
                w2[0] = d0.x; w2[1] = d0.y; w2[2] = d0.z; w2[3] = d0.w; w2[4] = d1.x; w2[5] = d1.y; w2[6] = d1.z; w2[7] = d1.w;
            }
            if (t0 > 0) {
                const u16* Uq = U + (r0 - 2) * DINP;
                const uint4 h2 = *(const uint4*)(Uq + c0), c2 = *(const uint4*)(Uq + 1024 + c0), h1 = *(const uint4*)(Uq + DINP + c0), c1 = *(const uint4*)(Uq + DINP + 1024 + c0);
                float fh[8], fc[8];
                UNPACK8(h2, fh); UNPACK8(c2, fc);
#pragma unroll
                for (int i = 0; i < 8; ++i) pm2[i] = fc[i] * fh[i];
                UNPACK8(h1, fh); UNPACK8(c1, fc);
#pragma unroll
                for (int i = 0; i < 8; ++i) pm1[i] = fc[i] * fh[i];
            } else {
#pragma unroll
                for (int i = 0; i < 8; ++i) { pm2[i] = 0.f; pm1[i] = 0.f; }
            }
            const float dtb = (tid < 16) ? p.in[I_DTB][l * 16 + tid] : 0.f;
#pragma unroll 4
            for (int j = 0; j < 16; ++j) {
                const u16* Ur = U + (r0 + j) * DINP;
                const uint4 vh = *(const uint4*)(Ur + c0), vc = *(const uint4*)(Ur + 1024 + c0), vb = *(const uint4*)(Ur + 512 + c0), vz = *(const uint4*)(Ur + 1536 + c0);
                float fh[8], fc[8], fb[8], fz[8], pc[8], y[8];
                UNPACK8(vh, fh); UNPACK8(vc, fc); UNPACK8(vb, fb); UNPACK8(vz, fz);
#pragma unroll
                for (int i = 0; i < 8; ++i) {
                    pc[i] = fc[i] * fh[i];
                    const float cv = w0[i] * pm2[i] + w1[i] * pm1[i] + w2[i] * pc[i];
                    y[i] = fb[i] * cv * siluf_(fz[i]);
                    pm2[i] = pm1[i]; pm1[i] = pc[i];
                }
                *(uint4*)(Ycat + (r0 + j) * 2048 + c0) = make_uint4(pack2(y[0], y[1]), pack2(y[2], y[3]), pack2(y[4], y[5]), pack2(y[6], y[7]));
                if (t0 + j >= SEQ - 2) {
                    float* o = p.out + O_CAP + (((size_t)l * 8 + b) * 2 + (t0 + j - (SEQ - 2))) * 512 + c0;
                    *(float4*)o = make_float4(pc[0], pc[1], pc[2], pc[3]);
                    *(float4*)(o + 4) = make_float4(pc[4], pc[5], pc[6], pc[7]);
                }
                if (tid < 16) {
                    const float xx = bf2f(Ur[6656 + tid]) + dtb;
                    DT[(r0 + j) * 16 + tid] = xx > 20.f ? xx : log1pf(__expf(xx));
                }
            }
        } else {
            const int c0 = (tid - 64) * 8;
            const float* cw = p.in[I_SCW] + (size_t)l * 4 * 1536 + c0;
            const float* cb = p.in[I_SCB] + (size_t)l * 1536 + c0;
            float w0[8], w1[8], w2[8], w3[8], bs[8], x3[8], x2[8], x1[8];
#pragma unroll
            for (int i = 0; i < 8; ++i) { w0[i] = cw[i]; w1[i] = cw[1536 + i]; w2[i] = cw[3072 + i]; w3[i] = cw[4608 + i]; bs[i] = cb[i]; }
            if (t0 > 0) {
                const u16* Uq = U + (r0 - 3) * DINP + 5120 + c0;
                const uint4 v3 = *(const uint4*)Uq, v2 = *(const uint4*)(Uq + DINP), v1 = *(const uint4*)(Uq + 2 * (size_t)DINP);
                UNPACK8(v3, x3); UNPACK8(v2, x2); UNPACK8(v1, x1);
            } else {
#pragma unroll
                for (int i = 0; i < 8; ++i) { x3[i] = 0.f; x2[i] = 0.f; x1[i] = 0.f; }
            }
#pragma unroll 4
            for (int j = 0; j < 16; ++j) {
                const uint4 v = *(const uint4*)(U + (r0 + j) * DINP + 5120 + c0);
                float x0[8], y[8];
                UNPACK8(v, x0);
#pragma unroll
                for (int i = 0; i < 8; ++i) {
                    y[i] = siluf_(w0[i] * x3[i] + w1[i] * x2[i] + w2[i] * x1[i] + w3[i] * x0[i] + bs[i]);
                    x3[i] = x2[i]; x2[i] = x1[i]; x1[i] = x0[i];
                }
                *(uint4*)((u16*)(p.ws + OFF_XBCB) + (r0 + j) * 1536 + c0) = make_uint4(pack2(y[0], y[1]), pack2(y[2], y[3]), pack2(y[4], y[5]), pack2(y[6], y[7]));
                if (t0 + j >= SEQ - 3) {
                    float* o = p.out + O_SCP + (((size_t)l * 8 + b) * 3 + (t0 + j - (SEQ - 3))) * 1536 + c0;
                    *(float4*)o = make_float4(x0[0], x0[1], x0[2], x0[3]);
                    *(float4*)(o + 4) = make_float4(x0[4], x0[5], x0[6], x0[7]);
                }
            }
        }
    }
    for (int r = NP + blockIdx.x; r < NR; r += gridDim.x) {
        const bool prompt = false;
        const int t = r & (SEQ - 1), b = r >> 11, s = r - NP;
        const u16* Ur = U + (size_t)r * DINP;
        if (tid < 64) {
            const int c0 = tid * 8;
            float pv[3][8];
#pragma unroll
            for (int j = 0; j < 3; ++j) {
                const int back = 2 - j;
                if (prompt ? (t - back >= 0) : (back == 0)) {
                    const u16* Uq = Ur - (size_t)back * DINP;
                    const uint4 vh = *(const uint4*)(Uq + c0), vc = *(const uint4*)(Uq + 1024 + c0);
                    float fh[8], fc[8]; UNPACK8(vh, fh); UNPACK8(vc, fc);
#pragma unroll
                    for (int i = 0; i < 8; ++i) pv[j][i] = fc[i] * fh[i];
                } else if (prompt) {
#pragma unroll
                    for (int i = 0; i < 8; ++i) pv[j][i] = 0.f;
                } else {
                    const float* st = p.in[I_SCA] + (((size_t)l * NS + s) * 2 + j) * 512 + c0;
                    const float4 a = *(const float4*)st, bb = *(const float4*)(st + 4);
                    pv[j][0] = a.x; pv[j][1] = a.y; pv[j][2] = a.z; pv[j][3] = a.w; pv[j][4] = bb.x; pv[j][5] = bb.y; pv[j][6] = bb.z; pv[j][7] = bb.w;
                }
            }
            const float* cw = p.in[I_CAW] + (size_t)l * 3 * 512 + c0;
            const uint4 vb = *(const uint4*)(Ur + 512 + c0), vz = *(const uint4*)(Ur + 1536 + c0);
            float fb[8], fz[8]; UNPACK8(vb, fb); UNPACK8(vz, fz);
            float y[8];
#pragma unroll
            for (int i = 0; i < 8; ++i) {
                const float cv = cw[i] * pv[0][i] + cw[512 + i] * pv[1][i] + cw[1024 + i] * pv[2][i];
                y[i] = fb[i] * cv * siluf_(fz[i]);
            }
            *(uint4*)(Ycat + (size_t)r * 2048 + c0) = make_uint4(pack2(y[0], y[1]), pack2(y[2], y[3]), pack2(y[4], y[5]), pack2(y[6], y[7]));
            if (prompt) {
                if (t >= SEQ - 2) {
                    float* o = p.out + O_CAP + (((size_t)l * 8 + b) * 2 + (t - (SEQ - 2))) * 512 + c0;
                    *(float4*)o = make_float4(pv[2][0], pv[2][1], pv[2][2], pv[2][3]);
                    *(float4*)(o + 4) = make_float4(pv[2][4], pv[2][5], pv[2][6], pv[2][7]);
                }
            } else {
                float* o = p.out + O_CAS + (((size_t)l * NS + s) * 2) * 512 + c0;
                *(float4*)o = make_float4(pv[1][0], pv[1][1], pv[1][2], pv[1][3]);
                *(float4*)(o + 4) = make_float4(pv[1][4], pv[1][5], pv[1][6], pv[1][7]);
                *(float4*)(o + 512) = make_float4(pv[2][0], pv[2][1], pv[2][2], pv[2][3]);
                *(float4*)(o + 516) = make_float4(pv[2][4], pv[2][5], pv[2][6], pv[2][7]);
            }
        } else {
            const int c0 = (tid - 64) * 8;
            float xv[4][8];
#pragma unroll
            for (int j = 0; j < 4; ++j) {
                const int back = 3 - j;
                if (prompt ? (t - back >= 0) : (back == 0)) {
                    const uint4 v = *(const uint4*)(Ur - (size_t)back * DINP + 5120 + c0);
                    UNPACK8(v, xv[j]);
                } else if (prompt) {
#pragma unroll
                    for (int i = 0; i < 8; ++i) xv[j][i] = 0.f;
                } else {
                    const float* st = p.in[I_SSC] + (((size_t)l * NS + s) * 3 + j) * 1536 + c0;
                    const float4 a = *(const float4*)st, bb = *(const float4*)(st + 4);
                    xv[j][0] = a.x; xv[j][1] = a.y; xv[j][2] = a.z; xv[j][3] = a.w; xv[j][4] = bb.x; xv[j][5] = bb.y; xv[j][6] = bb.z; xv[j][7] = bb.w;
                }
            }
            const float* cw = p.in[I_SCW] + (size_t)l * 4 * 1536 + c0;
            const float* cb = p.in[I_SCB] + (size_t)l * 1536 + c0;
            float y[8];
#pragma unroll
            for (int i = 0; i < 8; ++i) {
                const float cv = cw[i] * xv[0][i] + cw[1536 + i] * xv[1][i] + cw[3072 + i] * xv[2][i] + cw[4608 + i] * xv[3][i] + cb[i];
                y[i] = siluf_(cv);
            }
            if (!prompt) {
                float* xo = XBC + (size_t)r * 1536 + c0;
                *(float4*)xo = make_float4(y[0], y[1], y[2], y[3]);
                *(float4*)(xo + 4) = make_float4(y[4], y[5], y[6], y[7]);
            }
            *(uint4*)((u16*)(p.ws + OFF_XBCB) + (size_t)r * 1536 + c0) = make_uint4(pack2(y[0], y[1]), pack2(y[2], y[3]), pack2(y[4], y[5]), pack2(y[6], y[7]));
            if (prompt) {
                if (t >= SEQ - 3) {
                    float* o = p.out + O_SCP + (((size_t)l * 8 + b) * 3 + (t - (SEQ - 3))) * 1536 + c0;
                    *(float4*)o = make_float4(xv[3][0], xv[3][1], xv[3][2], xv[3][3]);
                    *(float4*)(o + 4) = make_float4(xv[3][4], xv[3][5], xv[3][6], xv[3][7]);
                }
            } else {
                float* o = p.out + O_SCS + (((size_t)l * NS + s) * 3) * 1536 + c0;
#pragma unroll
                for (int j = 0; j < 3; ++j) {
                    *(float4*)(o + j * 1536) = make_float4(xv[j + 1][0], xv[j + 1][1], xv[j + 1][2], xv[j + 1][3]);
                    *(float4*)(o + j * 1536 + 4) = make_float4(xv[j + 1][4], xv[j + 1][5], xv[j + 1][6], xv[j + 1][7]);
                }
            }
        }
        if (tid < 16) {
            const float xx = bf2f(Ur[6656 + tid]) + p.in[I_DTB][l * 16 + tid];
            DT[(size_t)r * 16 + tid] = xx > 20.f ? xx : log1pf(__expf(xx));
        }
    }
}


DEVINL void hgrn_prompt_item(const Params& p, int l, int item, char* lds) {
    const int b = item >> 5, h = (item >> 3) & 3, vs = item & 7;
    const int tid = threadIdx.x, lane = tid & 63, wave = tid >> 6;
    const int vl = wave * 4 + (lane >> 4), kg = lane & 15;
    float* fS = (float*)lds;
    float* qS = fS + 2048;
    float* vS = qS + 2048;
    float* part = vS + 256;
    const u16* U = (const u16*)(p.ws + OFF_U);
    float* OB = (float*)(p.ws + OFF_OB);
    const int tl = tid >> 4, kc = (tid & 15) * 8, vi = tid & 15;
    float lbv[8];
#pragma unroll
    for (int j = 0; j < 8; ++j) lbv[j] = hgrn_lb(p, l, h * 128 + kc + j);
    const size_t rowb = (size_t)b * SEQ;
    const u16* Uq = U + (rowb + tl) * DINP + 2048 + h * 128 + kc;
    const u16* Uv = U + (rowb + tl) * DINP + 3072 + h * 128 + vs * 16 + vi;
    float S[8];
#pragma unroll
    for (int i = 0; i < 8; ++i) S[i] = 0.f;
    uint4 rq = *(const uint4*)Uq, rf = *(const uint4*)(Uq + 512);
    u16 rv = *Uv;
    for (int c = 0; c < SEQ / 16; ++c) {
        {
            float q[8], g[8]; UNPACK8(rq, q); UNPACK8(rf, g);
#pragma unroll
            for (int j = 0; j < 8; ++j) g[j] = lbv[j] + (1.0f - lbv[j]) * sigmoidf_(g[j]);
            *(float4*)(qS + tl * 128 + kc) = make_float4(q[0], q[1], q[2], q[3]);
            *(float4*)(qS + tl * 128 + kc + 4) = make_float4(q[4], q[5], q[6], q[7]);
            *(float4*)(fS + tl * 128 + kc) = make_float4(g[0], g[1], g[2], g[3]);
            *(float4*)(fS + tl * 128 + kc + 4) = make_float4(g[4], g[5], g[6], g[7]);
            vS[tl * 16 + vi] = bf2f(rv);
        }
        if (c + 1 < SEQ / 16) {
            const size_t adv = (size_t)(c + 1) * 16 * DINP;
            rq = *(const uint4*)(Uq + adv); rf = *(const uint4*)(Uq + adv + 512); rv = *(Uv + adv);
        }
        __syncthreads();
#pragma unroll 1
        for (int tg = 0; tg < 16; tg += 4) {
        float pa[4];
#pragma unroll
        for (int tt = 0; tt < 4; ++tt) {
            const int t = tg + tt;
            const float4 f0 = *(const float4*)(fS + t * 128 + kg * 4), f1 = *(const float4*)(fS + t * 128 + 64 + kg * 4);
            const float4 q0 = *(const float4*)(qS + t * 128 + kg * 4), q1 = *(const float4*)(qS + t * 128 + 64 + kg * 4);
            const float vv = vS[t * 16 + vl];
            S[0] = f0.x * S[0] + (1.f - f0.x) * vv; S[1] = f0.y * S[1] + (1.f - f0.y) * vv;
            S[2] = f0.z * S[2] + (1.f - f0.z) * vv; S[3] = f0.w * S[3] + (1.f - f0.w) * vv;
            S[4] = f1.x * S[4] + (1.f - f1.x) * vv; S[5] = f1.y * S[5] + (1.f - f1.y) * vv;
            S[6] = f1.z * S[6] + (1.f - f1.z) * vv; S[7] = f1.w * S[7] + (1.f - f1.w) * vv;
            float a = q0.x * S[0] + q0.y * S[1] + q0.z * S[2] + q0.w * S[3];
            a += q1.x * S[4] + q1.y * S[5] + q1.z * S[6] + q1.w * S[7];
            pa[tt] = a;
        }
#pragma unroll
        for (int tt = 0; tt < 4; ++tt) part[(tg + tt) * 256 + vl * 16 + kg] = pa[tt];
        }
        __syncthreads();
        {
            const float* pp = part + tl * 256 + vi * 16;
            const float4 a = *(const float4*)pp, bq = *(const float4*)(pp + 4), cq = *(const float4*)(pp + 8), dq = *(const float4*)(pp + 12);
            const float o = (a.x + a.y + a.z + a.w) + (bq.x + bq.y + bq.z + bq.w) + (cq.x + cq.y + cq.z + cq.w) + (dq.x + dq.y + dq.z + dq.w);
            OB[(rowb + c * 16 + tl) * 512 + h * 128 + vs * 16 + vi] = o;
        }
    }
    float* so = p.out + O_HGP + (((size_t)l * 8 + b) * 4 + h) * 128 * 128;
#pragma unroll
    for (int i = 0; i < 4; ++i) {
        so[(size_t)(kg * 4 + i) * 128 + vs * 16 + vl] = S[i];
        so[(size_t)(64 + kg * 4 + i) * 128 + vs * 16 + vl] = S[4 + i];
    }
    __syncthreads();
}

DEVINL void ssd_prompt_item(const Params& p, int l, int item, char* lds) {
    const int b = item >> 5, head = (item >> 1) & 15, ph = item & 1, g = head >> 3;
    const int tid = threadIdx.x;
    const int pl = tid >> 3, ng = tid & 7;
    float* Bs = (float*)lds;
    float* Cs = Bs + 2048;
    float* xs = Cs + 2048;
    float* xd = xs + 512;
    float* dcs = xd + 512;
    float* part = dcs + 64;
    const float* XBC = (const float*)(p.ws + OFF_XBC);
    const float* DT = (const float*)(p.ws + OFF_DT);
    const u16* U = (const u16*)(p.ws + OFF_U);
    float* YC = (float*)(p.ws + OFF_YC);
    const float Aneg = -__expf(p.in[I_ALOG][l * 16 + head]);
    const float Dsk = p.in[I_DSK][l * 16 + head];
    const int tl = tid >> 4, nc = (tid & 15) * 8, xc = (tid & 15) * 2;
    const size_t rowb = (size_t)b * SEQ;
    const float* pB = XBC + (rowb + tl) * 1536 + 1024 + g * 128 + nc;
    const float* pX = XBC + (rowb + tl) * 1536 + head * 64 + ph * 32 + xc;
    const float* pD = DT + (rowb + tl) * 16 + head;
    float S[16];
#pragma unroll
    for (int i = 0; i < 16; ++i) S[i] = 0.f;
    float4 rb0 = *(const float4*)pB, rb1 = *(const float4*)(pB + 4), rc0 = *(const float4*)(pB + 256), rc1 = *(const float4*)(pB + 260);
    float2 rx = *(const float2*)pX;
    float rd = *pD;
    for (int c = 0; c < SEQ / 16; ++c) {
        *(float4*)(Bs + tl * 128 + nc) = rb0; *(float4*)(Bs + tl * 128 + nc + 4) = rb1;
        *(float4*)(Cs + tl * 128 + nc) = rc0; *(float4*)(Cs + tl * 128 + nc + 4) = rc1;
        xs[tl * 32 + xc] = rx.x; xs[tl * 32 + xc + 1] = rx.y;
        xd[tl * 32 + xc] = rx.x * rd; xd[tl * 32 + xc + 1] = rx.y * rd;
        if ((tid & 15) == 0) dcs[tl] = __expf(rd * Aneg);
        if (c + 1 < SEQ / 16) {
            const size_t adv = (size_t)(c + 1) * 16;
            const float* qB = pB + adv * 1536;
            rb0 = *(const float4*)qB; rb1 = *(const float4*)(qB + 4); rc0 = *(const float4*)(qB + 256); rc1 = *(const float4*)(qB + 260);
            rx = *(const float2*)(pX + adv * 1536);
            rd = *(pD + adv * 16);
        }
        __syncthreads();
#pragma unroll 1
        for (int tg = 0; tg < 16; tg += 4) {
        float pa[4];
#pragma unroll
        for (int tt = 0; tt < 4; ++tt) {
            const int t = tg + tt;
            const float dec = dcs[t], xdt = xd[t * 32 + pl];
            float a = 0.f;
#pragma unroll
            for (int j = 0; j < 4; ++j) {
                const float4 Bv = *(const float4*)(Bs + t * 128 + j * 32 + ng * 4);
                const float4 Cv = *(const float4*)(Cs + t * 128 + j * 32 + ng * 4);
                S[j * 4 + 0] = dec * S[j * 4 + 0] + xdt * Bv.x; S[j * 4 + 1] = dec * S[j * 4 + 1] + xdt * Bv.y;
                S[j * 4 + 2] = dec * S[j * 4 + 2] + xdt * Bv.z; S[j * 4 + 3] = dec * S[j * 4 + 3] + xdt * Bv.w;
                a += Cv.x * S[j * 4 + 0] + Cv.y * S[j * 4 + 1] + Cv.z * S[j * 4 + 2] + Cv.w * S[j * 4 + 3];
            }
            pa[tt] = a;
        }
#pragma unroll
        for (int tt = 0; tt < 4; ++tt) part[(tg + tt) * 256 + tid] = pa[tt];
        }
        __syncthreads();
#pragma unroll
        for (int i = 0; i < 2; ++i) {
            const int idx = tid + 256 * i, t2 = idx >> 5, p2 = idx & 31;
            const float4 a = *(const float4*)(part + t2 * 256 + p2 * 8), bq = *(const float4*)(part + t2 * 256 + p2 * 8 + 4);
            const float y = (a.x + a.y + a.z + a.w) + (bq.x + bq.y + bq.z + bq.w) + Dsk * xs[t2 * 32 + p2];
            const size_t row = rowb + c * 16 + t2;
            const float z = bf2f(U[row * DINP + 4096 + head * 64 + ph * 32 + p2]);
            YC[row * 1024 + head * 64 + ph * 32 + p2] = y * siluf_(z);
        }
        __syncthreads();
    }
    float* so = p.out + O_SSP + ((((size_t)l * 8 + b) * 16 + head) * 64 + ph * 32 + pl) * 128;
#pragma unroll
    for (int j = 0; j < 4; ++j) *(float4*)(so + j * 32 + ng * 4) = make_float4(S[j * 4], S[j * 4 + 1], S[j * 4 + 2], S[j * 4 + 3]);
}

DEVINL void hgrn_sample_item(const Params& p, int l, int item, char* lds) {
    const int s = item >> 2, h = item & 3;
    const int tid = threadIdx.x;
    float* qs = (float*)lds; float* fs = qs + 128; float* vs = fs + 128; float* red = vs + 128;
    const u16* Ur = (const u16*)(p.ws + OFF_U) + (size_t)(NP + s) * DINP;
    if (tid < 128) {
        qs[tid] = bf2f(Ur[2048 + h * 128 + tid]);
        const float lb = hgrn_lb(p, l, h * 128 + tid);
        fs[tid] = lb + (1.f - lb) * sigmoidf_(bf2f(Ur[2560 + h * 128 + tid]));
        vs[tid] = bf2f(Ur[3072 + h * 128 + tid]);
    }
    __syncthreads();
    const int v4 = (tid & 31) * 4, kr = tid >> 5;
    const size_t sb = (((size_t)l * NS + s) * 4 + h) * 128 * 128;
    const float* Sin = p.in[I_SHG] + sb;
    float* Sout = p.out + O_HGS + sb;
    const float4 vv = *(const float4*)(vs + v4);
    float4 acc = make_float4(0.f, 0.f, 0.f, 0.f);
#pragma unroll 1
    for (int hb = 0; hb < 2; ++hb) {
        float4 so[8];
#pragma unroll
        for (int i = 0; i < 8; ++i) so[i] = ldnt4(Sin + (size_t)(kr + 8 * (hb * 8 + i)) * 128 + v4);
#pragma unroll
        for (int i = 0; i < 8; ++i) {
            const int k = kr + 8 * (hb * 8 + i);
            const float f = fs[k], kk = 1.f - f, q = qs[k];
            float4 sn;
            sn.x = f * so[i].x + kk * vv.x; sn.y = f * so[i].y + kk * vv.y; sn.z = f * so[i].z + kk * vv.z; sn.w = f * so[i].w + kk * vv.w;
            stnt4(Sout + (size_t)k * 128 + v4, sn);
            acc.x += q * sn.x; acc.y += q * sn.y; acc.z += q * sn.z; acc.w += q * sn.w;
        }
    }
    *(float4*)(red + kr * 128 + v4) = acc;
    __syncthreads();
    if (tid < 128) {
        float o = 0.f;
#pragma unroll
        for (int i = 0; i < 8; ++i) o += red[i * 128 + tid];
        ((u16*)(p.ws + OFF_OB))[(size_t)(NP + s) * 512 + h * 128 + tid] = (u16)f2bf(o);
    }
    __syncthreads();
}

DEVINL void ssd_sample_item(const Params& p, int l, int item) {
    const int s = item >> 4, head = item & 15, g = head >> 3;
    const int tid = threadIdx.x;
    const size_t row = NP + s;
    const float* xr = (const float*)(p.ws + OFF_XBC) + row * 1536;
    const float dt = ((const float*)(p.ws + OFF_DT))[row * 16 + head];
    const float dec = __expf(-__expf(p.in[I_ALOG][l * 16 + head]) * dt);
    const float Dsk = p.in[I_DSK][l * 16 + head];
    const int n4 = (tid & 31) * 4, pr = tid >> 5;
    const float4 Bv = *(const float4*)(xr + 1024 + g * 128 + n4), Cv = *(const float4*)(xr + 1280 + g * 128 + n4);
    const size_t sb = (((size_t)l * NS + s) * 16 + head) * 64 * 128;
    const float* Sin = p.in[I_SSS] + sb;
    float* Sout = p.out + O_SSS + sb;
    const u16* Ur = (const u16*)(p.ws + OFF_U) + row * DINP;
    u16* YC = (u16*)(p.ws + OFF_YC);
    float4 so[8];
#pragma unroll
    for (int i = 0; i < 8; ++i) so[i] = ldnt4(Sin + (size_t)(pr + 8 * i) * 128 + n4);
#pragma unroll
    for (int i = 0; i < 8; ++i) {
        const int pp = pr + 8 * i;
        const float x = xr[head * 64 + pp], xdt = x * dt;
        float4 sn;
        sn.x = dec * so[i].x + xdt * Bv.x; sn.y = dec * so[i].y + xdt * Bv.y; sn.z = dec * so[i].z + xdt * Bv.z; sn.w = dec * so[i].w + xdt * Bv.w;
        stnt4(Sout + (size_t)pp * 128 + n4, sn);
        float a = Cv.x * sn.x + Cv.y * sn.y + Cv.z * sn.z + Cv.w * sn.w;
#pragma unroll
        for (int o = 16; o; o >>= 1) a += __shfl_xor(a, o);
        if ((tid & 31) == 0) {
            const float y = a + Dsk * x;
            const float z = bf2f(Ur[4096 + head * 64 + pp]);
            YC[row * 1024 + head * 64 + pp] = (u16)f2bf(y * siluf_(z));
        }
    }
}


DEVINL bf16x8 ldfrag(const u16* base, int ld, int row, int k) { return *(const bf16x8*)(base + row * ld + k); }
DEVINL void st4bf(u16* dst, float a, float b, float c, float d) { *(uint2*)dst = make_uint2(pack2(a, b), pack2(c, d)); }

DEVINL void ssd_prompt_mfma(const Params& p, int l, int item, char* lds) {
    const int b = item >> 5, head = (item >> 1) & 15, ph = item & 1, g = head >> 3;
    const int tid = threadIdx.x, lane = tid & 63, w = tid >> 6, fr = lane & 15, fq = lane >> 4;
    u16* Cs = (u16*)lds;
    u16* Bs = Cs + 32 * 136;
    u16* Sb = Bs + 32 * 136;
    u16* BT = Sb + 32 * 136;
    u16* XT = BT + 128 * 40;
    u16* XW = XT + 32 * 40;
    u16* Ms = XW + 32 * 40;
    float* csS = (float*)(Ms + 32 * 40);
    float* dtS = csS + 32;
    const u16* XB = (const u16*)(p.ws + OFF_XBCB);
    const float* DT = (const float*)(p.ws + OFF_DT);
    const u16* U = (const u16*)(p.ws + OFF_U);
    u16* YC = (u16*)(p.ws + OFF_YC);
    const float Aneg = -__expf(p.in[I_ALOG][l * 16 + head]);
    const float Dsk = p.in[I_DSK][l * 16 + head];
    const size_t rowb = (size_t)b * SEQ;
    const int srow = tid >> 3, sc = tid & 7;
    const int ti = w >> 1, pi = w & 1;
    for (int i = tid; i < 32 * 136 / 2; i += 256) ((uint32_t*)Sb)[i] = 0u;
    f32x4 Sacc[2][2];
#pragma unroll
    for (int a = 0; a < 2; ++a)
#pragma unroll
        for (int c = 0; c < 2; ++c) Sacc[a][c] = (f32x4){0.f, 0.f, 0.f, 0.f};
    const u16* pC = XB + (rowb + srow) * 1536 + 1280 + g * 128 + sc * 16;
    const u16* pB = XB + (rowb + srow) * 1536 + 1024 + g * 128 + sc * 16;
    const u16* pX = XB + (rowb + srow) * 1536 + head * 64 + ph * 32 + sc * 4;
    const float* pD = DT + (rowb + (lane & 31)) * 16 + head;
    const u16* pZ = U + (rowb + ti * 16 + fr) * DINP + 4096 + head * 64 + ph * 32 + pi * 16 + fq * 4;
    const u16* pXs = XB + (rowb + ti * 16 + fr) * 1536 + head * 64 + ph * 32 + pi * 16 + fq * 4;
#define SSD_LD(S, CC) do { const size_t adv = (size_t)(CC) * 32; \
        S##C0 = *(const uint4*)(pC + adv * 1536); S##C1 = *(const uint4*)(pC + adv * 1536 + 8); \
        S##B0 = *(const uint4*)(pB + adv * 1536); S##B1 = *(const uint4*)(pB + adv * 1536 + 8); \
        S##x = *(const uint2*)(pX + adv * 1536); S##z = *(const uint2*)(pZ + adv * DINP); S##xs = *(const uint2*)(pXs + adv * 1536); \
        S##dt = *(pD + adv * 16); } while (0)
    uint4 aC0, aC1, aB0, aB1, bC0, bC1, bB0, bB1; uint2 ax, az, axs, bx, bz, bxs; float adt, bdt;
    SSD_LD(a, 0); SSD_LD(b, 1);
    auto stage = [&](uint4 rC0, uint4 rC1, uint4 rB0, uint4 rB1, float rdt) __attribute__((always_inline)) {
        *(uint4*)(Cs + srow * 136 + sc * 16) = rC0; *(uint4*)(Cs + srow * 136 + sc * 16 + 8) = rC1;
        *(uint4*)(Bs + srow * 136 + sc * 16) = rB0; *(uint4*)(Bs + srow * 136 + sc * 16 + 8) = rB1;
        {
            const uint32_t bw[8] = {rB0.x, rB0.y, rB0.z, rB0.w, rB1.x, rB1.y, rB1.z, rB1.w};
#pragma unroll
            for (int j = 0; j < 8; ++j) {
                BT[(sc * 16 + 2 * j) * 40 + srow] = (u16)(bw[j] & 0xffffu);
                BT[(sc * 16 + 2 * j + 1) * 40 + srow] = (u16)(bw[j] >> 16);
            }
        }
        if (w == 0) {
            float a = rdt * Aneg;
#pragma unroll
            for (int o = 1; o < 32; o <<= 1) { const float v = __shfl_up(a, o); if ((lane & 31) >= o) a += v; }
            if (lane < 32) { csS[lane] = a; dtS[lane] = rdt; }
        }
    };
    auto rest = [&](int c, uint2 cx, uint2 cz, uint2 cxs) __attribute__((always_inline)) {
        lds_barrier();
        const float cs31 = csS[31];
        {
            const float wgt = dtS[srow] * __expf(cs31 - csS[srow]);
            const float x0 = lo16(cx.x), x1 = hi16(cx.x), x2 = lo16(cx.y), x3 = hi16(cx.y);
            XT[(sc * 4 + 0) * 40 + srow] = (u16)(cx.x & 0xffffu); XT[(sc * 4 + 1) * 40 + srow] = (u16)(cx.x >> 16);
            XT[(sc * 4 + 2) * 40 + srow] = (u16)(cx.y & 0xffffu); XT[(sc * 4 + 3) * 40 + srow] = (u16)(cx.y >> 16);
            XW[(sc * 4 + 0) * 40 + srow] = (u16)f2bf(x0 * wgt); XW[(sc * 4 + 1) * 40 + srow] = (u16)f2bf(x1 * wgt);
            XW[(sc * 4 + 2) * 40 + srow] = (u16)f2bf(x2 * wgt); XW[(sc * 4 + 3) * 40 + srow] = (u16)f2bf(x3 * wgt);
        }
        {
            const int t = ti * 16 + fr, s0 = pi * 16 + fq * 4;
            if (pi <= ti) {
                f32x4 acc = (f32x4){0.f, 0.f, 0.f, 0.f};
#pragma unroll
                for (int ks = 0; ks < 4; ++ks)
                    acc = __builtin_amdgcn_mfma_f32_16x16x32_bf16(ldfrag(Bs, 136, pi * 16 + fr, ks * 32 + fq * 8), ldfrag(Cs, 136, ti * 16 + fr, ks * 32 + fq * 8), acc, 0, 0, 0);
                const float cst = csS[t];
                float m[4];
#pragma unroll
                for (int r = 0; r < 4; ++r) { const int s = s0 + r; m[r] = (s <= t) ? acc[r] * __expf(cst - csS[s]) * dtS[s] : 0.f; }
                st4bf(Ms + t * 40 + s0, m[0], m[1], m[2], m[3]);
            } else {
                *(uint2*)(Ms + t * 40 + s0) = make_uint2(0u, 0u);
            }
        }
        lds_barrier();
        {
            f32x4 ad = __builtin_amdgcn_mfma_f32_16x16x32_bf16(ldfrag(XT, 40, pi * 16 + fr, fq * 8), ldfrag(Ms, 40, ti * 16 + fr, fq * 8), (f32x4){0.f, 0.f, 0.f, 0.f}, 0, 0, 0);
            f32x4 ao = (f32x4){0.f, 0.f, 0.f, 0.f};
#pragma unroll
            for (int ks = 0; ks < 4; ++ks)
                ao = __builtin_amdgcn_mfma_f32_16x16x32_bf16(ldfrag(Sb, 136, pi * 16 + fr, ks * 32 + fq * 8), ldfrag(Cs, 136, ti * 16 + fr, ks * 32 + fq * 8), ao, 0, 0, 0);
            const int t = ti * 16 + fr;
            const float e = __expf(csS[t]);
            const float xs0 = lo16(cxs.x), xs1 = hi16(cxs.x), xs2 = lo16(cxs.y), xs3 = hi16(cxs.y);
            const float z0 = lo16(cz.x), z1 = hi16(cz.x), z2 = lo16(cz.y), z3 = hi16(cz.y);
            float4 y;
            y.x = (ad[0] + e * ao[0] + Dsk * xs0) * siluf_(z0);
            y.y = (ad[1] + e * ao[1] + Dsk * xs1) * siluf_(z1);
            y.z = (ad[2] + e * ao[2] + Dsk * xs2) * siluf_(z2);
            y.w = (ad[3] + e * ao[3] + Dsk * xs3) * siluf_(z3);
            *(uint2*)(YC + (rowb + (size_t)c * 32 + t) * 1024 + head * 64 + ph * 32 + pi * 16 + fq * 4) = make_uint2(pack2(y.x, y.y), pack2(y.z, y.w));
        }
        {
            const float e31 = __expf(cs31);
#pragma unroll
            for (int a = 0; a < 2; ++a) {
                const bf16x8 bt = ldfrag(BT, 40, (2 * w + a) * 16 + fr, fq * 8);
#pragma unroll
                for (int pt = 0; pt < 2; ++pt) {
                    f32x4 s = Sacc[a][pt];
                    s[0] *= e31; s[1] *= e31; s[2] *= e31; s[3] *= e31;
                    Sacc[a][pt] = __builtin_amdgcn_mfma_f32_16x16x32_bf16(bt, ldfrag(XW, 40, pt * 16 + fr, fq * 8), s, 0, 0, 0);
                }
            }
        }
        lds_barrier();
#pragma unroll
        for (int a = 0; a < 2; ++a)
#pragma unroll
            for (int pt = 0; pt < 2; ++pt)
                st4bf(Sb + (pt * 16 + fr) * 136 + (2 * w + a) * 16 + fq * 4, Sacc[a][pt][0], Sacc[a][pt][1], Sacc[a][pt][2], Sacc[a][pt][3]);
    };
#pragma unroll 1
    for (int c = 0; c < SEQ / 32; c += 2) {
        { stage(aC0, aC1, aB0, aB1, adt); const uint2 cx = ax, cz = az, cxs = axs; if (c + 2 < SEQ / 32) SSD_LD(a, c + 2); rest(c, cx, cz, cxs); }
        { stage(bC0, bC1, bB0, bB1, bdt); const uint2 cx = bx, cz = bz, cxs = bxs; if (c + 3 < SEQ / 32) SSD_LD(b, c + 3); rest(c + 1, cx, cz, cxs); }
    }
#undef SSD_LD
    float* so = p.out + O_SSP + ((((size_t)l * 8 + b) * 16 + head) * 64 + ph * 32) * 128;
#pragma unroll
    for (int a = 0; a < 2; ++a)
#pragma unroll
        for (int pt = 0; pt < 2; ++pt)
            *(float4*)(so + (size_t)(pt * 16 + fr) * 128 + (2 * w + a) * 16 + fq * 4) = make_float4(Sacc[a][pt][0], Sacc[a][pt][1], Sacc[a][pt][2], Sacc[a][pt][3]);
    __syncthreads();
}

DEVINL void hgrn_prompt_mfma(const Params& p, int l, int item, char* lds) {
    const int b = item >> 4, h = (item >> 2) & 3, vq = item & 3;
    const int tid = threadIdx.x, lane = tid & 63, w = tid >> 6, fr = lane & 15, fq = lane >> 4;
    u16* Qg = (u16*)lds;
    u16* Qm = Qg + 32 * 136;
    u16* Km = Qm + 32 * 136;
    u16* ST = Km + 32 * 136;
    u16* KdT = ST + 32 * 136;
    u16* VT = KdT + 128 * 40;
    u16* As = VT + 32 * 40;
    float* dS = (float*)(As + 32 * 40);
    const u16* U = (const u16*)(p.ws + OFF_U);
    u16* OB = (u16*)(p.ws + OFF_OB);
    const size_t rowb = (size_t)b * SEQ;
    const size_t u0 = (size_t)(b * 4 + h) * 64;
    const u16* gQG = (const u16*)(p.ws + OFF_HQG) + u0 * 4096;
    const u16* gQM = (const u16*)(p.ws + OFF_HQM) + u0 * 4096;
    const u16* gKM = (const u16*)(p.ws + OFF_HKM) + u0 * 4096;
    const u16* gKD = (const u16*)(p.ws + OFF_HKD) + u0 * 4096;
    const float* gDS = (const float*)(p.ws + OFF_HDS) + u0 * 128;
    const int vrow = tid >> 3, v4 = (tid & 7) * 4;
    const int ti = w >> 1, ji = w & 1;
    const int r0 = tid >> 4, c0 = (tid & 15) * 8;
    const int k0 = tid >> 2, p0 = (tid & 3) * 8;
    for (int i = tid; i < 32 * 136 / 2; i += 256) ((uint32_t*)ST)[i] = 0u;
    f32x4 Sacc[2][2];
#pragma unroll
    for (int a = 0; a < 2; ++a)
#pragma unroll
        for (int c = 0; c < 2; ++c) Sacc[a][c] = (f32x4){0.f, 0.f, 0.f, 0.f};
    const u16* pV = U + (rowb + vrow) * DINP + 3072 + h * 128 + vq * 32 + v4;
    const int gi0 = r0 * 128 + c0, gi1 = (r0 + 16) * 128 + c0, gk0 = k0 * 32 + p0, gk1 = (k0 + 64) * 32 + p0;
    const int li0 = r0 * 136 + c0, li1 = (r0 + 16) * 136 + c0, lk0 = k0 * 40 + p0, lk1 = (k0 + 64) * 40 + p0;
#define HG_LD(S, CC) do { const size_t au = (size_t)(CC) * 4096; \
        S##g0 = *(const uint4*)(gQG + au + gi0); S##g1 = *(const uint4*)(gQG + au + gi1); S##m0 = *(const uint4*)(gQM + au + gi0); S##m1 = *(const uint4*)(gQM + au + gi1); \
        S##k0 = *(const uint4*)(gKM + au + gi0); S##k1 = *(const uint4*)(gKM + au + gi1); S##d0 = *(const uint4*)(gKD + au + gk0); S##d1 = *(const uint4*)(gKD + au + gk1); \
        S##ds = *(const float4*)(gDS + (size_t)(CC) * 128 + (tid & 31) * 4); S##v = *(const uint2*)(pV + (size_t)(CC) * 32 * DINP); } while (0)
    uint4 ag0, ag1, am0, am1, ak0, ak1, ad0, ad1, bg0, bg1, bm0, bm1, bk0, bk1, bd0, bd1; float4 ads, bds; uint2 av, bv;
    HG_LD(a, 0); HG_LD(b, 1);
    auto stage = [&](uint4 g0, uint4 g1, uint4 m0, uint4 m1, uint4 kk0, uint4 kk1, uint4 d0, uint4 d1, float4 ds, uint2 rv) __attribute__((always_inline)) {
        *(uint4*)(Qg + li0) = g0; *(uint4*)(Qg + li1) = g1; *(uint4*)(Qm + li0) = m0; *(uint4*)(Qm + li1) = m1;
        *(uint4*)(Km + li0) = kk0; *(uint4*)(Km + li1) = kk1; *(uint4*)(KdT + lk0) = d0; *(uint4*)(KdT + lk1) = d1;
        if (tid < 32) *(float4*)(dS + tid * 4) = ds;
        VT[(v4 + 0) * 40 + vrow] = (u16)(rv.x & 0xffffu); VT[(v4 + 1) * 40 + vrow] = (u16)(rv.x >> 16);
        VT[(v4 + 2) * 40 + vrow] = (u16)(rv.y & 0xffffu); VT[(v4 + 3) * 40 + vrow] = (u16)(rv.y >> 16);
    };
    auto rest = [&](int c) __attribute__((always_inline)) {
        lds_barrier();
        {
            const int t = ti * 16 + fr, j0 = ji * 16 + fq * 4;
            if (ji <= ti) {
                f32x4 acc = (f32x4){0.f, 0.f, 0.f, 0.f};
#pragma unroll
                for (int ks = 0; ks < 4; ++ks)
                    acc = __builtin_amdgcn_mfma_f32_16x16x32_bf16(ldfrag(Km, 136, ji * 16 + fr, ks * 32 + fq * 8), ldfrag(Qm, 136, ti * 16 + fr, ks * 32 + fq * 8), acc, 0, 0, 0);
                st4bf(As + t * 40 + j0, (j0 + 0 <= t) ? acc[0] : 0.f, (j0 + 1 <= t) ? acc[1] : 0.f, (j0 + 2 <= t) ? acc[2] : 0.f, (j0 + 3 <= t) ? acc[3] : 0.f);
            } else {
                *(uint2*)(As + t * 40 + j0) = make_uint2(0u, 0u);
            }
        }
        lds_barrier();
        {
            const int vi = ji;
            f32x4 acc = __builtin_amdgcn_mfma_f32_16x16x32_bf16(ldfrag(VT, 40, vi * 16 + fr, fq * 8), ldfrag(As, 40, ti * 16 + fr, fq * 8), (f32x4){0.f, 0.f, 0.f, 0.f}, 0, 0, 0);
#pragma unroll
            for (int ks = 0; ks < 4; ++ks)
                acc = __builtin_amdgcn_mfma_f32_16x16x32_bf16(ldfrag(ST, 136, vi * 16 + fr, ks * 32 + fq * 8), ldfrag(Qg, 136, ti * 16 + fr, ks * 32 + fq * 8), acc, 0, 0, 0);
            *(uint2*)(OB + (rowb + (size_t)c * 32 + ti * 16 + fr) * 512 + h * 128 + vq * 32 + vi * 16 + fq * 4) = make_uint2(pack2(acc[0], acc[1]), pack2(acc[2], acc[3]));
        }
#pragma unroll
        for (int a = 0; a < 2; ++a) {
            const int kt = 2 * w + a;
            const bf16x8 kf = ldfrag(KdT, 40, kt * 16 + fr, fq * 8);
            const float4 dd = *(const float4*)(dS + kt * 16 + fq * 4);
#pragma unroll
            for (int vt = 0; vt < 2; ++vt) {
                f32x4 s = Sacc[a][vt];
                s[0] *= dd.x; s[1] *= dd.y; s[2] *= dd.z; s[3] *= dd.w;
                Sacc[a][vt] = __builtin_amdgcn_mfma_f32_16x16x32_bf16(kf, ldfrag(VT, 40, vt * 16 + fr, fq * 8), s, 0, 0, 0);
            }
        }
        lds_barrier();
#pragma unroll
        for (int a = 0; a < 2; ++a)
#pragma unroll
            for (int vt = 0; vt < 2; ++vt)
                st4bf(ST + (vt * 16 + fr) * 136 + (2 * w + a) * 16 + fq * 4, Sacc[a][vt][0], Sacc[a][vt][1], Sacc[a][vt][2], Sacc[a][vt][3]);
    };
#pragma unroll 1
    for (int c = 0; c < SEQ / 32; c += 2) {
        stage(ag0, ag1, am0, am1, ak0, ak1, ad0, ad1, ads, av); if (c + 2 < SEQ / 32) HG_LD(a, c + 2); rest(c);
        stage(bg0, bg1, bm0, bm1, bk0, bk1, bd0, bd1, bds, bv); if (c + 3 < SEQ / 32) HG_LD(b, c + 3); rest(c + 1);
    }
#undef HG_LD
    float* so = p.out + O_HGP + (((size_t)l * 8 + b) * 4 + h) * 128 * 128;
#pragma unroll
    for (int a = 0; a < 2; ++a)
#pragma unroll
        for (int vt = 0; vt < 2; ++vt)
#pragma unroll
            for (int r = 0; r < 4; ++r)
                so[(size_t)((2 * w + a) * 16 + fq * 4 + r) * 128 + vq * 32 + vt * 16 + fr] = Sacc[a][vt][r];
    __syncthreads();
}

DEVINL int scan_next_item(unsigned* ctr, int* slot) {
    __syncthreads();
    if (threadIdx.x == 0) *slot = (int)gridDim.x + (int)__hip_atomic_fetch_add(ctr, 1u, __ATOMIC_RELAXED, __HIP_MEMORY_SCOPE_AGENT);
    __syncthreads();
    return *slot;
}
DEVINL void phase_scan(const Params& p, int l, char* lds) {
    unsigned* ctr = (unsigned*)(p.ws + OFF_BAR) + 3520 + l * 64;
    __shared__ int nxt_item;
    int it = blockIdx.x;
#pragma unroll 1
    while (it < 256) { ssd_prompt_mfma(p, l, it, lds); it = scan_next_item(ctr, &nxt_item); }
#pragma unroll 1
    while (it < 384) { hgrn_prompt_mfma(p, l, it - 256, lds); it = scan_next_item(ctr, &nxt_item); }
#pragma unroll 1
    while (it < 896) { hgrn_sample_item(p, l, it - 384, lds); it = scan_next_item(ctr, &nxt_item); }
#pragma unroll 1
    while (it < 2944) { ssd_sample_item(p, l, it - 896); it = scan_next_item(ctr, &nxt_item); }
}

DEVINL void phase_mixnorm(const Params& p, int l) {
    const int wave = threadIdx.x >> 6, lane = threadIdx.x & 63;
    const u16* OB = (const u16*)(p.ws + OFF_OB);
    const u16* YC = (const u16*)(p.ws + OFF_YC);
    const u16* U = (const u16*)(p.ws + OFF_U);
    u16* Ycat = (u16*)(p.ws + OFF_YCAT);
    const float* gn = p.in[I_HGN] + (size_t)l * 512;
    const float* sn = p.in[I_SNORM] + (size_t)l * 1024;
    for (int it = blockIdx.x; it < NR / 4; it += gridDim.x) {
        const size_t r = (size_t)it * 4 + wave;
        {
            const uint4 ov = ldnt16(OB + r * 512 + lane * 8);
            float x[8]; UNPACK8(ov, x);
            float ss = 0.f;
#pragma unroll
            for (int i = 0; i < 8; ++i) ss += x[i] * x[i];
            ss += __shfl_xor(ss, 1); ss += __shfl_xor(ss, 2); ss += __shfl_xor(ss, 4); ss += __shfl_xor(ss, 8);
            const float rstd = rsqrtf(ss * (1.0f / 128.0f) + EPS);
            const uint4 zz = *(const uint4*)(U + r * DINP + 3584 + lane * 8);
            float z[8]; UNPACK8(zz, z);
            const float4 g0 = *(const float4*)(gn + lane * 8), g1 = *(const float4*)(gn + lane * 8 + 4);
            const float gg[8] = {g0.x, g0.y, g0.z, g0.w, g1.x, g1.y, g1.z, g1.w};
            float y[8];
#pragma unroll
            for (int i = 0; i < 8; ++i) y[i] = x[i] * rstd * gg[i] * siluf_(z[i]);
            *(uint4*)(Ycat + r * 2048 + 512 + lane * 8) = make_uint4(pack2(y[0], y[1]), pack2(y[2], y[3]), pack2(y[4], y[5]), pack2(y[6], y[7]));
        }
        {
            float x[16];
#pragma unroll
            for (int h = 0; h < 2; ++h) {
                const uint4 yv = ldnt16(YC + r * 1024 + h * 512 + lane * 8);
                x[h * 8 + 0] = lo16(yv.x); x[h * 8 + 1] = hi16(yv.x); x[h * 8 + 2] = lo16(yv.y); x[h * 8 + 3] = hi16(yv.y); x[h * 8 + 4] = lo16(yv.z); x[h * 8 + 5] = hi16(yv.z); x[h * 8 + 6] = lo16(yv.w); x[h * 8 + 7] = hi16(yv.w);
            }
            float ss = 0.f;
#pragma unroll
            for (int i = 0; i < 16; ++i) ss += x[i] * x[i];
            ss = wave_sum(ss);
            const float rstd = rsqrtf(ss * (1.0f / 1024.0f) + EPS);
#pragma unroll
            for (int h = 0; h < 2; ++h) {
                const float4 g0 = *(const float4*)(sn + h * 512 + lane * 8), g1 = *(const float4*)(sn + h * 512 + lane * 8 + 4);
                uint4 o;
                o.x = pack2(x[h * 8 + 0] * rstd * g0.x, x[h * 8 + 1] * rstd * g0.y);
                o.y = pack2(x[h * 8 + 2] * rstd * g0.z, x[h * 8 + 3] * rstd * g0.w);
                o.z = pack2(x[h * 8 + 4] * rstd * g1.x, x[h * 8 + 5] * rstd * g1.y);
                o.w = pack2(x[h * 8 + 6] * rstd * g1.z, x[h * 8 + 7] * rstd * g1.w);
                *(uint4*)(Ycat + r * 2048 + 1024 + h * 512 + lane * 8) = o;
            }
        }
    }
}

DEVINL void phase_rowpass(const Params& p, int l, int which) {
    const int wave = threadIdx.x >> 6, lane = threadIdx.x & 63;
    float* X = (float*)(p.ws + OFF_X);
    const u16* T = (const u16*)(p.ws + OFF_T);
    u16* Hb = (u16*)(p.ws + OFF_HB);
    u16* Mb = (u16*)(p.ws + OFF_MB);
    const bool last = (which == 1 && l == 1);
    const float* gpost = p.in[which == 0 ? I_GQM : I_GQX] + (size_t)l * 1024;
    const float* gnext = which == 0 ? p.in[I_GPX] + (size_t)l * 1024 : (last ? nullptr : p.in[I_GPM] + (size_t)(l + 1) * 1024);
    const int nrows = (which == 1 && !last) ? NR + 2048 : NR;
    for (int it = blockIdx.x; it < nrows / 4; it += gridDim.x) {
        const int r = it * 4 + wave;
        if (r < NR) {
            float* xd = X + (size_t)r * 1024;
            if (last) xd = r < NP ? p.out + O_YP + (size_t)r * 1024 : p.out + O_YS + (size_t)(r - NP) * 1024;
            const float* xb = X + (size_t)r * 1024;
            if (which == 0 && l == 0) xb = r < NP ? p.in[I_XP] + (size_t)r * 1024 : p.in[I_XS] + (size_t)(r - NP) * 1024;
            rowpass_row(xb, T + (size_t)r * 1024, gpost, xd, gnext, Hb + (size_t)r * 1024, lane, last);
        } else {
            const int m = r - NR;
            rowpass_row(p.in[I_MEM] + (size_t)m * 1024, nullptr, nullptr, nullptr, p.in[I_GMEM] + (size_t)(l + 1) * 1024, Mb + (size_t)m * 1024, lane);
        }
    }
}

DEVINL void attn_prompt_item(const Params& p, int item, char* lds) {
    const int b = item >> 6, h = (item >> 4) & 3, qt = item & 15;
    const int tid = threadIdx.x, lane = tid & 63, wave = tid >> 6;
    const u16* Qt = (const u16*)(p.ws + OFF_Q) + ((size_t)b * SEQ + qt * 128) * 1024 + h * 256;
    const u16* Kb = (const u16*)(p.ws + OFF_MK) + (size_t)b * 256 * 1024 + h * 256;
    const u16* Vt = (const u16*)(p.ws + OFF_MVT) + (size_t)(b * 4 + h) * 256 * 256;
    float* Ss = (float*)(p.ws + OFF_SCR + (size_t)blockIdx.x * SCR_PER_BLOCK);
    u16* Ps = (u16*)((char*)Ss + 128 * 256 * 4);
    u16* Ob = (u16*)(p.ws + OFF_O) + ((size_t)b * SEQ + qt * 128) * 1024 + h * 256;
#pragma unroll 1
    for (int nt = 0; nt < 2; ++nt)
        gemm_tile1(Qt, 1024, Kb + (size_t)nt * 128 * 1024, 1024, 256, lds,
                  [&](int r, int c, f32x4 v) { *(float4*)(Ss + r * 256 + nt * 128 + c) = make_float4(v[0] * 0.0625f, v[1] * 0.0625f, v[2] * 0.0625f, v[3] * 0.0625f); });
    __syncthreads();
    for (int i = 0; i < 32; ++i) {
        const int r = wave * 32 + i;
        const float4 x = *(const float4*)(Ss + r * 256 + lane * 4);
        const float m = wave_max(fmaxf(fmaxf(x.x, x.y), fmaxf(x.z, x.w)));
        const float e0 = __expf(x.x - m), e1 = __expf(x.y - m), e2 = __expf(x.z - m), e3 = __expf(x.w - m);
        const float inv = 1.0f / wave_sum(e0 + e1 + e2 + e3);
        *(uint2*)(Ps + r * 256 + lane * 4) = make_uint2(pack2(e0 * inv, e1 * inv), pack2(e2 * inv, e3 * inv));
    }
    __syncthreads();
#pragma unroll 1
    for (int nt = 0; nt < 2; ++nt)
        gemm_tile1(Ps, 256, Vt + (size_t)nt * 128 * 256, 256, 256, lds,
                  [&](int r, int c, f32x4 v) { *(uint2*)(Ob + (size_t)r * 1024 + nt * 128 + c) = make_uint2(pack2(v[0], v[1]), pack2(v[2], v[3])); });
    __syncthreads();
}


DEVINL void attn_prompt_item2(const Params& p, int item, char* lds) {
    const int b = item >> 7, h = (item >> 5) & 3, qt = item & 31;
    const int tid = threadIdx.x, lane = tid & 63, w = tid >> 6, fr = lane & 15, fq = lane >> 4;
    char* Kbuf = lds;
    char* Vbuf = lds + 33792;
    const size_t qrow = (size_t)b * SEQ + qt * 64 + w * 16 + fr;
    const u16* Qp = (const u16*)(p.ws + OFF_Q) + qrow * 1024 + h * 256 + fq * 8;
    const int krow = tid >> 5, kch = tid & 31;
    const u16* Kg = (const u16*)(p.ws + OFF_MK) + ((size_t)b * 256 + krow) * 1024 + h * 256 + kch * 8;
    const int klds = krow * 528 + kch * 16;
    const int vrow = tid >> 2, vch = tid & 3;
    const u16* Vg = (const u16*)(p.ws + OFF_MVT) + ((size_t)(b * 4 + h) * 256 + vrow) * 256 + vch * 8;
    const int vlds = vrow * 80 + vch * 16;
    bf16x8 qf[8];
#pragma unroll
    for (int ks = 0; ks < 8; ++ks) qf[ks] = *(const bf16x8*)(Qp + ks * 32);
    uint4 r0, r1, r2, r3, r4, r5, r6, r7;
#define KLOAD(KB) do { const u16* g_ = Kg + (size_t)(KB) * 64 * 1024; \
        r0 = *(const uint4*)(g_); r1 = *(const uint4*)(g_ + 8 * 1024); r2 = *(const uint4*)(g_ + 16 * 1024); r3 = *(const uint4*)(g_ + 24 * 1024); \
        r4 = *(const uint4*)(g_ + 32 * 1024); r5 = *(const uint4*)(g_ + 40 * 1024); r6 = *(const uint4*)(g_ + 48 * 1024); r7 = *(const uint4*)(g_ + 56 * 1024); } while (0)
#define KSTORE() do { char* d_ = Kbuf + klds; \
        *(uint4*)(d_) = r0; *(uint4*)(d_ + 8 * 528) = r1; *(uint4*)(d_ + 16 * 528) = r2; *(uint4*)(d_ + 24 * 528) = r3; \
        *(uint4*)(d_ + 32 * 528) = r4; *(uint4*)(d_ + 40 * 528) = r5; *(uint4*)(d_ + 48 * 528) = r6; *(uint4*)(d_ + 56 * 528) = r7; } while (0)
#define VLOAD(VB) do { const u16* g_ = Vg + (VB) * 32; \
        r0 = *(const uint4*)(g_); r1 = *(const uint4*)(g_ + 64 * 256); r2 = *(const uint4*)(g_ + 128 * 256); r3 = *(const uint4*)(g_ + 192 * 256); } while (0)
#define VSTORE() do { char* d_ = Vbuf + vlds; \
        *(uint4*)(d_) = r0; *(uint4*)(d_ + 64 * 80) = r1; *(uint4*)(d_ + 128 * 80) = r2; *(uint4*)(d_ + 192 * 80) = r3; } while (0)
    f32x4 sacc[16];
    KLOAD(0);
#pragma unroll
    for (int kb = 0; kb < 4; ++kb) {
        KSTORE();
        if (kb < 3) KLOAD(kb + 1); else VLOAD(0);
        lds_barrier();
#pragma unroll
        for (int kl = 0; kl < 4; ++kl) {
            f32x4 acc = (f32x4){0.f, 0.f, 0.f, 0.f};
#pragma unroll
            for (int ks = 0; ks < 8; ++ks)
                acc = __builtin_amdgcn_mfma_f32_16x16x32_bf16(*(const bf16x8*)(Kbuf + (kl * 16 + fr) * 528 + (ks * 32 + fq * 8) * 2), qf[ks], acc, 0, 0, 0);
            sacc[kb * 4 + kl] = acc;
        }
        lds_barrier();
    }
    float m = -3.0e38f;
#pragma unroll
    for (int kt = 0; kt < 16; ++kt) m = fmaxf(m, fmaxf(fmaxf(sacc[kt][0], sacc[kt][1]), fmaxf(sacc[kt][2], sacc[kt][3])));
    m = fmaxf(m, __shfl_xor(m, 16)); m = fmaxf(m, __shfl_xor(m, 32));
    float sum = 0.f;
#pragma unroll
    for (int kt = 0; kt < 16; ++kt)
#pragma unroll
        for (int r = 0; r < 4; ++r) { const float e = __expf((sacc[kt][r] - m) * 0.0625f); sacc[kt][r] = e; sum += e; }
    sum += __shfl_xor(sum, 16); sum += __shfl_xor(sum, 32);
    const float inv = __builtin_amdgcn_rcpf(sum);
    bf16x8 pf[8];
#pragma unroll
    for (int ks = 0; ks < 8; ++ks) {
        uint4 u;
        u.x = pack2(sacc[2 * ks][0] * inv, sacc[2 * ks][1] * inv); u.y = pack2(sacc[2 * ks][2] * inv, sacc[2 * ks][3] * inv);
        u.z = pack2(sacc[2 * ks + 1][0] * inv, sacc[2 * ks + 1][1] * inv); u.w = pack2(sacc[2 * ks + 1][2] * inv, sacc[2 * ks + 1][3] * inv);
        pf[ks] = __builtin_bit_cast(bf16x8, u);
    }
    f32x4 oacc[16];
#pragma unroll
    for (int dt = 0; dt < 16; ++dt) oacc[dt] = (f32x4){0.f, 0.f, 0.f, 0.f};
#pragma unroll
    for (int vb = 0; vb < 8; ++vb) {
        VSTORE();
        if (vb < 7) VLOAD(vb + 1);
        lds_barrier();
#pragma unroll
        for (int dt = 0; dt < 16; ++dt) {
            const uint2 lo = *(const uint2*)(Vbuf + (dt * 16 + fr) * 80 + fq * 8), hi = *(const uint2*)(Vbuf + (dt * 16 + fr) * 80 + fq * 8 + 32);
            const uint4 u = make_uint4(lo.x, lo.y, hi.x, hi.y);
            oacc[dt] = __builtin_amdgcn_mfma_f32_16x16x32_bf16(__builtin_bit_cast(bf16x8, u), pf[vb], oacc[dt], 0, 0, 0);
        }
        lds_barrier();
    }
#undef KLOAD
#undef KSTORE
#undef VLOAD
#undef VSTORE
    {
        char* img = lds + w * 8448 + fr * 528 + fq * 8;
#pragma unroll
        for (int dt = 0; dt < 16; ++dt)
            *(uint2*)(img + dt * 32) = make_uint2(pack2(oacc[dt][0], oacc[dt][1]), pack2(oacc[dt][2], oacc[dt][3]));
        const char* rd = lds + w * 8448 + (lane >> 5) * 528 + (lane & 31) * 16;
        u16* o0 = (u16*)(p.ws + OFF_O) + ((size_t)b * SEQ + qt * 64 + w * 16 + (lane >> 5)) * 1024 + h * 256 + (lane & 31) * 8;
#pragma unroll
        for (int it = 0; it < 8; ++it) *(uint4*)(o0 + (size_t)it * 2048) = *(const uint4*)(rd + it * 1056);
    }
    lds_barrier();
}

DEVINL void attn_sample_item(const Params& p, int l, int item, char* lds) {
    const int s = item >> 2, h = item & 3;
    const int tid = threadIdx.x, lane = tid & 63, wave = tid >> 6;
    float* sc = (float*)lds;
    float* red = sc + 256;
    float* wred = red + 1024;
    const int rsub = lane >> 4, part = lane & 15;
    const u16* qp = (const u16*)(p.ws + OFF_Q) + (size_t)(NP + s) * 1024 + h * 256 + part * 4;
    float qv[16];
#pragma unroll
    for (int j = 0; j < 4; ++j) {
        const uint2 qq = *(const uint2*)(qp + j * 64);
        qv[j * 4 + 0] = lo16(qq.x); qv[j * 4 + 1] = hi16(qq.x); qv[j * 4 + 2] = lo16(qq.y); qv[j * 4 + 3] = hi16(qq.y);
    }
    const size_t cb0 = (((size_t)l * NS + s) * 256) * 1024 + h * 256;
    const float* Kc = p.in[I_CK] + cb0 + part * 4;
    const float* Vc = p.in[I_CV] + cb0 + lane * 4;
#pragma unroll 1
    for (int i = 0; i < 4; ++i) {
        float4 kv[4][4];
#pragma unroll
        for (int pp = 0; pp < 4; ++pp)
#pragma unroll
            for (int j = 0; j < 4; ++j) kv[pp][j] = ldnt4(Kc + (size_t)(wave * 64 + (i * 4 + pp) * 4 + rsub) * 1024 + j * 64);
#pragma unroll
        for (int pp = 0; pp < 4; ++pp) {
            float d = 0.f;
#pragma unroll
            for (int j = 0; j < 4; ++j) d += kv[pp][j].x * qv[j * 4] + kv[pp][j].y * qv[j * 4 + 1] + kv[pp][j].z * qv[j * 4 + 2] + kv[pp][j].w * qv[j * 4 + 3];
            d += __shfl_xor(d, 1); d += __shfl_xor(d, 2); d += __shfl_xor(d, 4); d += __shfl_xor(d, 8);
            if (part == 0) sc[wave * 64 + (i * 4 + pp) * 4 + rsub] = d * 0.0625f;
        }
    }
    __syncthreads();
    const float x = sc[tid];
    const float wm = wave_max(x);
    if (lane == 0) wred[wave] = wm;
    __syncthreads();
    const float m = fmaxf(fmaxf(wred[0], wred[1]), fmaxf(wred[2], wred[3]));
    const float e = __expf(x - m);
    const float ws_ = wave_sum(e);
    if (lane == 0) wred[4 + wave] = ws_;
    __syncthreads();
    const float inv = 1.0f / (wred[4] + wred[5] + wred[6] + wred[7]);
    sc[tid] = e * inv;
    __syncthreads();
    float4 acc = make_float4(0.f, 0.f, 0.f, 0.f);
#pragma unroll 1
    for (int i = 0; i < 4; ++i) {
        float4 vv[16];
#pragma unroll
        for (int j = 0; j < 16; ++j) vv[j] = ldnt4(Vc + (size_t)(wave * 64 + i * 16 + j) * 1024);
#pragma unroll
        for (int j = 0; j < 16; ++j) {
            const float pw = sc[wave * 64 + i * 16 + j];
            acc.x += pw * vv[j].x; acc.y += pw * vv[j].y; acc.z += pw * vv[j].z; acc.w += pw * vv[j].w;
        }
    }
    *(float4*)(red + wave * 256 + lane * 4) = acc;
    __syncthreads();
    {
        const float o = red[tid] + red[256 + tid] + red[512 + tid] + red[768 + tid];
        ((u16*)(p.ws + OFF_O))[(size_t)(NP + s) * 1024 + h * 256 + tid] = (u16)f2bf(o);
    }
    __syncthreads();
}

DEVINL void phase_attn(const Params& p, int l, char* lds) {
    const int G = gridDim.x;
    const bool sample_first = (int)blockIdx.x >= (G >> 1);
#pragma unroll 1
    for (int pass = 0; pass < 2; ++pass) {
        const bool do_sample = (pass == 0) == sample_first;
        if (do_sample) {
#pragma unroll 1
            for (int it = blockIdx.x; it < 512; it += G) attn_sample_item(p, l, it, lds);
        } else {
#pragma unroll 1
            for (int it = blockIdx.x; it < 1024; it += G) attn_prompt_item2(p, it, lds);
        }
    }
}

#define XB_TMO      128
#define XB_XCNT(j)  (256  + 64 * (j))
#define XB_XSUB(j)  (1280 + 64 * (j))
#define XB_XGEN(j)  (2304 + 64 * (j))
#define XB_TOP      3328
#define XB_TOPGEN   3392
#define XCD_BAR_WORDS 3456
#define XB_SPIN_CAP (1u << 22)
#define LAS __attribute__((address_space(3)))
DEVINL unsigned xb_ld(unsigned* p) { return __hip_atomic_load(p, __ATOMIC_RELAXED, __HIP_MEMORY_SCOPE_AGENT); }
DEVINL unsigned xb_add(unsigned* p, unsigned v) { return __hip_atomic_fetch_add(p, v, __ATOMIC_RELAXED, __HIP_MEMORY_SCOPE_AGENT); }
DEVINL unsigned xb_xcc_id() { return (unsigned)__builtin_amdgcn_s_getreg((3 << 11) | 20) & 0xFu; }
#define XB_SPIN(cond, bar) do { unsigned _sp = 0; while (cond) { __builtin_amdgcn_s_sleep(1); \
    if ((++_sp & 255u) == 0u) { if (xb_ld(&(bar)[XB_TMO])) break; if (_sp > XB_SPIN_CAP) { atomicAdd(&(bar)[XB_TMO], 1u); break; } } } } while (0)
struct XcdBarrier { unsigned* bar; unsigned x; volatile LAS unsigned* st; };
DEVINL XcdBarrier xcd_barrier_post(unsigned* bar, volatile LAS unsigned* st) {
    XcdBarrier b; b.bar = bar; b.x = xb_xcc_id(); b.st = st;
    if (threadIdx.x == 0) (void)xb_add(&bar[XB_XCNT(b.x)], 1u);
    return b;
}
DEVINL void xcd_barrier_complete(unsigned* bar, unsigned x, unsigned& nloc, unsigned& nx) {
    const unsigned G = gridDim.x * gridDim.y * gridDim.z;
    unsigned sum, cnt, mine, sp = 0u;
    for (;;) {
        sum = 0u; cnt = 0u; mine = 0u;
#pragma unroll
        for (unsigned j = 0; j < 16; ++j) { const unsigned c = xb_ld(&bar[XB_XCNT(j)]); sum += c; cnt += (c > 0u) ? 1u : 0u; mine = (j == x) ? c : mine; }
        if (sum == G) break;
        __builtin_amdgcn_s_sleep(1);
        if ((++sp & 255u) == 0u) { if (xb_ld(&bar[XB_TMO])) break; if (sp > XB_SPIN_CAP) { atomicAdd(&bar[XB_TMO], 1u); break; } }
    }
    nloc = mine > 0u ? mine : 1u; nx = cnt > 0u ? cnt : 1u;
}
DEVINL void xcd_barrier(const XcdBarrier& b) {
    asm volatile("s_waitcnt vmcnt(0)" ::: "memory");
    __syncthreads();
    if (threadIdx.x == 0) {
        unsigned* bar = b.bar;
        __builtin_amdgcn_s_waitcnt(0);
        unsigned nloc = b.st[0], nx = b.st[1];
        if (nloc == 0u) { xcd_barrier_complete(bar, b.x, nloc, nx); b.st[0] = nloc; b.st[1] = nx; }
        const unsigned old = xb_add(&bar[XB_XSUB(b.x)], 1u);
        const unsigned gen = old / nloc;
        if (old + 1u == (gen + 1u) * nloc) {
            __builtin_amdgcn_fence(__ATOMIC_RELEASE, "agent");
            asm volatile("s_waitcnt vmcnt(0)" ::: "memory");
            const unsigned og = xb_add(&bar[XB_TOP], 1u);
            const unsigned tg = og / nx;
            if (og + 1u == (tg + 1u) * nx) xb_add(&bar[XB_TOPGEN], 1u);
            else XB_SPIN(xb_ld(&bar[XB_TOPGEN]) == tg, bar);
            __builtin_amdgcn_fence(__ATOMIC_ACQUIRE, "agent");
            xb_add(&bar[XB_XGEN(b.x)], 1u);
            asm volatile("s_waitcnt vmcnt(0)" ::: "memory");
        } else {
            XB_SPIN(xb_ld(&bar[XB_XGEN(b.x)]) == gen, bar);
            __builtin_amdgcn_fence(__ATOMIC_ACQUIRE, "agent");
            asm volatile("s_waitcnt vmcnt(0)" ::: "memory");
        }
    }
    __syncthreads();
}

#ifndef ONLYQ
#define ONLYQ -1
#endif
#ifndef REP_MASK
#define REP_MASK 0
#endif
__global__ void __launch_bounds__(256, 2) mega(Params p) {
    __shared__ __attribute__((aligned(16))) char lds[65536];
    __shared__ uint4 xb_words;
    XcdBarrier bar; bar.bar = (unsigned*)(p.ws + OFF_BAR); bar.x = 0; bar.st = (volatile LAS unsigned*)&xb_words;
    if (p.coop) {
        if (threadIdx.x == 0) xb_words = make_uint4(0u, 0u, 0u, 0u);
        __syncthreads();
        bar = xcd_barrier_post((unsigned*)(p.ws + OFF_BAR), (volatile LAS unsigned*)&xb_words);
    }
#define RUNPH(PH, Q, BODY) if ((ONLYQ < 0 || ONLYQ == (Q)) && p.ph_lo <= (PH) && (PH) < p.ph_hi) { BODY; if (REP_MASK & (1 << (Q))) { BODY; } \
        if (p.coop && (PH) + 1 < p.ph_hi) { if (p.pad == 0x5a5a5a5a) cg::this_grid().sync(); else xcd_barrier(bar); } }
#define LAYER(L) \
    RUNPH(1 + (L) * 10 + 0, 0, phase_gemm_in(p, L, lds)) \
    RUNPH(1 + (L) * 10 + 1, 1, phase_prep(p, L, lds)) \
    RUNPH(1 + (L) * 10 + 2, 2, phase_scan(p, L, lds)) \
    RUNPH(1 + (L) * 10 + 3, 3, phase_mixnorm(p, L)) \
    RUNPH(1 + (L) * 10 + 4, 4, phase_gemm_n1024((const u16*)(p.ws + OFF_YCAT), 2048, (const u16*)(p.ws + OFF_WOUT) + (size_t)(L) * 1024 * 2048, nullptr, (u16*)(p.ws + OFF_T), lds)) \
    RUNPH(1 + (L) * 10 + 5, 15, phase_rowpass(p, L, 0)) \
    RUNPH(1 + (L) * 10 + 6, 6, phase_gemm_n1024((const u16*)(p.ws + OFF_HB), 1024, (const u16*)(p.ws + OFF_WQ) + (size_t)(L) * 1024 * 1024, nullptr, (u16*)(p.ws + OFF_Q), lds)) \
    RUNPH(1 + (L) * 10 + 7, 7, phase_attn(p, L, lds)) \
    RUNPH(1 + (L) * 10 + 8, 8, phase_gemm_n1024((const u16*)(p.ws + OFF_O), 1024, (const u16*)(p.ws + OFF_WO) + (size_t)(L) * 1024 * 1024, nullptr, (u16*)(p.ws + OFF_T), lds)) \
    RUNPH(1 + (L) * 10 + 9, 15, phase_rowpass(p, L, 1))
    RUNPH(0, 10, phase_prologue(p, lds))
    LAYER(0)
    LAYER(1)
}

extern "C" void kernel_launch(void* const* d_in, const int* in_sizes, int n_in, void* d_out, int out_size, void* d_ws, size_t ws_size,
                              hipStream_t stream) {
    static int grid = 0;
    if (!grid) {
        int dev = 0, cus = 0, per_cu = 0;
        hipGetDevice(&dev);
        hipDeviceGetAttribute(&cus, hipDeviceAttributeMultiprocessorCount, dev);
        hipOccupancyMaxActiveBlocksPerMultiprocessor(&per_cu, mega, 256, 0);
        if (per_cu > 2) per_cu = 2;
        if (per_cu < 1) per_cu = 1;
        grid = cus * per_cu;
        if (grid > MAX_GRID) grid = MAX_GRID;
        if (n_in != 29 || ws_size < WS_END) { fprintf(stderr, "kernel_launch: unexpected n_in %d or ws_size %zu (< %zu)\n", n_in, ws_size, (size_t)WS_END); }
    }
    Params p{};
    for (int i = 0; i < 29; ++i) p.in[i] = (const float*)d_in[i];
    p.out = (float*)d_out; p.ws = (char*)d_ws;
#if MULTI_LAUNCH
    for (int ph = 0; ph < NPHASE; ++ph) {
        p.ph_lo = ph; p.ph_hi = ph + 1; p.coop = 0;
        hipLaunchKernelGGL(mega, dim3(grid), dim3(256), 0, stream, p);
    }
#else
    p.ph_lo = 0; p.ph_hi = NPHASE; p.coop = 1;
    (void)hipMemsetAsync((char*)d_ws + OFF_BAR, 0, 16384, stream);
    void* args[] = {&p};
    hipError_t e = hipLaunchCooperativeKernel((void*)mega, dim3(grid), dim3(256), args, 0, stream);
    if (e != hipSuccess) fprintf(stderr, "cooperative launch failed: %s (grid %d)\n", hipGetErrorString(e), grid);
#endif
}
```
